# Optimizing an MI355X kernel written in HIP

```python
import jax, jax.numpy as jnp
from jax import lax
import numpy as np

D_MODEL = 1024
BATCH = 2
SEQ = 8192
DEPTH = 2

HEAD_DIM = 64
MLA_HEADS = 4
MLA_Q_LORA = 256
MLA_KV_LORA = 128
MLA_NOPE = 64
MLA_ROPE = 32
MLA_V = 64
DIL_HEADS = 6
DIL_PATTERNS = ((128, 1), (512, 4), (2048, 16))
NSA_HEADS = 6
NSA_KV_GROUPS = 2
NSA_CMP_BLOCK = 32
NSA_CMP_STRIDE = 16
NSA_CMP_HIDDEN = 256
NSA_SEL_BLOCK = 64
NSA_TOP_N = 16
NSA_WINDOW = 512

Q_BLOCK = 128
MIX_WIDTH = (MLA_HEADS + DIL_HEADS + NSA_HEADS) * HEAD_DIM
D_FF = ((8 * D_MODEL // 3 + 255) // 256) * 256
ROPE_THETA = 10000.0
LN_EPS = 1e-5
RMS_EPS = 1e-6
NEG_INF = -1e30
FORCE_SCORE = 1e4

IN_SPLITS = (
    MLA_Q_LORA, MLA_KV_LORA, MLA_ROPE,
    DIL_HEADS * HEAD_DIM, DIL_HEADS * HEAD_DIM, DIL_HEADS * HEAD_DIM,
    NSA_HEADS * HEAD_DIM,
) + (NSA_KV_GROUPS * HEAD_DIM,) * 6 + (NSA_HEADS * 3,)
IN_WIDTH = sum(IN_SPLITS)

kernel_name = 'hybrid_mla_dilated_nsa_macaron_deepnorm'


def layer_norm(x, g, b):
    xf = x.astype(jnp.float32)
    mu = jnp.mean(xf, axis=-1, keepdims=True)
    var = jnp.mean(jnp.square(xf - mu), axis=-1, keepdims=True)
    return ((xf - mu) * lax.rsqrt(var + LN_EPS) * g + b).astype(x.dtype)


def rms_norm(x, g):
    xf = x.astype(jnp.float32)
    return (xf * lax.rsqrt(jnp.mean(xf * xf, axis=-1, keepdims=True) + RMS_EPS) * g).astype(x.dtype)


def swiglu(x, w_in, w_out):
    gate, up = jnp.split(x @ w_in, 2, axis=-1)
    return (jax.nn.silu(gate) * up) @ w_out


def rope_cos_sin(n_pos, dim):
    inv_freq = ROPE_THETA ** (-jnp.arange(0, dim, 2, dtype=jnp.float32) / dim)
    ang = jnp.arange(n_pos, dtype=jnp.float32)[:, None] * inv_freq[None, :]
    return jnp.cos(ang), jnp.sin(ang)


def apply_rope(x, cos, sin):
    half = x.shape[-1] // 2
    x1 = x[..., :half].astype(jnp.float32)
    x2 = x[..., half:].astype(jnp.float32)
    c, s = cos[:, None, :], sin[:, None, :]
    return jnp.concatenate([x1 * c - x2 * s, x1 * s + x2 * c], axis=-1).astype(x.dtype)


def masked_softmax(s, mask):
    s = jnp.where(mask, s.astype(jnp.float32), NEG_INF)
    m = jnp.max(s, axis=-1, keepdims=True)
    e = jnp.where(mask, jnp.exp(s - m), 0.0)
    l = jnp.maximum(jnp.sum(e, axis=-1, keepdims=True), 1e-30)
    return e / l, (m + jnp.log(l))[..., 0]


def split_cols(h, sizes):
    out, start = [], 0
    for n in sizes:
        out.append(h[..., start:start + n])
        start += n
    return out


def causal_block_attention(q, k, v):
    B, S, H, dq = q.shape
    nb = S // Q_BLOCK
    qb = q.reshape(B, nb, Q_BLOCK, H, dq).transpose(1, 0, 2, 3, 4)
    key_pos = jnp.arange(S)
    scale = dq ** -0.5

    def one_block(args):
        i, q_blk = args
        s = jnp.einsum('bqhd,bkhd->bhqk', q_blk, k).astype(jnp.float32) * scale
        qpos = i * Q_BLOCK + jnp.arange(Q_BLOCK)
        p, _ = masked_softmax(s, key_pos[None, :] <= qpos[:, None])
        return jnp.einsum('bhqk,bkhd->bqhd', p.astype(v.dtype), v)

    o = lax.map(one_block, (jnp.arange(nb), qb))
    return o.transpose(1, 0, 2, 3, 4).reshape(B, S, H, v.shape[-1])


def banded_attention(q, k, v, window):
    L, d = q.shape[-2], q.shape[-1]
    nb = L // Q_BLOCK
    n_prev = -(-window // Q_BLOCK)

    def blocks(t):
        return t.reshape(t.shape[:-2] + (nb, Q_BLOCK, t.shape[-1]))

    def with_history(tb):
        pad = [(0, 0)] * (tb.ndim - 3) + [(n_prev, 0), (0, 0), (0, 0)]
        tp = jnp.pad(tb, pad)
        return jnp.concatenate([tp[..., j:j + nb, :, :] for j in range(n_prev + 1)], axis=-2)

    qb = blocks(q)
    kh, vh = with_history(blocks(k)), with_history(blocks(v))
    s = jnp.matmul(qb, jnp.swapaxes(kh, -1, -2)).astype(jnp.float32) * d ** -0.5
    qi = jnp.arange(Q_BLOCK)[:, None] + n_prev * Q_BLOCK
    kj = jnp.arange((n_prev + 1) * Q_BLOCK)[None, :]
    dist = qi - kj
    key_pos = jnp.arange(nb)[:, None, None] * Q_BLOCK - n_prev * Q_BLOCK + kj[None]
    mask = (dist >= 0) & (dist <= window) & (key_pos >= 0)
    p, lse = masked_softmax(s, mask)
    o = jnp.matmul(p.astype(vh.dtype), vh)
    return o.reshape(o.shape[:-3] + (L, d)), lse.reshape(lse.shape[:-2] + (L,))


def dilated_attention(q, k, v):
    B, S, H, d = q.shape
    outs, lses = [], []
    for window, dil in DIL_PATTERNS:
        span = dil * Q_BLOCK
        Sp = -(-S // span) * span

        def to_sub(t):
            t = jnp.pad(t, ((0, 0), (0, Sp - S), (0, 0), (0, 0)))
            return t.reshape(B, Sp // dil, dil, H, d).transpose(0, 2, 3, 1, 4)

        o, lse = banded_attention(to_sub(q), to_sub(k), to_sub(v), window // dil)
        outs.append(o.transpose(0, 3, 1, 2, 4).reshape(B, Sp, H, d)[:, :S])
        lses.append(lse.transpose(0, 3, 1, 2).reshape(B, Sp, H)[:, :S])
    w = jax.nn.softmax(jnp.stack(lses, axis=-1), axis=-1)
    return jnp.einsum('bshp,pbshd->bshd', w.astype(q.dtype), jnp.stack(outs))


def nsa_attention(q, k_cmp, v_cmp, k_slc, v_slc, k_win, v_win, gates,
                  cmp_pos, cmp_w1, cmp_w2, cos, sin):
    B, S, H, d = q.shape
    G, Hg = NSA_KV_GROUPS, NSA_HEADS // NSA_KV_GROUPS
    nb = S // Q_BLOCK
    scale = d ** -0.5
    q_rot = apply_rope(q, cos, sin)

    n_cmp = (S - NSA_CMP_BLOCK) // NSA_CMP_STRIDE + 1
    cmp_start = jnp.arange(n_cmp) * NSA_CMP_STRIDE
    cmp_end = cmp_start + NSA_CMP_BLOCK - 1
    cmp_idx = cmp_start[:, None] + jnp.arange(NSA_CMP_BLOCK)[None, :]

    def compress(t, pos, w1, w2):
        blk = t[:, cmp_idx] + pos[:, None, :]
        flat = blk.transpose(0, 1, 3, 2, 4).reshape(B, n_cmp, G, NSA_CMP_BLOCK * d)
        return (jax.nn.silu(flat @ w1) @ w2).transpose(0, 2, 1, 3)

    kc = compress(k_cmp, cmp_pos[0], cmp_w1[0], cmp_w2[0])
    vc = compress(v_cmp, cmp_pos[1], cmp_w1[1], cmp_w2[1])

    n_sel = S // NSA_SEL_BLOCK
    n_top = min(NSA_TOP_N, n_sel)
    sel_start = jnp.arange(n_sel) * NSA_SEL_BLOCK
    overlap = ((cmp_start[:, None] < sel_start[None, :] + NSA_SEL_BLOCK) &
               (cmp_end[:, None] >= sel_start[None, :])).astype(jnp.float32)
    ks = k_slc.transpose(0, 2, 1, 3)
    vs = v_slc.transpose(0, 2, 1, 3)
    sel_offsets = jnp.arange(NSA_SEL_BLOCK)
    blk_ids = jnp.arange(n_sel)[None, :]

    def grouped(t):
        return t.reshape(B, nb, Q_BLOCK, G, Hg, d).transpose(1, 0, 3, 4, 2, 5)

    def one_block(args):
        i, q_c, q_s = args
        qpos = i * Q_BLOCK + jnp.arange(Q_BLOCK)
        s = jnp.einsum('bghqd,bgcd->bghqc', q_c, kc).astype(jnp.float32) * scale
        p, _ = masked_softmax(s, cmp_end[None, :] <= qpos[:, None])
        o_c = jnp.einsum('bghqc,bgcd->bghqd', p.astype(vc.dtype), vc)
        imp = jnp.einsum('bgqc,cj->bgqj', jnp.sum(p, axis=2), overlap)
        cur = (qpos // NSA_SEL_BLOCK)[:, None]
        forced = (blk_ids == 0) | (blk_ids == cur) | (blk_ids == cur - 1)
        score = jnp.where(forced, FORCE_SCORE, jnp.where(blk_ids <= cur, imp, -FORCE_SCORE))
        _, top = lax.top_k(score, n_top)
        tok = (top[..., None] * NSA_SEL_BLOCK + sel_offsets).reshape(B, G, -1)
        n_keys = n_top * NSA_SEL_BLOCK
        kg = jnp.take_along_axis(ks, tok[..., None], axis=2).reshape(B, G, Q_BLOCK, n_keys, d)
        vg = jnp.take_along_axis(vs, tok[..., None], axis=2).reshape(B, G, Q_BLOCK, n_keys, d)
        s = jnp.einsum('bghqd,bgqkd->bghqk', q_s, kg).astype(jnp.float32) * scale
        kmask = tok.reshape(B, G, 1, Q_BLOCK, n_keys) <= qpos[:, None]
        p, _ = masked_softmax(s, kmask)
        o_s = jnp.einsum('bghqk,bgqkd->bghqd', p.astype(vg.dtype), vg)
        return o_c, o_s

    o_cmp, o_slc = lax.map(one_block, (jnp.arange(nb), grouped(q), grouped(q_rot)))

    def ungroup(t):
        return t.transpose(1, 0, 4, 2, 3, 5).reshape(B, S, H, d)

    q_w = q_rot.reshape(B, S, G, Hg, d).transpose(0, 2, 3, 1, 4)
    k_w = k_win.transpose(0, 2, 1, 3)[:, :, None]
    v_w = v_win.transpose(0, 2, 1, 3)[:, :, None]
    o_win, _ = banded_attention(q_w, k_w, v_w, NSA_WINDOW)
    o_win = o_win.transpose(0, 3, 1, 2, 4).reshape(B, S, H, d)
    g = gates.astype(q.dtype)
    return g[..., 0:1] * ungroup(o_cmp) + g[..., 1:2] * ungroup(o_slc) + g[..., 2:3] * o_win


def token_mixing(h, w_in, w_out, q_norm, kv_norm, w_uq, w_ukv, cmp_pos, cmp_w1, cmp_w2,
                 cos, sin, cos_m, sin_m):
    B, S, _ = h.shape
    (c_q, c_kv, k_pe, dq, dk, dv, nq, kc, vc, ksl, vsl, kw, vw, gl) = split_cols(h @ w_in, IN_SPLITS)

    def heads(t):
        return t.reshape(B, S, -1, HEAD_DIM)

    q_a = (rms_norm(c_q, q_norm) @ w_uq).reshape(B, S, MLA_HEADS, MLA_NOPE + MLA_ROPE)
    q_a = jnp.concatenate([q_a[..., :MLA_NOPE], apply_rope(q_a[..., MLA_NOPE:], cos_m, sin_m)], axis=-1)
    kv_a = (rms_norm(c_kv, kv_norm) @ w_ukv).reshape(B, S, MLA_HEADS, MLA_NOPE + MLA_V)
    k_pe = apply_rope(k_pe.reshape(B, S, 1, MLA_ROPE), cos_m, sin_m)
    k_a = jnp.concatenate([kv_a[..., :MLA_NOPE],
                           jnp.broadcast_to(k_pe, (B, S, MLA_HEADS, MLA_ROPE))], axis=-1)
    o_a = causal_block_attention(q_a, k_a, kv_a[..., MLA_NOPE:])

    o_b = dilated_attention(apply_rope(heads(dq), cos, sin), apply_rope(heads(dk), cos, sin), heads(dv))

    o_c = nsa_attention(heads(nq), heads(kc), heads(vc),
                        apply_rope(heads(ksl), cos, sin), heads(vsl),
                        apply_rope(heads(kw), cos, sin), heads(vw),
                        jax.nn.sigmoid(gl.astype(jnp.float32)).reshape(B, S, NSA_HEADS, 3),
                        cmp_pos, cmp_w1, cmp_w2, cos, sin)

    o = jnp.concatenate([o_a, o_b, o_c], axis=2).reshape(B, S, MIX_WIDTH)
    return o @ w_out


def setup_inputs(seed: int = 0) -> dict:
    key = jax.random.key(seed)
    k = jax.random.split(key, 14)
    beta = (8 * DEPTH) ** -0.25

    def nrm(kk, shape, scale):
        return jax.random.normal(kk, shape, jnp.float32) * scale

    return {
        'x': nrm(k[0], (BATCH, SEQ, D_MODEL), 1.0),
        'ffn_w_in': nrm(k[1], (DEPTH, 2, D_MODEL, 2 * D_FF), D_MODEL ** -0.5),
        'ffn_w_out': nrm(k[2], (DEPTH, 2, D_FF, D_MODEL), beta * D_FF ** -0.5),
        'ln_gain': 1.0 + nrm(k[3], (DEPTH, 3, D_MODEL), 0.02),
        'ln_bias': nrm(k[4], (DEPTH, 3, D_MODEL), 0.02),
        'w_in': nrm(k[5], (DEPTH, D_MODEL, IN_WIDTH), D_MODEL ** -0.5),
        'w_out': nrm(k[6], (DEPTH, MIX_WIDTH, D_MODEL), beta * MIX_WIDTH ** -0.5),
        'mla_q_norm': 1.0 + nrm(k[7], (DEPTH, MLA_Q_LORA), 0.02),
        'mla_kv_norm': 1.0 + nrm(k[8], (DEPTH, MLA_KV_LORA), 0.02),
        'mla_w_uq': nrm(k[9], (DEPTH, MLA_Q_LORA, MLA_HEADS * (MLA_NOPE + MLA_ROPE)), MLA_Q_LORA ** -0.5),
        'mla_w_ukv': nrm(k[10], (DEPTH, MLA_KV_LORA, MLA_HEADS * (MLA_NOPE + MLA_V)), MLA_KV_LORA ** -0.5),
        'nsa_cmp_pos': nrm(k[11], (DEPTH, 2, NSA_CMP_BLOCK, HEAD_DIM), 0.1),
        'nsa_cmp_w1': nrm(k[12], (DEPTH, 2, NSA_CMP_BLOCK * HEAD_DIM, NSA_CMP_HIDDEN),
                          (NSA_CMP_BLOCK * HEAD_DIM) ** -0.5),
        'nsa_cmp_w2': nrm(k[13], (DEPTH, 2, NSA_CMP_HIDDEN, HEAD_DIM), NSA_CMP_HIDDEN ** -0.5),
    }


def reference(x, ffn_w_in, ffn_w_out, ln_gain, ln_bias, w_in, w_out, mla_q_norm, mla_kv_norm,
              mla_w_uq, mla_w_ukv, nsa_cmp_pos, nsa_cmp_w1, nsa_cmp_w2):
    S = x.shape[1]
    alpha = (2 * DEPTH) ** 0.25
    cos, sin = rope_cos_sin(S, HEAD_DIM)
    cos_m, sin_m = rope_cos_sin(S, MLA_ROPE)
    for l in range(DEPTH):
        x = layer_norm(alpha * x + 0.5 * swiglu(x, ffn_w_in[l, 0], ffn_w_out[l, 0]),
                       ln_gain[l, 0], ln_bias[l, 0])
        mix = token_mixing(x, w_in[l], w_out[l], mla_q_norm[l], mla_kv_norm[l], mla_w_uq[l],
                           mla_w_ukv[l], nsa_cmp_pos[l], nsa_cmp_w1[l], nsa_cmp_w2[l],
                           cos, sin, cos_m, sin_m)
        x = layer_norm(alpha * x + mix, ln_gain[l, 1], ln_bias[l, 1])
        x = layer_norm(alpha * x + 0.5 * swiglu(x, ffn_w_in[l, 1], ffn_w_out[l, 1]),
                       ln_gain[l, 2], ln_bias[l, 2])
    return x
```

```cpp
#include <hip/hip_runtime.h>
#include <hip/hip_cooperative_groups.h>
#include <cstdio>
#include <cstdint>
#include <cstring>
namespace cg = cooperative_groups;

typedef unsigned short bf16_t;
typedef short bf16x8 __attribute__((ext_vector_type(8)));
typedef short s16x4 __attribute__((ext_vector_type(4)));
typedef float f32x4 __attribute__((ext_vector_type(4)));
typedef unsigned u32x4 __attribute__((ext_vector_type(4)));
typedef unsigned u32x2 __attribute__((ext_vector_type(2)));
#define DI __device__ __forceinline__
#define LDSP(T, p) ((__attribute__((address_space(3))) T*)(p))

#ifndef ENABLE_MIX
#define ENABLE_MIX 1
#endif
#ifndef ONE_LAUNCH
#define ONE_LAUNCH 1
#endif

constexpr int T_ = 16384, S_ = 8192, D_ = 1024, F_ = 2816, PW = 3200;
constexpr float ALPHA = 1.41421356237f;
constexpr int C_CQ = 0, C_CKV = 256, C_DQ = 384, C_DK = 768, C_DV = 1152, C_NQ = 1536, C_NQR = 1920, C_KC = 2304, C_VC = 2432,
              C_KSL = 2560, C_VSL = 2688, C_KW = 2816, C_VW = 2944, C_KPE = 3072, C_GL = 3104;
constexpr int NCMP = 511;

constexpr size_t SZ_FIN = 5632ull * 1024 * 2, SZ_FOUT = 1024ull * 2816 * 2, SZ_WIN = (size_t)PW * 1024 * 2, SZ_WOUT = 1024ull * 1024 * 2,
                 SZ_UQ = 384ull * 256 * 2, SZ_UKV = 512ull * 128 * 2, SZ_C1 = 256ull * 2048 * 2, SZ_C2 = 64ull * 256 * 2;
constexpr size_t LW_FIN = 0, LW_FOUT = LW_FIN + 2 * SZ_FIN, LW_WIN = LW_FOUT + 2 * SZ_FOUT, LW_WOUT = LW_WIN + SZ_WIN, LW_UQ = LW_WOUT + SZ_WOUT,
                 LW_UKV = LW_UQ + SZ_UQ, LW_C1 = LW_UKV + SZ_UKV, LW_C2 = LW_C1 + 2 * SZ_C1, LW_SIZE = LW_C2 + 2 * SZ_C2;
constexpr size_t OFF_CTRL = 0, OFF_C64 = 4096, OFF_S64 = OFF_C64 + 8192ull * 32 * 4, OFF_C32 = OFF_S64 + 8192ull * 32 * 4, OFF_S32 = OFF_C32 + 8192ull * 16 * 4,
                 OFF_CBIAS = OFF_S32 + 8192ull * 16 * 4, OFF_W = OFF_CBIAS + 4096, OFF_XB = OFF_W + 2 * LW_SIZE, OFF_BIG = OFF_XB + (size_t)T_ * D_ * 2,
                 OFF_QA = OFF_BIG + (size_t)T_ * PW * 2, OFF_KA = OFF_QA + (size_t)T_ * 384 * 2, OFF_VA = OFF_KA + (size_t)T_ * 384 * 2,
                 OFF_DILO = OFF_VA + (size_t)T_ * 256 * 2, OFF_DILL = OFF_DILO + 3ull * T_ * 384 * 2, OFF_CHID = OFF_DILL + 3ull * T_ * 6 * 4,
                 OFF_KCVC = OFF_CHID + 2ull * 2048 * 256 * 2, OFF_SEL = OFF_KCVC + 2ull * 2048 * 64 * 2, OFF_IMP = OFF_SEL + (size_t)T_ * 2 * 4 * 4,
                 OFF_END = OFF_IMP + (size_t)T_ * 2 * 128 * 4;

struct WDesc { const float* src; bf16_t* dst; const float* kscale; int K, Nsrc, Ndst, map, tile0, ntn; };
struct Params {
  const float* x; const float* ln_g; const float* ln_b; const float* cmp_pos; const float* cmp_w1;
  float* out; char* ws;
  WDesc wd[24];
  int n_wtiles; int pad0;
};
struct Ctx { const float* x; const float* ln_g; const float* ln_b; const float* cmp_pos; const float* cmp_w1; float* out; char* ws; int tid; };

DI bf16_t f2bf(float x) { unsigned u = __float_as_uint(x); u += 0x7fffu + ((u >> 16) & 1u); return (bf16_t)(u >> 16); }
DI float bf2f(bf16_t v) { return __uint_as_float(((unsigned)v) << 16); }
DI unsigned pk2(float a, float b) { return (unsigned)f2bf(a) | ((unsigned)f2bf(b) << 16); }
DI float fast_exp2(float x) { return __builtin_amdgcn_exp2f(x); }
DI float silu(float v) { return v / (1.f + __expf(-v)); }
DI f32x4 mfma16(bf16x8 a, bf16x8 b, f32x4 c) { return __builtin_amdgcn_mfma_f32_16x16x32_bf16(a, b, c, 0, 0, 0); }

DI void sincos_rr(float ang, float& c, float& s) {
  const double rev = (double)ang * 0.15915494309189533577; const float fr = (float)(rev - rint(rev));
  c = __builtin_amdgcn_cosf(fr); s = __builtin_amdgcn_sinf(fr);
}

struct ALin { const bf16_t* A; int lda; int mmax; DI const bf16_t* ptr(int row, int k) const { row = row < mmax ? row : mmax - 1; return A + (size_t)row * lda + k; } };
struct ACmp {
  const bf16_t* proj; int colbase;
  DI const bf16_t* ptr(int m, int k) const { if (m > 2043) m = 2043; int b = m / 1022, rem = m - b * 1022, g = rem / 511, c = rem - g * 511;
    return proj + (size_t)(b * S_ + 16 * c + (k >> 6)) * PW + colbase + g * 64 + (k & 63); } };

template <class AL, class EPI>
DI void gemm_tile(const int tid, const AL al, const bf16_t* __restrict__ Bt, int ldb, int nvalid, int K, int m0, int n0, const EPI epi, char* smem) {
  const int lane = tid & 63, wave = tid >> 6, wr = wave >> 1, wc = wave & 1, g = lane >> 4;
  const int lrow = tid >> 3, lc = tid & 7;
  f32x4 acc[4][4];
#pragma unroll
  for (int i = 0; i < 4; ++i)
#pragma unroll
    for (int j = 0; j < 4; ++j) acc[i][j] = (f32x4){0.f, 0.f, 0.f, 0.f};
  u32x4 ra[4], rb[4];
  const bf16_t* bp[4];
#pragma unroll
  for (int i = 0; i < 4; ++i) { int r = n0 + lrow + 32 * i; r = r < nvalid ? r : nvalid - 1; bp[i] = Bt + (size_t)r * ldb + lc * 8; }
  const int soff = lrow * 128 + ((lc ^ (lrow & 7)) << 4);
  const int offA = (wr * 64 + (lane & 15)) * 128 + ((g ^ (lane & 7)) << 4);
  const int offB = (wc * 64 + (lane & 15)) * 128 + ((g ^ (lane & 7)) << 4);
  const int nk = K >> 6;
#pragma unroll
  for (int i = 0; i < 4; ++i) { ra[i] = *(const u32x4*)al.ptr(m0 + lrow + 32 * i, lc * 8); rb[i] = *(const u32x4*)(bp[i]); }
#pragma unroll
  for (int i = 0; i < 4; ++i) { *(u32x4*)(smem + soff + i * 4096) = ra[i]; *(u32x4*)(smem + 16384 + soff + i * 4096) = rb[i]; }
  __syncthreads();
  for (int kt = 0; kt < nk; ++kt) {
    const bool more = kt + 1 < nk;
    if (more) {
      const int k0 = (kt + 1) << 6;
#pragma unroll
      for (int i = 0; i < 4; ++i) { ra[i] = *(const u32x4*)al.ptr(m0 + lrow + 32 * i, k0 + lc * 8); rb[i] = *(const u32x4*)(bp[i] + k0); }
    }
    const char* sa = smem + (kt & 1) * 32768; const char* sb = sa + 16384;
#pragma unroll
    for (int ks = 0; ks < 2; ++ks) {
      bf16x8 af[4], bfr[4];
#pragma unroll
      for (int i = 0; i < 4; ++i) { af[i] = *(const bf16x8*)(sa + ((offA + i * 2048) ^ (ks << 6))); bfr[i] = *(const bf16x8*)(sb + ((offB + i * 2048) ^ (ks << 6))); }
#pragma unroll
      for (int i = 0; i < 4; ++i)
#pragma unroll
        for (int j = 0; j < 4; ++j) acc[i][j] = mfma16(af[i], bfr[j], acc[i][j]);
    }
    if (more) {
      char* da = smem + ((kt + 1) & 1) * 32768;
#pragma unroll
      for (int i = 0; i < 4; ++i) { *(u32x4*)(da + soff + i * 4096) = ra[i]; *(u32x4*)(da + 16384 + soff + i * 4096) = rb[i]; }
    }
    __syncthreads();
  }
  epi(acc, m0 + wr * 64, n0 + wc * 64, lane);
}

DI void store_plain(bf16_t* dst, int ld, const f32x4 (&acc)[4][4], int row0, int col0, int lane, float sc) {
#pragma unroll
  for (int mi = 0; mi < 4; ++mi)
#pragma unroll
    for (int r = 0; r < 4; ++r) { const int row = row0 + mi * 16 + (lane >> 4) * 4 + r;
#pragma unroll
      for (int ni = 0; ni < 4; ++ni) dst[(size_t)row * ld + col0 + ni * 16 + (lane & 15)] = f2bf(acc[mi][ni][r] * sc); }
}

struct EpiSwiGLU { bf16_t* H;
  DI void operator()(const f32x4 (&acc)[4][4], int row0, int col0, int lane) const {
#pragma unroll
    for (int mi = 0; mi < 4; ++mi)
#pragma unroll
      for (int r = 0; r < 4; ++r) { const int row = row0 + mi * 16 + (lane >> 4) * 4 + r;
#pragma unroll
        for (int pr = 0; pr < 2; ++pr) { const float gt = acc[mi][2 * pr][r], up = acc[mi][2 * pr + 1][r];
          H[(size_t)row * F_ + ((col0 >> 5) + pr) * 16 + (lane & 15)] = f2bf(silu(gt) * up); } }
  } };
struct EpiResid { const float* xin; float* y; float scale;
  DI void operator()(const f32x4 (&acc)[4][4], int row0, int col0, int lane) const {
#pragma unroll
    for (int mi = 0; mi < 4; ++mi)
#pragma unroll
      for (int r = 0; r < 4; ++r) { const int row = row0 + mi * 16 + (lane >> 4) * 4 + r;
#pragma unroll
        for (int ni = 0; ni < 4; ++ni) { const size_t ix = (size_t)row * D_ + col0 + ni * 16 + (lane & 15); y[ix] = ALPHA * xin[ix] + scale * acc[mi][ni][r]; } }
  } };
struct EpiProj { bf16_t* proj; bf16_t* ka; const float* c64; const float* s64; const float* c32; const float* s32;
  DI void operator()(const f32x4 (&acc)[4][4], int row0, int col0, int lane) const {
    const bool rope = (col0 >= C_DQ && col0 < C_DV) || (col0 >= C_NQR && col0 < C_KC) || (col0 >= C_KSL && col0 < C_VSL) || (col0 >= C_KW && col0 < C_VW);
    if (rope) {
#pragma unroll
      for (int mi = 0; mi < 4; ++mi)
#pragma unroll
        for (int r = 0; r < 4; ++r) { const int row = row0 + mi * 16 + (lane >> 4) * 4 + r, pos = row & (S_ - 1);
#pragma unroll
          for (int ni = 0; ni < 2; ++ni) { const int i = ni * 16 + (lane & 15); const float c = c64[pos * 32 + i], s = s64[pos * 32 + i];
            const float x1 = acc[mi][ni][r], x2 = acc[mi][ni + 2][r];
            proj[(size_t)row * PW + col0 + i] = f2bf(x1 * c - x2 * s); proj[(size_t)row * PW + col0 + 32 + i] = f2bf(x1 * s + x2 * c); } }
    } else if (col0 == C_KPE) {
#pragma unroll
      for (int mi = 0; mi < 4; ++mi)
#pragma unroll
        for (int r = 0; r < 4; ++r) { const int row = row0 + mi * 16 + (lane >> 4) * 4 + r, pos = row & (S_ - 1); const int i = lane & 15;
          const float c = c32[pos * 16 + i], s = s32[pos * 16 + i]; const float x1 = acc[mi][0][r], x2 = acc[mi][1][r];
          const bf16_t o1 = f2bf(x1 * c - x2 * s), o2 = f2bf(x1 * s + x2 * c);
#pragma unroll
          for (int h = 0; h < 4; ++h) { ka[(size_t)row * 384 + h * 96 + 64 + i] = o1; ka[(size_t)row * 384 + h * 96 + 80 + i] = o2; }
#pragma unroll
          for (int ni = 2; ni < 4; ++ni) { const float v = acc[mi][ni][r]; proj[(size_t)row * PW + col0 + ni * 16 + i] = f2bf(1.f / (1.f + __expf(-v))); } }
    } else store_plain(proj, PW, acc, row0, col0, lane, 1.f);
  } };
struct EpiMLAq { bf16_t* qa; const float* rs; int m0; const float* c32; const float* s32;
  DI void operator()(const f32x4 (&acc)[4][4], int row0, int col0, int lane) const {
#pragma unroll
    for (int mi = 0; mi < 4; ++mi)
#pragma unroll
      for (int r = 0; r < 4; ++r) { const int row = row0 + mi * 16 + (lane >> 4) * 4 + r, pos = row & (S_ - 1); const float sc = rs[row - m0]; const int i = lane & 15;
#pragma unroll
        for (int ch = 0; ch < 2; ++ch) { const int gc = col0 + 32 * ch; const float x1 = acc[mi][2 * ch][r] * sc, x2 = acc[mi][2 * ch + 1][r] * sc;
          if (((gc >> 5) % 3) == 2) { const float c = c32[pos * 16 + i], s = s32[pos * 16 + i];
            qa[(size_t)row * 384 + gc + i] = f2bf(x1 * c - x2 * s); qa[(size_t)row * 384 + gc + 16 + i] = f2bf(x1 * s + x2 * c); }
          else { qa[(size_t)row * 384 + gc + i] = f2bf(x1); qa[(size_t)row * 384 + gc + 16 + i] = f2bf(x2); } } }
  } };
struct EpiMLAkv { bf16_t* ka; bf16_t* va; const float* rs; int m0;
  DI void operator()(const f32x4 (&acc)[4][4], int row0, int col0, int lane) const {
    const int h = col0 >> 7, part = (col0 >> 6) & 1;
#pragma unroll
    for (int mi = 0; mi < 4; ++mi)
#pragma unroll
      for (int r = 0; r < 4; ++r) { const int row = row0 + mi * 16 + (lane >> 4) * 4 + r; const float sc = rs[row - m0];
#pragma unroll
        for (int ni = 0; ni < 4; ++ni) { const int j = ni * 16 + (lane & 15); const bf16_t v = f2bf(acc[mi][ni][r] * sc);
          if (part == 0) ka[(size_t)row * 384 + h * 96 + j] = v; else va[(size_t)row * 256 + h * 64 + j] = v; } }
  } };
struct EpiCmp1 { bf16_t* hid; const float* bias;
  DI void operator()(const f32x4 (&acc)[4][4], int row0, int col0, int lane) const {
#pragma unroll
    for (int mi = 0; mi < 4; ++mi)
#pragma unroll
      for (int r = 0; r < 4; ++r) { const int row = row0 + mi * 16 + (lane >> 4) * 4 + r;
#pragma unroll
        for (int ni = 0; ni < 4; ++ni) { const int col = col0 + ni * 16 + (lane & 15); hid[(size_t)row * 256 + col] = f2bf(silu(acc[mi][ni][r] + bias[col])); } }
  } };
struct EpiCmp2 { bf16_t* kc;
  DI void operator()(const f32x4 (&acc)[4][4], int row0, int col0, int lane) const {
    if (col0 >= 64) return;
#pragma unroll
    for (int mi = 0; mi < 4; ++mi)
#pragma unroll
      for (int r = 0; r < 4; ++r) { const int row = row0 + mi * 16 + (lane >> 4) * 4 + r;
        if (row < 2044) {
#pragma unroll
          for (int ni = 0; ni < 4; ++ni) kc[(size_t)row * 64 + col0 + ni * 16 + (lane & 15)] = f2bf(acc[mi][ni][r]); } }
  } };

template <int DQ, int MODE, class OUT>
DI void attn_core(const int tid, const bf16_t* __restrict__ Qb, long qs, const bf16_t* __restrict__ Kb, long kst, const bf16_t* __restrict__ Vb, long vst,
                  int q0, int k0, int kmax, int ntiles, const int* tlist, float sl2, int window,
                  const unsigned* selw, float* impg, bool first_head, float (&m_io)[2], float (&l_io)[2], const OUT out, char* smem) {
  constexpr int NKD = DQ / 32, CPR = DQ / 8, KST = (DQ == 64) ? 128 : 256, NKC = 64 * CPR / 256;
  const int lane = tid & 63, wave = tid >> 6, g = lane >> 4, li = lane & 15;
  bf16x8 qf[2][NKD];
#pragma unroll
  for (int qt = 0; qt < 2; ++qt)
#pragma unroll
    for (int kd = 0; kd < NKD; ++kd) qf[qt][kd] = *(const bf16x8*)(Qb + (long)(q0 + wave * 32 + qt * 16 + li) * qs + kd * 32 + g * 8);
  int qidx[2]; qidx[0] = q0 + wave * 32 + li; qidx[1] = qidx[0] + 16;
  f32x4 o[4][2];
#pragma unroll
  for (int i = 0; i < 4; ++i) { o[i][0] = (f32x4){0.f, 0.f, 0.f, 0.f}; o[i][1] = (f32x4){0.f, 0.f, 0.f, 0.f}; }
  float mrun[2], lrun[2], invl[2], prev3[2];
#pragma unroll
  for (int qt = 0; qt < 2; ++qt) { prev3[qt] = 0.f;
    if (MODE == 3) { mrun[qt] = m_io[qt]; lrun[qt] = 0.f; invl[qt] = l_io[qt] > 0.f ? 1.f / l_io[qt] : 0.f; } else { mrun[qt] = -1e30f; lrun[qt] = 0.f; invl[qt] = 0.f; } }
  u32x4 rk[NKC], rv[2];
  auto gload = [&](int jt) {
    const int kb = k0 + jt * 64;
#pragma unroll
    for (int i = 0; i < NKC; ++i) { const int id = tid + 256 * i, row = id / CPR, c = id - row * CPR; int ix = kb + row; ix = ix < 0 ? 0 : (ix > kmax ? kmax : ix);
      rk[i] = *(const u32x4*)(Kb + (long)ix * kst + c * 8); }
    if (MODE != 2) {
#pragma unroll
      for (int i = 0; i < 2; ++i) { const int id = tid + 256 * i, row = id >> 3, c = id & 7; int ix = kb + row; ix = ix < 0 ? 0 : (ix > kmax ? kmax : ix);
        rv[i] = *(const u32x4*)(Vb + (long)ix * vst + c * 8); }
    }
  };
  auto lstore = [&](int buf) {
    char* kbuf = smem + buf * 16384; char* vbuf = smem + 32768 + buf * 8192;
#pragma unroll
    for (int i = 0; i < NKC; ++i) { const int id = tid + 256 * i, row = id / CPR, c = id - row * CPR; *(u32x4*)(kbuf + row * KST + ((c ^ (row & 7)) << 4)) = rk[i]; }
    if (MODE != 2) {
#pragma unroll
      for (int i = 0; i < 2; ++i) { const int id = tid + 256 * i, row = id >> 3, c = id & 7;
        *(u32x4*)(vbuf + row * 128 + (((((c >> 1) ^ ((row >> 1) & 3)) << 1) | (c & 1)) << 4)) = rv[i]; }
    }
  };
  if (ntiles > 0) { gload(tlist ? tlist[0] : 0); lstore(0); }
  __syncthreads();
  for (int it = 0; it < ntiles; ++it) {
    const int jt = tlist ? tlist[it] : it;
    const bool more = it + 1 < ntiles;
    if (more) gload(tlist ? tlist[it + 1] : it + 1);
    const char* kbuf = smem + (it & 1) * 16384; const char* vbuf = smem + 32768 + (it & 1) * 8192;
    f32x4 st[4][2];
#pragma unroll
    for (int kt4 = 0; kt4 < 4; ++kt4) {
      bf16x8 kf[NKD]; const int row = kt4 * 16 + li;
#pragma unroll
      for (int kd = 0; kd < NKD; ++kd) kf[kd] = *(const bf16x8*)(kbuf + row * KST + (((kd * 4 + g) ^ (row & 7)) << 4));
#pragma unroll
      for (int qt = 0; qt < 2; ++qt) { f32x4 a = (f32x4){0.f, 0.f, 0.f, 0.f};
#pragma unroll
        for (int kd = 0; kd < NKD; ++kd) a = mfma16(kf[kd], qf[qt][kd], a);
        st[kt4][qt] = a; }
    }
    const int kbase = k0 + jt * 64;
    bool sb[2] = {true, true};
    if (MODE == 4) { sb[0] = (selw[(wave * 32 + li) * 4 + (jt >> 5)] >> (jt & 31)) & 1u; sb[1] = (selw[(wave * 32 + 16 + li) * 4 + (jt >> 5)] >> (jt & 31)) & 1u; }
    float alpha[2];
#pragma unroll
    for (int qt = 0; qt < 2; ++qt) {
      float mx = -1e30f;
#pragma unroll
      for (int kt4 = 0; kt4 < 4; ++kt4)
#pragma unroll
        for (int r = 0; r < 4; ++r) { const int kidx = kbase + kt4 * 16 + g * 4 + r; bool v;
          if (MODE == 0) v = kidx <= qidx[qt];
          else if (MODE == 1) v = (kidx >= 0) && (kidx <= qidx[qt]) && (qidx[qt] - kidx <= window);
          else if (MODE == 2 || MODE == 3) v = (kidx <= kmax) && (16 * kidx + 31 <= qidx[qt]);
          else v = (kidx <= qidx[qt]) && sb[qt];
          const float s = v ? st[kt4][qt][r] * sl2 : -1e30f; st[kt4][qt][r] = s; mx = fmaxf(mx, s); }
      if (MODE != 3) {
        mx = fmaxf(mx, __shfl_xor(mx, 16)); mx = fmaxf(mx, __shfl_xor(mx, 32));
        const float mn = fmaxf(mrun[qt], mx); alpha[qt] = fast_exp2(mrun[qt] - mn); mrun[qt] = mn;
      } else alpha[qt] = 1.f;
      float ls = 0.f;
#pragma unroll
      for (int kt4 = 0; kt4 < 4; ++kt4)
#pragma unroll
        for (int r = 0; r < 4; ++r) { const float s = st[kt4][qt][r]; float p = (s > -5e29f) ? fast_exp2(s - mrun[qt]) : 0.f; if (MODE == 3) p *= invl[qt]; st[kt4][qt][r] = p; ls += p; }
      lrun[qt] = lrun[qt] * alpha[qt] + ls;
    }
    if (MODE == 3) {
#pragma unroll
      for (int qt = 0; qt < 2; ++qt)
#pragma unroll
        for (int kt4 = 0; kt4 < 4; ++kt4) { const float p3 = st[kt4][qt][3]; const float a = (st[kt4][qt][0] + st[kt4][qt][1]) + (st[kt4][qt][2] + p3);
          const float give = (g == 3) ? prev3[qt] : p3; const float up = __shfl(give, (lane + 48) & 63); prev3[qt] = p3;
          float* ip = impg + (size_t)(wave * 32 + qt * 16 + li) * 128 + jt * 16 + kt4 * 4 + g; const float val = a + up;
          if (first_head) *ip = val; else *ip += val; }
    }
    if (MODE != 2) {
      if (MODE != 3) {
#pragma unroll
        for (int dt = 0; dt < 4; ++dt) { o[dt][0] *= alpha[0]; o[dt][1] *= alpha[1]; }
      }
#pragma unroll
      for (int ks2 = 0; ks2 < 2; ++ks2) {
        bf16x8 pf[2];
#pragma unroll
        for (int qt = 0; qt < 2; ++qt) { u32x4 w; w[0] = pk2(st[2 * ks2][qt][0], st[2 * ks2][qt][1]); w[1] = pk2(st[2 * ks2][qt][2], st[2 * ks2][qt][3]);
          w[2] = pk2(st[2 * ks2 + 1][qt][0], st[2 * ks2 + 1][qt][1]); w[3] = pk2(st[2 * ks2 + 1][qt][2], st[2 * ks2 + 1][qt][3]); pf[qt] = __builtin_bit_cast(bf16x8, w); }
        const int rowA = 32 * ks2 + 4 * g + (li >> 2), p_ = li & 3;
#pragma unroll
        for (int dt = 0; dt < 4; ++dt) {
          const int off = rowA * 128 + ((((dt ^ ((rowA >> 1) & 3)) << 1) | (p_ >> 1)) << 4) + 8 * (p_ & 1);
          const s16x4 lo = __builtin_amdgcn_ds_read_tr16_b64_v4i16(LDSP(s16x4, vbuf + off));
          const s16x4 hi = __builtin_amdgcn_ds_read_tr16_b64_v4i16(LDSP(s16x4, vbuf + off + 2048));
          const bf16x8 vf = __builtin_shufflevector(lo, hi, 0, 1, 2, 3, 4, 5, 6, 7);
          o[dt][0] = mfma16(vf, pf[0], o[dt][0]); o[dt][1] = mfma16(vf, pf[1], o[dt][1]);
        }
      }
    }
    if (more) lstore((it + 1) & 1);
    __syncthreads();
  }
#pragma unroll
  for (int qt = 0; qt < 2; ++qt) {
    float lt = lrun[qt]; lt += __shfl_xor(lt, 16); lt += __shfl_xor(lt, 32);
    if (MODE == 2) { m_io[qt] = mrun[qt]; l_io[qt] = lt; }
    else {
      const float inv = (MODE == 3) ? 1.f : (lt > 0.f ? 1.f / lt : 0.f);
#pragma unroll
      for (int dt = 0; dt < 4; ++dt) out(wave * 32 + qt * 16 + li, dt * 16 + g * 4, o[dt][qt] * inv, mrun[qt], lt);
    }
  }
}

struct OutSet { bf16_t* dst; long ld; const bf16_t* gate; long gld; float* lse; long lld;
  DI void operator()(int ql, int d0, f32x4 v, float m, float l) const {
    float gs = 1.f; if (gate) gs = bf2f(gate[ql * gld]);
    u32x2 w; w[0] = pk2(v[0] * gs, v[1] * gs); w[1] = pk2(v[2] * gs, v[3] * gs); *(u32x2*)(dst + ql * ld + d0) = w;
    if (lse && d0 == 0) lse[ql * lld] = (m + __log2f(l)) * 0.69314718056f;
  } };
struct OutAdd { bf16_t* dst; long ld; const bf16_t* gate; long gld;
  DI void operator()(int ql, int d0, f32x4 v, float m, float l) const {
    const float gs = bf2f(gate[ql * gld]); u32x2* p = (u32x2*)(dst + ql * ld + d0); const u32x2 old = *p;
    u32x2 w; w[0] = pk2(__uint_as_float(old[0] << 16) + v[0] * gs, __uint_as_float(old[0] & 0xffff0000u) + v[1] * gs);
    w[1] = pk2(__uint_as_float(old[1] << 16) + v[2] * gs, __uint_as_float(old[1] & 0xffff0000u) + v[3] * gs); *p = w;
  } };

DI bf16_t* lw(char* ws, int l, size_t off) { return (bf16_t*)(ws + OFF_W + (size_t)l * LW_SIZE + off); }

DI int colmap(int map, int n, int nsrc) {
  if (map == 0) return n < nsrc ? n : -1;
  if (map == 1) { const int t = n >> 5, i = n & 31; return i < 16 ? 16 * t + i : 2816 + 16 * t + (i - 16); }
  if (n < 384) return n;
  if (n < C_DV + 384) return 416 + (n - C_DQ);
  if (n < C_NQR) return 1568 + (n - C_NQ);
  if (n < C_KC) return 1568 + (n - C_NQR);
  if (n < C_KPE) return 1952 + (n - C_KC);
  if (n < C_GL) return 384 + (n - C_KPE);
  if (n < C_GL + 18) return 2720 + (n - C_GL);
  return -1;
}

DI void phase_prologue(const Params& P, const Ctx& p, char* smem) {
  const int tid = p.tid;
  const int n_w = P.n_wtiles, n_cb = 4, n_r64 = 256, n_r32 = 128, n_xb = 4096;
  const int total = n_w + n_cb + n_r64 + n_r32 + n_xb;
  for (int t = blockIdx.x; t < total; t += gridDim.x) {
    if (t < n_w) {
      int di = 0;
#pragma unroll 1
      for (int i = 1; i < 24; ++i) if (t >= P.wd[i].tile0) di = i;
      const WDesc d = P.wd[di]; const int lt = t - d.tile0, tn = lt % d.ntn, tk = lt / d.ntn, n0 = tn * 64, k0 = tk * 64;
      float* tile = (float*)smem;
      const int nn = tid & 63; const int sc = colmap(d.map, n0 + nn, d.Nsrc);
#pragma unroll 4
      for (int i = 0; i < 16; ++i) { const int kk = (tid >> 6) + 4 * i; float v = 0.f;
        if (sc >= 0) { v = d.src[(size_t)(k0 + kk) * d.Nsrc + sc]; if (d.kscale) v *= d.kscale[k0 + kk]; }
        tile[kk * 65 + nn] = v; }
      __syncthreads();
      { const int on = tid >> 2, kq = tid & 3; u32x4 w0, w1;
#pragma unroll
        for (int j = 0; j < 4; ++j) { w0[j] = pk2(tile[(kq * 16 + 2 * j) * 65 + on], tile[(kq * 16 + 2 * j + 1) * 65 + on]);
          w1[j] = pk2(tile[(kq * 16 + 8 + 2 * j) * 65 + on], tile[(kq * 16 + 8 + 2 * j + 1) * 65 + on]); }
        bf16_t* dp = d.dst + (size_t)(n0 + on) * d.K + k0 + kq * 16; *(u32x4*)dp = w0; *(u32x4*)(dp + 8) = w1; }
      __syncthreads();
    } else if (t < n_w + n_cb) {
      const int id = t - n_w; const float* pos = p.cmp_pos + (size_t)id * 2048; const float* w1 = p.cmp_w1 + (size_t)id * 2048 * 256; float a = 0.f;
      for (int k = 0; k < 2048; ++k) a += pos[k] * w1[(size_t)k * 256 + tid];
      ((float*)(p.ws + OFF_CBIAS))[id * 256 + tid] = a;
    } else if (t < n_w + n_cb + n_r64) {
      const int e0 = (t - n_w - n_cb) * 1024; float* C = (float*)(p.ws + OFF_C64); float* Sn = (float*)(p.ws + OFF_S64);
      for (int e = e0 + tid; e < e0 + 1024; e += 256) { const int pos = e >> 5, i = e & 31; const float inv = exp2f(-(float)(2 * i) / 64.f * 13.287712379549449f); const float ang = (float)pos * inv;
        sincos_rr(ang, C[e], Sn[e]); }
    } else if (t < n_w + n_cb + n_r64 + n_r32) {
      const int e0 = (t - n_w - n_cb - n_r64) * 1024; float* C = (float*)(p.ws + OFF_C32); float* Sn = (float*)(p.ws + OFF_S32);
      for (int e = e0 + tid; e < e0 + 1024; e += 256) { const int pos = e >> 4, i = e & 15; const float inv = exp2f(-(float)(2 * i) / 32.f * 13.287712379549449f); const float ang = (float)pos * inv;
        sincos_rr(ang, C[e], Sn[e]); }
    } else {
      const size_t e0 = (size_t)(t - n_w - n_cb - n_r64 - n_r32) * 4096 + tid * 16; bf16_t* xb = (bf16_t*)(p.ws + OFF_XB);
      const f32x4 a = *(const f32x4*)(p.x + e0), b = *(const f32x4*)(p.x + e0 + 4), c = *(const f32x4*)(p.x + e0 + 8), d = *(const f32x4*)(p.x + e0 + 12);
      u32x4 w0, w1; w0[0] = pk2(a[0], a[1]); w0[1] = pk2(a[2], a[3]); w0[2] = pk2(b[0], b[1]); w0[3] = pk2(b[2], b[3]);
      w1[0] = pk2(c[0], c[1]); w1[1] = pk2(c[2], c[3]); w1[2] = pk2(d[0], d[1]); w1[3] = pk2(d[2], d[3]);
      *(u32x4*)(xb + e0) = w0; *(u32x4*)(xb + e0 + 8) = w1;
    }
  }
}

DI void phase_ffn_up(const Ctx& p, int l, int j, char* smem) {
  const ALin al{(const bf16_t*)(p.ws + OFF_XB), D_, T_}; const bf16_t* Bt = lw(p.ws, l, LW_FIN + j * SZ_FIN); const EpiSwiGLU epi{(bf16_t*)(p.ws + OFF_BIG)};
  for (int t = blockIdx.x; t < 128 * 44; t += gridDim.x) { const int nt = t % 44, mt = t / 44; gemm_tile(p.tid, al, Bt, D_, 5632, D_, mt * 128, nt * 128, epi, smem); }
}
DI void phase_ffn_down(const Ctx& p, int l, int j, char* smem) {
  const ALin al{(const bf16_t*)(p.ws + OFF_BIG), F_, T_}; const bf16_t* Bt = lw(p.ws, l, LW_FOUT + j * SZ_FOUT);
  const EpiResid epi{(l == 0 && j == 0) ? p.x : p.out, p.out, 0.5f};
  for (int t = blockIdx.x; t < 128 * 8; t += gridDim.x) { const int nt = t & 7, mt = t >> 3; gemm_tile(p.tid, al, Bt, F_, D_, F_, mt * 128, nt * 128, epi, smem); }
}
DI void phase_wout(const Ctx& p, int l, char* smem) {
  const ALin al{(const bf16_t*)(p.ws + OFF_XB), D_, T_}; const bf16_t* Bt = lw(p.ws, l, LW_WOUT); const EpiResid epi{p.out, p.out, 1.0f};
  for (int t = blockIdx.x; t < 128 * 8; t += gridDim.x) { const int nt = t & 7, mt = t >> 3; gemm_tile(p.tid, al, Bt, D_, D_, D_, mt * 128, nt * 128, epi, smem); }
}
DI void phase_ln(const Ctx& p, int l, int j, bool zero_o) {
  const int lane = p.tid & 63, wave = p.tid >> 6; const float* gp = p.ln_g + (size_t)(l * 3 + j) * D_; const float* bp = p.ln_b + (size_t)(l * 3 + j) * D_;
  bf16_t* xb = (bf16_t*)(p.ws + OFF_XB);
  for (int t = blockIdx.x; t < T_ / 4; t += gridDim.x) {
    const int row = t * 4 + wave; float* yr = p.out + (size_t)row * D_; f32x4 v[4]; float s = 0.f;
#pragma unroll
    for (int i = 0; i < 4; ++i) { v[i] = *(const f32x4*)(yr + i * 256 + lane * 4); s += (v[i][0] + v[i][1]) + (v[i][2] + v[i][3]); }
#pragma unroll
    for (int o = 1; o < 64; o <<= 1) s += __shfl_xor(s, o);
    const float mu = s * (1.f / D_); float q = 0.f;
#pragma unroll
    for (int i = 0; i < 4; ++i)
#pragma unroll
      for (int e = 0; e < 4; ++e) { const float d = v[i][e] - mu; q += d * d; }
#pragma unroll
    for (int o = 1; o < 64; o <<= 1) q += __shfl_xor(q, o);
    const float rstd = rsqrtf(q * (1.f / D_) + 1e-5f);
#pragma unroll
    for (int i = 0; i < 4; ++i) { const int c = i * 256 + lane * 4; const f32x4 gg = *(const f32x4*)(gp + c), bb = *(const f32x4*)(bp + c); f32x4 r;
#pragma unroll
      for (int e = 0; e < 4; ++e) r[e] = (v[i][e] - mu) * rstd * gg[e] + bb[e];
      *(f32x4*)(yr + c) = r; u32x2 w; w[0] = pk2(r[0], r[1]); w[1] = pk2(r[2], r[3]); *(u32x2*)(xb + (size_t)row * D_ + c) = w; }
  }
}
DI void phase_win(const Ctx& p, int l, char* smem) {
  const ALin al{(const bf16_t*)(p.ws + OFF_XB), D_, T_}; const bf16_t* Bt = lw(p.ws, l, LW_WIN);
  const EpiProj epi{(bf16_t*)(p.ws + OFF_BIG), (bf16_t*)(p.ws + OFF_KA), (const float*)(p.ws + OFF_C64), (const float*)(p.ws + OFF_S64), (const float*)(p.ws + OFF_C32), (const float*)(p.ws + OFF_S32)};
  for (int t = blockIdx.x; t < 128 * 25; t += gridDim.x) { const int nt = t % 25, mt = t / 25; gemm_tile(p.tid, al, Bt, D_, PW, D_, mt * 128, nt * 128, epi, smem); }
}

DI int next_item(const int tid, unsigned* ctr, char* smem) {
  int* slot = (int*)(smem + 69632 - 16);
  __syncthreads();
  if (tid == 0) *slot = (int)atomicAdd(ctr, 1u);
  __syncthreads();
  return *slot;
}

DI void item_dilated(const Ctx& p, int id, char* smem) {
  const int pat = id / 768, r1 = id % 768, b = r1 / 384, r2 = r1 % 384, h = r2 >> 6, blk = r2 & 63;
  const int dil = pat == 0 ? 1 : (pat == 1 ? 4 : 16), nsub = 64 / dil, rho = blk / nsub, i = blk % nsub;
  const bf16_t* proj = (const bf16_t*)(p.ws + OFF_BIG); const bf16_t* base = proj + (size_t)(b * S_ + rho) * PW; const long rs = (long)dil * PW;
  bf16_t* dst = (bf16_t*)(p.ws + OFF_DILO) + ((size_t)pat * T_ + b * S_ + rho + (size_t)dil * 128 * i) * 384 + h * 64;
  float* lse = (float*)(p.ws + OFF_DILL) + ((size_t)pat * T_ + b * S_ + rho + (size_t)dil * 128 * i) * 6 + h;
  const OutSet out{dst, (long)dil * 384, nullptr, 0, lse, (long)dil * 6}; float mm[2], ll[2];
  attn_core<64, 1>(p.tid, base + C_DQ + h * 64, rs, base + C_DK + h * 64, rs, base + C_DV + h * 64, rs, 128 * i, 128 * i - 128, S_ / dil - 1, 4, nullptr,
                   0.125f * 1.44269504089f, 128, nullptr, nullptr, false, mm, ll, out, smem);
}
DI void item_nsawin(const Ctx& p, int id, char* smem) {
  const int b = id / 384, r = id % 384, h = r >> 6, i = r & 63, g = h / 3;
  const bf16_t* proj = (const bf16_t*)(p.ws + OFF_BIG); const bf16_t* base = proj + (size_t)(b * S_) * PW;
  bf16_t* o = (bf16_t*)(p.ws + OFF_XB) + (size_t)(b * S_ + 128 * i) * D_ + 640 + h * 64;
  const OutSet out{o, D_, base + (size_t)(128 * i) * PW + C_GL + h * 3 + 2, PW, nullptr, 0}; float mm[2], ll[2];
  attn_core<64, 1>(p.tid, base + C_NQR + h * 64, PW, base + C_KW + g * 64, PW, base + C_VW + g * 64, PW, 128 * i, 128 * i - 512, S_ - 1, 10, nullptr,
                   0.125f * 1.44269504089f, 512, nullptr, nullptr, false, mm, ll, out, smem);
}
DI void item_expand(const Ctx& p, int l, int id, char* smem) {
  const bf16_t* proj = (const bf16_t*)(p.ws + OFF_BIG); float* rs = (float*)(smem + 65536);
  const bool isq = id < 384; const int lid = isq ? id : id - 384; const int mt = isq ? lid / 3 : lid >> 2, nt = isq ? lid % 3 : lid & 3;
  const int K = isq ? 256 : 128, cb = isq ? C_CQ : C_CKV, tid = p.tid;
  { const int row = tid >> 1, half = tid & 1; const bf16_t* rp = proj + (size_t)(mt * 128 + row) * PW + cb + half * (K / 2); float ss = 0.f;
    for (int c = 0; c < K / 2; c += 8) { const u32x4 w = *(const u32x4*)(rp + c);
#pragma unroll
      for (int e = 0; e < 4; ++e) { const float a = __uint_as_float(w[e] << 16), b2 = __uint_as_float(w[e] & 0xffff0000u); ss += a * a + b2 * b2; } }
    ss += __shfl_xor(ss, 1); if (half == 0) rs[row] = rsqrtf(ss / (float)K + 1e-6f); }
  __syncthreads();
  const ALin al{proj + cb, PW, T_};
  if (isq) { const EpiMLAq epi{(bf16_t*)(p.ws + OFF_QA), rs, mt * 128, (const float*)(p.ws + OFF_C32), (const float*)(p.ws + OFF_S32)};
    gemm_tile(p.tid, al, lw(p.ws, l, LW_UQ), 256, 384, 256, mt * 128, nt * 128, epi, smem); }
  else { const EpiMLAkv epi{(bf16_t*)(p.ws + OFF_KA), (bf16_t*)(p.ws + OFF_VA), rs, mt * 128};
    gemm_tile(p.tid, al, lw(p.ws, l, LW_UKV), 128, 512, 128, mt * 128, nt * 128, epi, smem); }
}
DI void item_cmp1(const Ctx& p, int l, int id, char* smem) {
  const int kv = id >> 5, mt = (id >> 1) & 15, nt = id & 1; const ACmp al{(const bf16_t*)(p.ws + OFF_BIG), kv ? C_VC : C_KC};
  const EpiCmp1 epi{(bf16_t*)(p.ws + OFF_CHID) + (size_t)kv * 2048 * 256, (const float*)(p.ws + OFF_CBIAS) + (l * 2 + kv) * 256};
  gemm_tile(p.tid, al, lw(p.ws, l, LW_C1 + kv * SZ_C1), 2048, 256, 2048, mt * 128, nt * 128, epi, smem);
}
DI void item_cmp2(const Ctx& p, int l, int id, char* smem) {
  const int kv = id >> 4, mt = id & 15; const ALin al{(const bf16_t*)(p.ws + OFF_CHID) + (size_t)kv * 2048 * 256, 256, 2048};
  const EpiCmp2 epi{(bf16_t*)(p.ws + OFF_KCVC) + (size_t)kv * 2048 * 64};
  gemm_tile(p.tid, al, lw(p.ws, l, LW_C2 + kv * SZ_C2), 256, 64, 256, mt * 128, 0, epi, smem);
}
DI void item_mla(const Ctx& p, int id, char* smem) {
  const int i = 63 - (id >> 3), bh = id & 7, b = bh >> 2, h = bh & 3;
  const bf16_t* qa = (const bf16_t*)(p.ws + OFF_QA) + (size_t)(b * S_) * 384 + h * 96; const bf16_t* ka = (const bf16_t*)(p.ws + OFF_KA) + (size_t)(b * S_) * 384 + h * 96;
  const bf16_t* va = (const bf16_t*)(p.ws + OFF_VA) + (size_t)(b * S_) * 256 + h * 64;
  bf16_t* o = (bf16_t*)(p.ws + OFF_XB) + (size_t)(b * S_ + 128 * i) * D_ + h * 64; const OutSet out{o, D_, nullptr, 0, nullptr, 0}; float mm[2], ll[2];
  attn_core<96, 0>(p.tid, qa, 384, ka, 384, va, 256, 128 * i, 0, S_ - 1, 2 * (i + 1), nullptr, 0.10206207261f * 1.44269504089f, 0, nullptr, nullptr, false, mm, ll, out, smem);
}
DI void item_nsacmp(const Ctx& p, int id, char* smem) {
  const int i = 63 - (id >> 2), bg = id & 3, b = bg >> 1, g = bg & 1, tid = p.tid;
  const bf16_t* proj = (const bf16_t*)(p.ws + OFF_BIG); const bf16_t* base = proj + (size_t)(b * S_) * PW;
  const bf16_t* kc = (const bf16_t*)(p.ws + OFF_KCVC) + (size_t)((b * 2 + g) * NCMP) * 64; const bf16_t* vc = kc + (size_t)2048 * 64;
  float* imp = (float*)(p.ws + OFF_IMP) + ((size_t)((b * 2 + g) * S_) + 128 * i) * 128;
  const int nkt = (i + 8) >> 3;
#pragma unroll 1
  for (int hh = 0; hh < 3; ++hh) { const int h = g * 3 + hh; float mm[2], ll[2];
    bf16_t* o = (bf16_t*)(p.ws + OFF_XB) + (size_t)(b * S_ + 128 * i) * D_ + 640 + h * 64;
    const OutAdd out{o, D_, base + (size_t)(128 * i) * PW + C_GL + h * 3 + 0, PW};
    attn_core<64, 2>(p.tid, base + C_NQ + h * 64, PW, kc, 64, vc, 64, 128 * i, 0, NCMP - 1, nkt, nullptr, 0.125f * 1.44269504089f, 0, nullptr, nullptr, false, mm, ll, out, smem);
    attn_core<64, 3>(p.tid, base + C_NQ + h * 64, PW, kc, 64, vc, 64, 128 * i, 0, NCMP - 1, nkt, nullptr, 0.125f * 1.44269504089f, 0, nullptr, imp, hh == 0, mm, ll, out, smem);
  }
  __syncthreads();
  float* sc = (float*)smem;
  const int q = tid >> 1, half = tid & 1, qpos = 128 * i + q, cur = qpos >> 6;
#pragma unroll 2
  for (int j = half * 64; j < half * 64 + 64; ++j) { const float v = (j < nkt * 16) ? imp[(size_t)q * 128 + j] : 0.f; const bool forced = (j == 0) || (j == cur) || (j == cur - 1);
    sc[q * 129 + j] = forced ? 1e4f : (j <= cur ? v : -1e4f); }
  unsigned m0 = 0, m1 = 0, m2 = 0, m3 = 0;
#pragma unroll 1
  for (int rd = 0; rd < 16; ++rd) {
    float bv = -3e38f; int bj = half * 64;
#pragma unroll 4
    for (int j = half * 64; j < half * 64 + 64; ++j) { const float v = sc[q * 129 + j]; if (v > bv) { bv = v; bj = j; } }
    const float ov = __shfl_xor(bv, 1); const int oj = __shfl_xor(bj, 1);
    if (ov > bv || (ov == bv && oj < bj)) { bv = ov; bj = oj; }
    if ((bj >> 6) == half) sc[q * 129 + bj] = -3.2e38f;
    if (bj <= cur) { const unsigned bit = 1u << (bj & 31); const int w = bj >> 5; m0 |= (w == 0) ? bit : 0u; m1 |= (w == 1) ? bit : 0u; m2 |= (w == 2) ? bit : 0u; m3 |= (w == 3) ? bit : 0u; }
  }
  if (half == 0) { u32x4 w; w[0] = m0; w[1] = m1; w[2] = m2; w[3] = m3; *(u32x4*)((unsigned*)(p.ws + OFF_SEL) + ((size_t)(b * S_ + qpos) * 2 + g) * 4) = w; }
  __syncthreads();
}
DI void item_dilcombine(const Ctx& p, int id) {
  const size_t e = (size_t)id * 256 + p.tid; const int tok = (int)(e / 48), r = (int)(e % 48), h = r >> 3, d0 = (r & 7) * 8;
  const float* L = (const float*)(p.ws + OFF_DILL); const bf16_t* O = (const bf16_t*)(p.ws + OFF_DILO);
  const float l0 = L[(size_t)tok * 6 + h], l1 = L[((size_t)T_ + tok) * 6 + h], l2 = L[((size_t)2 * T_ + tok) * 6 + h]; const float mx = fmaxf(l0, fmaxf(l1, l2));
  float w0 = __expf(l0 - mx), w1 = __expf(l1 - mx), w2 = __expf(l2 - mx); const float inv = 1.f / (w0 + w1 + w2); w0 *= inv; w1 *= inv; w2 *= inv;
  const u32x4 a = *(const u32x4*)(O + (size_t)tok * 384 + h * 64 + d0), b = *(const u32x4*)(O + ((size_t)T_ + tok) * 384 + h * 64 + d0), c = *(const u32x4*)(O + ((size_t)2 * T_ + tok) * 384 + h * 64 + d0);
  u32x4 w;
#pragma unroll
  for (int k = 0; k < 4; ++k) { const float lo = w0 * __uint_as_float(a[k] << 16) + w1 * __uint_as_float(b[k] << 16) + w2 * __uint_as_float(c[k] << 16);
    const float hi = w0 * __uint_as_float(a[k] & 0xffff0000u) + w1 * __uint_as_float(b[k] & 0xffff0000u) + w2 * __uint_as_float(c[k] & 0xffff0000u); w[k] = pk2(lo, hi); }
  *(u32x4*)((bf16_t*)(p.ws + OFF_XB) + (size_t)tok * D_ + 256 + h * 64 + d0) = w;
}
DI void item_nsaslc(const Ctx& p, int id, char* smem) {
  const int i = 63 - id / 12, r = id % 12, b = r / 6, h = r % 6, g = h / 3, tid = p.tid;
  const bf16_t* proj = (const bf16_t*)(p.ws + OFF_BIG); const bf16_t* base = proj + (size_t)(b * S_) * PW;
  unsigned* selw = (unsigned*)(smem + 49152 + 2048); int* tlist = (int*)(smem + 49152); unsigned* un = (unsigned*)(smem + 49152 + 1024);
  __syncthreads();
  if (tid < 4) un[tid] = 0u;
  __syncthreads();
  if (tid < 128) { const u32x4 w = *(const u32x4*)((const unsigned*)(p.ws + OFF_SEL) + ((size_t)(b * S_ + 128 * i + tid) * 2 + g) * 4);
    selw[tid * 4 + 0] = w[0]; selw[tid * 4 + 1] = w[1]; selw[tid * 4 + 2] = w[2]; selw[tid * 4 + 3] = w[3];
    atomicOr(&un[0], w[0]); atomicOr(&un[1], w[1]); atomicOr(&un[2], w[2]); atomicOr(&un[3], w[3]); }
  __syncthreads();
  if (tid == 0) { int n = 0; for (int jt = 0; jt < 2 * (i + 1); ++jt) if ((un[jt >> 5] >> (jt & 31)) & 1u) tlist[n++] = jt; tlist[255] = n; }
  __syncthreads();
  const int nt = tlist[255];
  bf16_t* o = (bf16_t*)(p.ws + OFF_XB) + (size_t)(b * S_ + 128 * i) * D_ + 640 + h * 64;
  const OutAdd out{o, D_, base + (size_t)(128 * i) * PW + C_GL + h * 3 + 1, PW}; float mm[2], ll[2];
  attn_core<64, 4>(p.tid, base + C_NQR + h * 64, PW, base + C_KSL + g * 64, PW, base + C_VSL + g * 64, PW, 128 * i, 0, S_ - 1, nt, tlist, 0.125f * 1.44269504089f, 0, selw, nullptr, false, mm, ll, out, smem);
}

DI void phase_mix_a(const Ctx& p0, int l, char* smem) {
  unsigned* ctr = (unsigned*)(p0.ws + OFF_CTRL) + l * 8 + 0; const int total = 768 + 2304 + 896 + 64;
  for (;;) { Ctx q = p0; asm volatile("" : "+v"(q.tid)); const Ctx& p = q; const int t = next_item(p.tid, ctr, smem); if (t >= total) break;
    if (t < 768) item_nsawin(p, t, smem); else if (t < 768 + 2304) item_dilated(p, t - 768, smem);
    else if (t < 768 + 2304 + 896) item_expand(p, l, t - 768 - 2304, smem); else item_cmp1(p, l, t - 768 - 2304 - 896, smem); }
}
DI void phase_mix_b(const Ctx& p0, int l, char* smem) {
  unsigned* ctr = (unsigned*)(p0.ws + OFF_CTRL) + l * 8 + 1; const int total = 512 + 32;
  for (;;) { Ctx q = p0; asm volatile("" : "+v"(q.tid)); const Ctx& p = q; const int t = next_item(p.tid, ctr, smem); if (t >= total) break; if (t < 512) item_mla(p, t, smem); else item_cmp2(p, l, t - 512, smem); }
}
DI void phase_mix_c(const Ctx& p0, int l, char* smem) {
  unsigned* ctr = (unsigned*)(p0.ws + OFF_CTRL) + l * 8 + 2; const int total = 256 + 3072;
  for (;;) { Ctx q = p0; asm volatile("" : "+v"(q.tid)); const Ctx& p = q; const int t = next_item(p.tid, ctr, smem); if (t >= total) break; if (t < 256) item_nsacmp(p, t, smem); else item_dilcombine(p, t - 256); }
}
DI void phase_mix_d(const Ctx& p0, int l, char* smem) {
  unsigned* ctr = (unsigned*)(p0.ws + OFF_CTRL) + l * 8 + 3; const int total = 768;
  for (;;) { Ctx q = p0; asm volatile("" : "+v"(q.tid)); const Ctx& p = q; const int t = next_item(p.tid, ctr, smem); if (t >= total) break; item_nsaslc(p, t, smem); }
}
DI void phase_zero_o(const Ctx& p) {
  u32x4* o = (u32x4*)(p.ws + OFF_XB); const u32x4 z = (u32x4){0u, 0u, 0u, 0u};
  for (size_t e = (size_t)blockIdx.x * 256 + p.tid; e < (size_t)T_ * D_ / 8; e += (size_t)gridDim.x * 256) o[e] = z;
}

DI void run_phase(const Params& P, int ph, char* smem) {
  Ctx p; p.x = P.x; p.ln_g = P.ln_g; p.ln_b = P.ln_b; p.cmp_pos = P.cmp_pos; p.cmp_w1 = P.cmp_w1; p.out = P.out; p.ws = P.ws; p.tid = threadIdx.x;
  asm volatile("" : "+v"(p.tid));
  if (ph == 0) { phase_prologue(P, p, smem); return; }
  const int l = (ph - 1) / 13; int s = (ph - 1) % 13;
#ifdef ONLY_S
  if (s != ONLY_S) return;
  s = ONLY_S;
#endif
  switch (s) {
    case 0: phase_ffn_up(p, l, 0, smem); break;
    case 1: phase_ffn_down(p, l, 0, smem); break;
    case 2: phase_ln(p, l, 0, false); break;
#if ENABLE_MIX
    case 3: phase_win(p, l, smem); break;
    case 4: phase_mix_a(p, l, smem); break;
    case 5: phase_mix_b(p, l, smem); break;
    case 6: phase_mix_c(p, l, smem); break;
    case 7: phase_mix_d(p, l, smem); break;
#else
    case 3: phase_zero_o(p); break;
    case 4: case 5: case 6: case 7: break;
#endif
    case 8: phase_wout(p, l, smem); break;
    case 9: phase_ln(p, l, 1, false); break;
    case 10: phase_ffn_up(p, l, 1, smem); break;
    case 11: phase_ffn_down(p, l, 1, smem); break;
    case 12: phase_ln(p, l, 2, false); break;
  }
}
constexpr int NPHASE = 27;

#if ONE_LAUNCH
DI void grid_bar(const Params& P, unsigned idx) {
  __syncthreads();
  int t = threadIdx.x; asm volatile("" : "+v"(t));
  if (t == 0) {
    unsigned* bar = (unsigned*)(P.ws + OFF_CTRL + 1024);
    __threadfence();
    __hip_atomic_fetch_add(bar, 1u, __ATOMIC_RELAXED, __HIP_MEMORY_SCOPE_AGENT);
    const unsigned target = idx * gridDim.x;
    while (__hip_atomic_load(bar, __ATOMIC_RELAXED, __HIP_MEMORY_SCOPE_AGENT) < target) __builtin_amdgcn_s_sleep(1);
    __threadfence();
  }
  __syncthreads();
}
template <int PH> DI void run_all(const Params& p, char* smem) {
  run_phase(p, PH, smem);
  if constexpr (PH + 1 < NPHASE) { grid_bar(p, PH + 1); run_all<PH + 1>(p, smem); }
}
__global__ void __launch_bounds__(256, 2) mega_kernel(Params p) {
  __shared__ __attribute__((aligned(16))) char smem[69632];
  cg::this_grid().sync();
  run_all<0>(p, smem);
}
#define MAIN_KERNEL mega_kernel
#else
#define MAIN_KERNEL phase_kernel
#endif
__global__ void __launch_bounds__(256, 2) phase_kernel(Params p, int ph) {
  __shared__ __attribute__((aligned(16))) char smem[69632];
  run_phase(p, ph, smem);
}

extern "C" void kernel_launch(void* const* d_in, const int* in_sizes, int n_in, void* d_out, int out_size, void* d_ws, size_t ws_size, hipStream_t stream) {
  static int grid_blocks = 0;
  if (!grid_blocks) { int dev = 0, cus = 0, per_cu = 0; hipGetDevice(&dev); hipDeviceGetAttribute(&cus, hipDeviceAttributeMultiprocessorCount, dev);
    hipOccupancyMaxActiveBlocksPerMultiprocessor(&per_cu, MAIN_KERNEL, 256, 0); if (per_cu > 2) per_cu = 2; if (per_cu < 1) per_cu = 1; grid_blocks = cus * per_cu; }
  if (ws_size < OFF_END) { fprintf(stderr, "workspace too small: %zu < %zu\n", ws_size, (size_t)OFF_END); return; }
  Params p; memset(&p, 0, sizeof(p));
  const float* x = (const float*)d_in[0]; const float* ffn_in = (const float*)d_in[1]; const float* ffn_out = (const float*)d_in[2];
  const float* w_in = (const float*)d_in[5]; const float* w_out = (const float*)d_in[6]; const float* qn = (const float*)d_in[7]; const float* kvn = (const float*)d_in[8];
  const float* wuq = (const float*)d_in[9]; const float* wukv = (const float*)d_in[10]; const float* cw1 = (const float*)d_in[12]; const float* cw2 = (const float*)d_in[13];
  p.x = x; p.ln_g = (const float*)d_in[3]; p.ln_b = (const float*)d_in[4]; p.cmp_pos = (const float*)d_in[11]; p.cmp_w1 = cw1; p.out = (float*)d_out; p.ws = (char*)d_ws;
  int tile0 = 0, di = 0;
  auto add = [&](const float* src, size_t dst_off, const float* ksc, int K, int Nsrc, int Ndst, int map) {
    WDesc& d = p.wd[di++]; d.src = src; d.dst = (bf16_t*)((char*)d_ws + dst_off); d.kscale = ksc; d.K = K; d.Nsrc = Nsrc; d.Ndst = Ndst; d.map = map; d.tile0 = tile0; d.ntn = Ndst / 64;
    tile0 += (Ndst / 64) * (K / 64); };
  for (int l = 0; l < 2; ++l) { const size_t wb = OFF_W + (size_t)l * LW_SIZE;
    for (int j = 0; j < 2; ++j) add(ffn_in + (size_t)(l * 2 + j) * 1024 * 5632, wb + LW_FIN + j * SZ_FIN, nullptr, 1024, 5632, 5632, 1);
    for (int j = 0; j < 2; ++j) add(ffn_out + (size_t)(l * 2 + j) * 2816 * 1024, wb + LW_FOUT + j * SZ_FOUT, nullptr, 2816, 1024, 1024, 0);
    add(w_in + (size_t)l * 1024 * 2738, wb + LW_WIN, nullptr, 1024, 2738, PW, 2);
    add(w_out + (size_t)l * 1024 * 1024, wb + LW_WOUT, nullptr, 1024, 1024, 1024, 0);
    add(wuq + (size_t)l * 256 * 384, wb + LW_UQ, qn + l * 256, 256, 384, 384, 0);
    add(wukv + (size_t)l * 128 * 512, wb + LW_UKV, kvn + l * 128, 128, 512, 512, 0);
    for (int kv = 0; kv < 2; ++kv) add(cw1 + (size_t)(l * 2 + kv) * 2048 * 256, wb + LW_C1 + kv * SZ_C1, nullptr, 2048, 256, 256, 0);
    for (int kv = 0; kv < 2; ++kv) add(cw2 + (size_t)(l * 2 + kv) * 256 * 64, wb + LW_C2 + kv * SZ_C2, nullptr, 256, 64, 64, 0);
  }
  p.n_wtiles = tile0;
  hipMemsetAsync((char*)d_ws + OFF_CTRL, 0, 4096, stream);
#if ONE_LAUNCH
  void* args[] = {&p};
  hipError_t e = hipLaunchCooperativeKernel((void*)mega_kernel, dim3(grid_blocks), dim3(256), args, 0, stream);
  if (e != hipSuccess) fprintf(stderr, "cooperative launch failed: %s (grid %d)\n", hipGetErrorString(e), grid_blocks);
#else
  for (int ph = 0; ph < NPHASE; ++ph) phase_kernel<<<dim3(grid_blocks), dim3(256), 0, stream>>>(p, ph);
#endif
}
```

```cpp
#include <hip/hip_runtime.h>
#include <hip/hip_cooperative_groups.h>
#include <cstdio>
#include <cstdint>
#include <cstring>
namespace cg = cooperative_groups;

typedef unsigned short bf16_t;
typedef short bf16x8 __attribute__((ext_vector_type(8)));
typedef short s16x4 __attribute__((ext_vector_type(4)));
typedef float f32x4 __attribute__((ext_vector_type(4)));
typedef unsigned u32x4 __attribute__((ext_vector_type(4)));
typedef unsigned u32x2 __attribute__((ext_vector_type(2)));
#define DI __device__ __forceinline__
#define LDSP(T, p) ((__attribute__((address_space(3))) T*)(p))

#ifndef ENABLE_MIX
#define ENABLE_MIX 1
#endif
#ifndef ONE_LAUNCH
#define ONE_LAUNCH 1
#endif

constexpr int T_ = 16384, S_ = 8192, D_ = 1024, F_ = 2816, PW = 3200;
constexpr float ALPHA = 1.41421356237f;
constexpr int C_CQ = 0, C_CKV = 256, C_DQ = 384, C_DK = 768, C_DV = 1152, C_NQ = 1536, C_NQR = 1920, C_KC = 2304, C_VC = 2432,
              C_KSL = 2560, C_VSL = 2688, C_KW = 2816, C_VW = 2944, C_KPE = 3072, C_GL = 3104;
constexpr int NCMP = 511;

constexpr size_t SZ_FIN = 5632ull * 1024 * 2, SZ_FOUT = 1024ull * 2816 * 2, SZ_WIN = (size_t)PW * 1024 * 2, SZ_WOUT = 1024ull * 1024 * 2,
                 SZ_UQ = 384ull * 256 * 2, SZ_UKV = 512ull * 128 * 2, SZ_C1 = 256ull * 2048 * 2, SZ_C2 = 64ull * 256 * 2;
constexpr size_t LW_FIN = 0, LW_FOUT = LW_FIN + 2 * SZ_FIN, LW_WIN = LW_FOUT + 2 * SZ_FOUT, LW_WOUT = LW_WIN + SZ_WIN, LW_UQ = LW_WOUT + SZ_WOUT,
                 LW_UKV = LW_UQ + SZ_UQ, LW_C1 = LW_UKV + SZ_UKV, LW_C2 = LW_C1 + 2 * SZ_C1, LW_SIZE = LW_C2 + 2 * SZ_C2;
constexpr size_t OFF_CTRL = 0, OFF_C64 = 16384, OFF_S64 = OFF_C64 + 8192ull * 32 * 4, OFF_C32 = OFF_S64 + 8192ull * 32 * 4, OFF_S32 = OFF_C32 + 8192ull * 16 * 4,
                 OFF_CBIAS = OFF_S32 + 8192ull * 16 * 4, OFF_W = OFF_CBIAS + 4096, OFF_XB = OFF_W + 2 * LW_SIZE, OFF_BIG = OFF_XB + (size_t)T_ * D_ * 2,
                 OFF_QA = OFF_BIG + (size_t)T_ * PW * 2, OFF_KA = OFF_QA + (size_t)T_ * 384 * 2, OFF_VA = OFF_KA + (size_t)T_ * 384 * 2,
                 OFF_DILO = OFF_VA + (size_t)T_ * 256 * 2, OFF_DILL = OFF_DILO + 3ull * T_ * 384 * 2, OFF_CHID = OFF_DILL + 3ull * T_ * 6 * 4,
                 OFF_KCVC = OFF_CHID + 2ull * 2048 * 256 * 2, OFF_SEL = OFF_KCVC + 2ull * 2048 * 64 * 2, OFF_IMP = OFF_SEL + (size_t)T_ * 2 * 4 * 4,
                 OFF_END = OFF_IMP + (size_t)T_ * 2 * 128 * 4;

struct WDesc { const float* src; bf16_t* dst; const float* kscale; int K, Nsrc, Ndst, map, tile0, ntn; };
struct Params {
  const float* x; const float* ln_g; const float* ln_b; const float* cmp_pos; const float* cmp_w1;
  float* out; char* ws;
  WDesc wd[24];
  int n_wtiles; int pad0;
};
struct Ctx { const float* x; const float* ln_g; const float* ln_b; const float* cmp_pos; const float* cmp_w1; float* out; char* ws; int tid; };

DI bf16_t f2bf(float x) { unsigned u = __float_as_uint(x); u += 0x7fffu + ((u >> 16) & 1u); return (bf16_t)(u >> 16); }
DI float bf2f(bf16_t v) { return __uint_as_float(((unsigned)v) << 16); }
DI unsigned pk2(float a, float b) { return (unsigned)f2bf(a) | ((unsigned)f2bf(b) << 16); }
DI float fast_exp2(float x) { return __builtin_amdgcn_exp2f(x); }
DI float silu(float v) { return v / (1.f + __expf(-v)); }
DI f32x4 mfma16(bf16x8 a, bf16x8 b, f32x4 c) { return __builtin_amdgcn_mfma_f32_16x16x32_bf16(a, b, c, 0, 0, 0); }

DI void sincos_rr(float ang, float& c, float& s) {
  const double rev = (double)ang * 0.15915494309189533577; const float fr = (float)(rev - rint(rev));
  c = __builtin_amdgcn_cosf(fr); s = __builtin_amdgcn_sinf(fr);
}

struct ALin { const bf16_t* A; int lda; int mmax; DI const bf16_t* ptr(int row, int k) const { row = row < mmax ? row : mmax - 1; return A + (size_t)row * lda + k; } };
struct ACmp {
  const bf16_t* proj; int colbase;
  DI const bf16_t* ptr(int m, int k) const { if (m > 2043) m = 2043; int b = m / 1022, rem = m - b * 1022, g = rem / 511, c = rem - g * 511;
    return proj + (size_t)(b * S_ + 16 * c + (k >> 6)) * PW + colbase + g * 64 + (k & 63); } };

template <class AL, class EPI>
DI void gemm_tile(const int tid, const AL al, const bf16_t* __restrict__ Bt, int ldb, int nvalid, int K, int m0, int n0, const EPI epi, char* smem) {
  const int lane = tid & 63, wave = tid >> 6, wr = wave >> 1, wc = wave & 1, g = lane >> 4;
  const int lrow = tid >> 3, lc = tid & 7;
  f32x4 acc[4][4];
#pragma unroll
  for (int i = 0; i < 4; ++i)
#pragma unroll
    for (int j = 0; j < 4; ++j) acc[i][j] = (f32x4){0.f, 0.f, 0.f, 0.f};
  u32x4 ra[4], rb[4];
  const bf16_t* bp[4];
#pragma unroll
  for (int i = 0; i < 4; ++i) { int r = n0 + lrow + 32 * i; r = r < nvalid ? r : nvalid - 1; bp[i] = Bt + (size_t)r * ldb + lc * 8; }
  const int soff = lrow * 128 + ((lc ^ (lrow & 7)) << 4);
  const int offA = (wr * 64 + (lane & 15)) * 128 + ((g ^ (lane & 7)) << 4);
  const int offB = (wc * 64 + (lane & 15)) * 128 + ((g ^ (lane & 7)) << 4);
  const int nk = K >> 6;
#pragma unroll
  for (int i = 0; i < 4; ++i) { ra[i] = *(const u32x4*)al.ptr(m0 + lrow + 32 * i, lc * 8); rb[i] = *(const u32x4*)(bp[i]); }
#pragma unroll
  for (int i = 0; i < 4; ++i) { *(u32x4*)(smem + soff + i * 4096) = ra[i]; *(u32x4*)(smem + 16384 + soff + i * 4096) = rb[i]; }
  __syncthreads();
  for (int kt = 0; kt < nk; ++kt) {
    const bool more = kt + 1 < nk;
    if (more) {
      const int k0 = (kt + 1) << 6;
#pragma unroll
      for (int i = 0; i < 4; ++i) { ra[i] = *(const u32x4*)al.ptr(m0 + lrow + 32 * i, k0 + lc * 8); rb[i] = *(const u32x4*)(bp[i] + k0); }
    }
    const char* sa = smem + (kt & 1) * 32768; const char* sb = sa + 16384;
#pragma unroll
    for (int ks = 0; ks < 2; ++ks) {
      bf16x8 af[4], bfr[4];
#pragma unroll
      for (int i = 0; i < 4; ++i) { af[i] = *(const bf16x8*)(sa + ((offA + i * 2048) ^ (ks << 6))); bfr[i] = *(const bf16x8*)(sb + ((offB + i * 2048) ^ (ks << 6))); }
#pragma unroll
      for (int i = 0; i < 4; ++i)
#pragma unroll
        for (int j = 0; j < 4; ++j) acc[i][j] = mfma16(af[i], bfr[j], acc[i][j]);
    }
    if (more) {
      char* da = smem + ((kt + 1) & 1) * 32768;
#pragma unroll
      for (int i = 0; i < 4; ++i) { *(u32x4*)(da + soff + i * 4096) = ra[i]; *(u32x4*)(da + 16384 + soff + i * 4096) = rb[i]; }
    }
    __syncthreads();
  }
  epi(acc, m0 + wr * 64, n0 + wc * 64, lane);
}

DI void store_plain(bf16_t* dst, int ld, const f32x4 (&acc)[4][4], int row0, int col0, int lane, float sc) {
#pragma unroll
  for (int mi = 0; mi < 4; ++mi)
#pragma unroll
    for (int r = 0; r < 4; ++r) { const int row = row0 + mi * 16 + (lane >> 4) * 4 + r;
#pragma unroll
      for (int ni = 0; ni < 4; ++ni) dst[(size_t)row * ld + col0 + ni * 16 + (lane & 15)] = f2bf(acc[mi][ni][r] * sc); }
}

struct EpiSwiGLU { bf16_t* H;
  DI void operator()(const f32x4 (&acc)[4][4], int row0, int col0, int lane) const {
#pragma unroll
    for (int mi = 0; mi < 4; ++mi)
#pragma unroll
      for (int r = 0; r < 4; ++r) { const int row = row0 + mi * 16 + (lane >> 4) * 4 + r;
#pragma unroll
        for (int pr = 0; pr < 2; ++pr) { const float gt = acc[mi][2 * pr][r], up = acc[mi][2 * pr + 1][r];
          H[(size_t)row * F_ + ((col0 >> 5) + pr) * 16 + (lane & 15)] = f2bf(silu(gt) * up); } }
  } };
struct EpiResid { const float* xin; float* y; float scale;
  DI void operator()(const f32x4 (&acc)[4][4], int row0, int col0, int lane) const {
#pragma unroll
    for (int mi = 0; mi < 4; ++mi)
#pragma unroll
      for (int r = 0; r < 4; ++r) { const int row = row0 + mi * 16 + (lane >> 4) * 4 + r;
#pragma unroll
        for (int ni = 0; ni < 4; ++ni) { const size_t ix = (size_t)row * D_ + col0 + ni * 16 + (lane & 15); y[ix] = ALPHA * xin[ix] + scale * acc[mi][ni][r]; } }
  } };
struct EpiProj { bf16_t* proj; bf16_t* ka; const float* c64; const float* s64; const float* c32; const float* s32;
  DI void operator()(const f32x4 (&acc)[4][4], int row0, int col0, int lane) const {
    const bool rope = (col0 >= C_DQ && col0 < C_DV) || (col0 >= C_NQR && col0 < C_KC) || (col0 >= C_KSL && col0 < C_VSL) || (col0 >= C_KW && col0 < C_VW);
    if (rope) {
#pragma unroll
      for (int mi = 0; mi < 4; ++mi)
#pragma unroll
        for (int r = 0; r < 4; ++r) { const int row = row0 + mi * 16 + (lane >> 4) * 4 + r, pos = row & (S_ - 1);
#pragma unroll
          for (int ni = 0; ni < 2; ++ni) { const int i = ni * 16 + (lane & 15); const float c = c64[pos * 32 + i], s = s64[pos * 32 + i];
            const float x1 = acc[mi][ni][r], x2 = acc[mi][ni + 2][r];
            proj[(size_t)row * PW + col0 + i] = f2bf(x1 * c - x2 * s); proj[(size_t)row * PW + col0 + 32 + i] = f2bf(x1 * s + x2 * c); } }
    } else if (col0 == C_KPE) {
#pragma unroll
      for (int mi = 0; mi < 4; ++mi)
#pragma unroll
        for (int r = 0; r < 4; ++r) { const int row = row0 + mi * 16 + (lane >> 4) * 4 + r, pos = row & (S_ - 1); const int i = lane & 15;
          const float c = c32[pos * 16 + i], s = s32[pos * 16 + i]; const float x1 = acc[mi][0][r], x2 = acc[mi][1][r];
          const bf16_t o1 = f2bf(x1 * c - x2 * s), o2 = f2bf(x1 * s + x2 * c);
#pragma unroll
          for (int h = 0; h < 4; ++h) { ka[(size_t)row * 384 + h * 96 + 64 + i] = o1; ka[(size_t)row * 384 + h * 96 + 80 + i] = o2; }
#pragma unroll
          for (int ni = 2; ni < 4; ++ni) { const float v = acc[mi][ni][r]; proj[(size_t)row * PW + col0 + ni * 16 + i] = f2bf(1.f / (1.f + __expf(-v))); } }
    } else store_plain(proj, PW, acc, row0, col0, lane, 1.f);
  } };
struct EpiMLAq { bf16_t* qa; const float* rs; int m0; const float* c32; const float* s32;
  DI void operator()(const f32x4 (&acc)[4][4], int row0, int col0, int lane) const {
#pragma unroll
    for (int mi = 0; mi < 4; ++mi)
#pragma unroll
      for (int r = 0; r < 4; ++r) { const int row = row0 + mi * 16 + (lane >> 4) * 4 + r, pos = row & (S_ - 1); const float sc = rs[row - m0]; const int i = lane & 15;
#pragma unroll
        for (int ch = 0; ch < 2; ++ch) { const int gc = col0 + 32 * ch; const float x1 = acc[mi][2 * ch][r] * sc, x2 = acc[mi][2 * ch + 1][r] * sc;
          if (((gc >> 5) % 3) == 2) { const float c = c32[pos * 16 + i], s = s32[pos * 16 + i];
            qa[(size_t)row * 384 + gc + i] = f2bf(x1 * c - x2 * s); qa[(size_t)row * 384 + gc + 16 + i] = f2bf(x1 * s + x2 * c); }
          else { qa[(size_t)row * 384 + gc + i] = f2bf(x1); qa[(size_t)row * 384 + gc + 16 + i] = f2bf(x2); } } }
  } };
struct EpiMLAkv { bf16_t* ka; bf16_t* va; const float* rs; int m0;
  DI void operator()(const f32x4 (&acc)[4][4], int row0, int col0, int lane) const {
    const int h = col0 >> 7, part = (col0 >> 6) & 1;
#pragma unroll
    for (int mi = 0; mi < 4; ++mi)
#pragma unroll
      for (int r = 0; r < 4; ++r) { const int row = row0 + mi * 16 + (lane >> 4) * 4 + r; const float sc = rs[row - m0];
#pragma unroll
        for (int ni = 0; ni < 4; ++ni) { const int j = ni * 16 + (lane & 15); const bf16_t v = f2bf(acc[mi][ni][r] * sc);
          if (part == 0) ka[(size_t)row * 384 + h * 96 + j] = v; else va[(size_t)row * 256 + h * 64 + j] = v; } }
  } };
struct EpiCmp1 { bf16_t* hid; const float* bias;
  DI void operator()(const f32x4 (&acc)[4][4], int row0, int col0, int lane) const {
#pragma unroll
    for (int mi = 0; mi < 4; ++mi)
#pragma unroll
      for (int r = 0; r < 4; ++r) { const int row = row0 + mi * 16 + (lane >> 4) * 4 + r;
#pragma unroll
        for (int ni = 0; ni < 4; ++ni) { const int col = col0 + ni * 16 + (lane & 15); hid[(size_t)row * 256 + col] = f2bf(silu(acc[mi][ni][r] + bias[col])); } }
  } };
struct EpiCmp2 { bf16_t* kc;
  DI void operator()(const f32x4 (&acc)[4][4], int row0, int col0, int lane) const {
    if (col0 >= 64) return;
#pragma unroll
    for (int mi = 0; mi < 4; ++mi)
#pragma unroll
      for (int r = 0; r < 4; ++r) { const int row = row0 + mi * 16 + (lane >> 4) * 4 + r;
        if (row < 2044) {
#pragma unroll
          for (int ni = 0; ni < 4; ++ni) kc[(size_t)row * 64 + col0 + ni * 16 + (lane & 15)] = f2bf(acc[mi][ni][r]); } }
  } };

template <int DQ, int MODE, class OUT>
DI void attn_core(const int tid, const bf16_t* __restrict__ Qb, long qs, const bf16_t* __restrict__ Kb, long kst, const bf16_t* __restrict__ Vb, long vst,
                  int q0, int k0, int kmax, int ntiles, const int* tlist, float sl2, int window,
                  const unsigned* selw, float* impg, bool first_head, float (&m_io)[2], float (&l_io)[2], const OUT out, char* smem) {
  constexpr int NKD = DQ / 32, CPR = DQ / 8, KST = (DQ == 64) ? 128 : 256, NKC = 64 * CPR / 256;
  const int lane = tid & 63, wave = tid >> 6, g = lane >> 4, li = lane & 15;
  bf16x8 qf[2][NKD];
#pragma unroll
  for (int qt = 0; qt < 2; ++qt)
#pragma unroll
    for (int kd = 0; kd < NKD; ++kd) qf[qt][kd] = *(const bf16x8*)(Qb + (long)(q0 + wave * 32 + qt * 16 + li) * qs + kd * 32 + g * 8);
  int qidx[2]; qidx[0] = q0 + wave * 32 + li; qidx[1] = qidx[0] + 16;
  f32x4 o[4][2];
#pragma unroll
  for (int i = 0; i < 4; ++i) { o[i][0] = (f32x4){0.f, 0.f, 0.f, 0.f}; o[i][1] = (f32x4){0.f, 0.f, 0.f, 0.f}; }
  float mrun[2], lrun[2], invl[2], prev3[2];
#pragma unroll
  for (int qt = 0; qt < 2; ++qt) { prev3[qt] = 0.f;
    if (MODE == 3) { mrun[qt] = m_io[qt]; lrun[qt] = 0.f; invl[qt] = l_io[qt] > 0.f ? 1.f / l_io[qt] : 0.f; } else { mrun[qt] = -1e30f; lrun[qt] = 0.f; invl[qt] = 0.f; } }
  u32x4 rk[NKC], rv[2];
  auto gload = [&](int jt) {
    const int kb = k0 + jt * 64;
#pragma unroll
    for (int i = 0; i < NKC; ++i) { const int id = tid + 256 * i, row = id / CPR, c = id - row * CPR; int ix = kb + row; ix = ix < 0 ? 0 : (ix > kmax ? kmax : ix);
      rk[i] = *(const u32x4*)(Kb + (long)ix * kst + c * 8); }
    if (MODE != 2) {
#pragma unroll
      for (int i = 0; i < 2; ++i) { const int id = tid + 256 * i, row = id >> 3, c = id & 7; int ix = kb + row; ix = ix < 0 ? 0 : (ix > kmax ? kmax : ix);
        rv[i] = *(const u32x4*)(Vb + (long)ix * vst + c * 8); }
    }
  };
  auto lstore = [&](int buf) {
    char* kbuf = smem + buf * 16384; char* vbuf = smem + 32768 + buf * 8192;
#pragma unroll
    for (int i = 0; i < NKC; ++i) { const int id = tid + 256 * i, row = id / CPR, c = id - row * CPR; *(u32x4*)(kbuf + row * KST + ((c ^ (row & 7)) << 4)) = rk[i]; }
    if (MODE != 2) {
#pragma unroll
      for (int i = 0; i < 2; ++i) { const int id = tid + 256 * i, row = id >> 3, c = id & 7;
        *(u32x4*)(vbuf + row * 128 + (((((c >> 1) ^ ((row >> 1) & 3)) << 1) | (c & 1)) << 4)) = rv[i]; }
    }
  };
  if (ntiles > 0) { gload(tlist ? tlist[0] : 0); lstore(0); }
  __syncthreads();
  for (int it = 0; it < ntiles; ++it) {
    const int jt = tlist ? tlist[it] : it;
    const bool more = it + 1 < ntiles;
    if (more) gload(tlist ? tlist[it + 1] : it + 1);
    const char* kbuf = smem + (it & 1) * 16384; const char* vbuf = smem + 32768 + (it & 1) * 8192;
    f32x4 st[4][2];
#pragma unroll
    for (int kt4 = 0; kt4 < 4; ++kt4) {
      bf16x8 kf[NKD]; const int row = kt4 * 16 + li;
#pragma unroll
      for (int kd = 0; kd < NKD; ++kd) kf[kd] = *(const bf16x8*)(kbuf + row * KST + (((kd * 4 + g) ^ (row & 7)) << 4));
#pragma unroll
      for (int qt = 0; qt < 2; ++qt) { f32x4 a = (f32x4){0.f, 0.f, 0.f, 0.f};
#pragma unroll
        for (int kd = 0; kd < NKD; ++kd) a = mfma16(kf[kd], qf[qt][kd], a);
        st[kt4][qt] = a; }
    }
    const int kbase = k0 + jt * 64;
    bool sb[2] = {true, true};
    if (MODE == 4) { sb[0] = (selw[(wave * 32 + li) * 4 + (jt >> 5)] >> (jt & 31)) & 1u; sb[1] = (selw[(wave * 32 + 16 + li) * 4 + (jt >> 5)] >> (jt & 31)) & 1u; }
    float alpha[2];
#pragma unroll
    for (int qt = 0; qt < 2; ++qt) {
      float mx = -1e30f;
#pragma unroll
      for (int kt4 = 0; kt4 < 4; ++kt4)
#pragma unroll
        for (int r = 0; r < 4; ++r) { const int kidx = kbase + kt4 * 16 + g * 4 + r; bool v;
          if (MODE == 0) v = kidx <= qidx[qt];
          else if (MODE == 1) v = (kidx >= 0) && (kidx <= qidx[qt]) && (qidx[qt] - kidx <= window);
          else if (MODE == 2 || MODE == 3) v = (kidx <= kmax) && (16 * kidx + 31 <= qidx[qt]);
          else v = (kidx <= qidx[qt]) && sb[qt];
          const float s = v ? st[kt4][qt][r] * sl2 : -1e30f; st[kt4][qt][r] = s; mx = fmaxf(mx, s); }
      if (MODE != 3) {
        mx = fmaxf(mx, __shfl_xor(mx, 16)); mx = fmaxf(mx, __shfl_xor(mx, 32));
        const float mn = fmaxf(mrun[qt], mx); alpha[qt] = fast_exp2(mrun[qt] - mn); mrun[qt] = mn;
      } else alpha[qt] = 1.f;
      float ls = 0.f;
#pragma unroll
      for (int kt4 = 0; kt4 < 4; ++kt4)
#pragma unroll
        for (int r = 0; r < 4; ++r) { const float s = st[kt4][qt][r]; float p = (s > -5e29f) ? fast_exp2(s - mrun[qt]) : 0.f; if (MODE == 3) p *= invl[qt]; st[kt4][qt][r] = p; ls += p; }
      lrun[qt] = lrun[qt] * alpha[qt] + ls;
    }
    if (MODE == 3) {
#pragma unroll
      for (int qt = 0; qt < 2; ++qt)
#pragma unroll
        for (int kt4 = 0; kt4 < 4; ++kt4) { const float p3 = st[kt4][qt][3]; const float a = (st[kt4][qt][0] + st[kt4][qt][1]) + (st[kt4][qt][2] + p3);
          const float give = (g == 3) ? prev3[qt] : p3; const float up = __shfl(give, (lane + 48) & 63); prev3[qt] = p3;
          float* ip = impg + (size_t)(wave * 32 + qt * 16 + li) * 128 + jt * 16 + kt4 * 4 + g; const float val = a + up;
          if (first_head) *ip = val; else *ip += val; }
    }
    if (MODE != 2) {
      if (MODE != 3) {
#pragma unroll
        for (int dt = 0; dt < 4; ++dt) { o[dt][0] *= alpha[0]; o[dt][1] *= alpha[1]; }
      }
#pragma unroll
      for (int ks2 = 0; ks2 < 2; ++ks2) {
        bf16x8 pf[2];
#pragma unroll
        for (int qt = 0; qt < 2; ++qt) { u32x4 w; w[0] = pk2(st[2 * ks2][qt][0], st[2 * ks2][qt][1]); w[1] = pk2(st[2 * ks2][qt][2], st[2 * ks2][qt][3]);
          w[2] = pk2(st[2 * ks2 + 1][qt][0], st[2 * ks2 + 1][qt][1]); w[3] = pk2(st[2 * ks2 + 1][qt][2], st[2 * ks2 + 1][qt][3]); pf[qt] = __builtin_bit_cast(bf16x8, w); }
        const int rowA = 32 * ks2 + 4 * g + (li >> 2), p_ = li & 3;
#pragma unroll
        for (int dt = 0; dt < 4; ++dt) {
          const int off = rowA * 128 + ((((dt ^ ((rowA >> 1) & 3)) << 1) | (p_ >> 1)) << 4) + 8 * (p_ & 1);
          const s16x4 lo = __builtin_amdgcn_ds_read_tr16_b64_v4i16(LDSP(s16x4, vbuf + off));
          const s16x4 hi = __builtin_amdgcn_ds_read_tr16_b64_v4i16(LDSP(s16x4, vbuf + off + 2048));
          const bf16x8 vf = __builtin_shufflevector(lo, hi, 0, 1, 2, 3, 4, 5, 6, 7);
          o[dt][0] = mfma16(vf, pf[0], o[dt][0]); o[dt][1] = mfma16(vf, pf[1], o[dt][1]);
        }
      }
    }
    if (more) lstore((it + 1) & 1);
    __syncthreads();
  }
#pragma unroll
  for (int qt = 0; qt < 2; ++qt) {
    float lt = lrun[qt]; lt += __shfl_xor(lt, 16); lt += __shfl_xor(lt, 32);
    if (MODE == 2) { m_io[qt] = mrun[qt]; l_io[qt] = lt; }
    else {
      const float inv = (MODE == 3) ? 1.f : (lt > 0.f ? 1.f / lt : 0.f);
#pragma unroll
      for (int dt = 0; dt < 4; ++dt) out(wave * 32 + qt * 16 + li, dt * 16 + g * 4, o[dt][qt] * inv, mrun[qt], lt);
    }
  }
}

struct OutSet { bf16_t* dst; long ld; const bf16_t* gate; long gld; float* lse; long lld;
  DI void operator()(int ql, int d0, f32x4 v, float m, float l) const {
    float gs = 1.f; if (gate) gs = bf2f(gate[ql * gld]);
    u32x2 w; w[0] = pk2(v[0] * gs, v[1] * gs); w[1] = pk2(v[2] * gs, v[3] * gs); *(u32x2*)(dst + ql * ld + d0) = w;
    if (lse && d0 == 0) lse[ql * lld] = (m + __log2f(l)) * 0.69314718056f;
  } };
struct OutAdd { bf16_t* dst; long ld; const bf16_t* gate; long gld;
  DI void operator()(int ql, int d0, f32x4 v, float m, float l) const {
    const float gs = bf2f(gate[ql * gld]); u32x2* p = (u32x2*)(dst + ql * ld + d0); const u32x2 old = *p;
    u32x2 w; w[0] = pk2(__uint_as_float(old[0] << 16) + v[0] * gs, __uint_as_float(old[0] & 0xffff0000u) + v[1] * gs);
    w[1] = pk2(__uint_as_float(old[1] << 16) + v[2] * gs, __uint_as_float(old[1] & 0xffff0000u) + v[3] * gs); *p = w;
  } };

DI bf16_t* lw(char* ws, int l, size_t off) { return (bf16_t*)(ws + OFF_W + (size_t)l * LW_SIZE + off); }

DI int colmap(int map, int n, int nsrc) {
  if (map == 0) return n < nsrc ? n : -1;
  if (map == 1) { const int t = n >> 5, i = n & 31; return i < 16 ? 16 * t + i : 2816 + 16 * t + (i - 16); }
  if (n < 384) return n;
  if (n < C_DV + 384) return 416 + (n - C_DQ);
  if (n < C_NQR) return 1568 + (n - C_NQ);
  if (n < C_KC) return 1568 + (n - C_NQR);
  if (n < C_KPE) return 1952 + (n - C_KC);
  if (n < C_GL) return 384 + (n - C_KPE);
  if (n < C_GL + 18) return 2720 + (n - C_GL);
  return -1;
}

DI void phase_prologue(const Params& P, const Ctx& p, char* smem) {
  const int tid = p.tid;
  const int n_w = P.n_wtiles, n_cb = 4, n_r64 = 256, n_r32 = 128, n_xb = 4096;
  const int total = n_w + n_cb + n_r64 + n_r32 + n_xb;
  for (int t = blockIdx.x; t < total; t += gridDim.x) {
    if (t < n_w) {
      int di = 0;
#pragma unroll 1
      for (int i = 1; i < 24; ++i) if (t >= P.wd[i].tile0) di = i;
      const WDesc d = P.wd[di]; const int lt = t - d.tile0, tn = lt % d.ntn, tk = lt / d.ntn, n0 = tn * 64, k0 = tk * 64;
      float* tile = (float*)smem;
      const int nn = tid & 63; const int sc = colmap(d.map, n0 + nn, d.Nsrc);
#pragma unroll 4
      for (int i = 0; i < 16; ++i) { const int kk = (tid >> 6) + 4 * i; float v = 0.f;
        if (sc >= 0) { v = d.src[(size_t)(k0 + kk) * d.Nsrc + sc]; if (d.kscale) v *= d.kscale[k0 + kk]; }
        tile[kk * 65 + nn] = v; }
      __syncthreads();
      { const int on = tid >> 2, kq = tid & 3; u32x4 w0, w1;
#pragma unroll
        for (int j = 0; j < 4; ++j) { w0[j] = pk2(tile[(kq * 16 + 2 * j) * 65 + on], tile[(kq * 16 + 2 * j + 1) * 65 + on]);
          w1[j] = pk2(tile[(kq * 16 + 8 + 2 * j) * 65 + on], tile[(kq * 16 + 8 + 2 * j + 1) * 65 + on]); }
        bf16_t* dp = d.dst + (size_t)(n0 + on) * d.K + k0 + kq * 16; *(u32x4*)dp = w0; *(u32x4*)(dp + 8) = w1; }
      __syncthreads();
    } else if (t < n_w + n_cb) {
      const int id = t - n_w; const float* pos = p.cmp_pos + (size_t)id * 2048; const float* w1 = p.cmp_w1 + (size_t)id * 2048 * 256; float a = 0.f;
      for (int k = 0; k < 2048; ++k) a += pos[k] * w1[(size_t)k * 256 + tid];
      ((float*)(p.ws + OFF_CBIAS))[id * 256 + tid] = a;
    } else if (t < n_w + n_cb + n_r64) {
      const int e0 = (t - n_w - n_cb) * 1024; float* C = (float*)(p.ws + OFF_C64); float* Sn = (float*)(p.ws + OFF_S64);
      for (int e = e0 + tid; e < e0 + 1024; e += 256) { const int pos = e >> 5, i = e & 31; const float inv = exp2f(-(float)(2 * i) / 64.f * 13.287712379549449f); const float ang = (float)pos * inv;
        sincos_rr(ang, C[e], Sn[e]); }
    } else if (t < n_w + n_cb + n_r64 + n_r32) {
      const int e0 = (t - n_w - n_cb - n_r64) * 1024; float* C = (float*)(p.ws + OFF_C32); float* Sn = (float*)(p.ws + OFF_S32);
      for (int e = e0 + tid; e < e0 + 1024; e += 256) { const int pos = e >> 4, i = e & 15; const float inv = exp2f(-(float)(2 * i) / 32.f * 13.287712379549449f); const float ang = (float)pos * inv;
        sincos_rr(ang, C[e], Sn[e]); }
    } else {
      const size_t e0 = (size_t)(t - n_w - n_cb - n_r64 - n_r32) * 4096 + tid * 16; bf16_t* xb = (bf16_t*)(p.ws + OFF_XB);
      const f32x4 a = *(const f32x4*)(p.x + e0), b = *(const f32x4*)(p.x + e0 + 4), c = *(const f32x4*)(p.x + e0 + 8), d = *(const f32x4*)(p.x + e0 + 12);
      u32x4 w0, w1; w0[0] = pk2(a[0], a[1]); w0[1] = pk2(a[2], a[3]); w0[2] = pk2(b[0], b[1]); w0[3] = pk2(b[2], b[3]);
      w1[0] = pk2(c[0], c[1]); w1[1] = pk2(c[2], c[3]); w1[2] = pk2(d[0], d[1]); w1[3] = pk2(d[2], d[3]);
      *(u32x4*)(xb + e0) = w0; *(u32x4*)(xb + e0 + 8) = w1;
    }
  }
}

DI void phase_ffn_up(const Ctx& p, int l, int j, char* smem) {
  const ALin al{(const bf16_t*)(p.ws + OFF_XB), D_, T_}; const bf16_t* Bt = lw(p.ws, l, LW_FIN + j * SZ_FIN); const EpiSwiGLU epi{(bf16_t*)(p.ws + OFF_BIG)};
  for (int t = blockIdx.x; t < 128 * 44; t += gridDim.x) { const int nt = t % 44, mt = t / 44; gemm_tile(p.tid, al, Bt, D_, 5632, D_, mt * 128, nt * 128, epi, smem); }
}
DI void phase_ffn_down(const Ctx& p, int l, int j, char* smem) {
  const ALin al{(const bf16_t*)(p.ws + OFF_BIG), F_, T_}; const bf16_t* Bt = lw(p.ws, l, LW_FOUT + j * SZ_FOUT);
  const EpiResid epi{(l == 0 && j == 0) ? p.x : p.out, p.out, 0.5f};
  for (int t = blockIdx.x; t < 128 * 8; t += gridDim.x) { const int nt = t & 7, mt = t >> 3; gemm_tile(p.tid, al, Bt, F_, D_, F_, mt * 128, nt * 128, epi, smem); }
}
DI void phase_wout(const Ctx& p, int l, char* smem) {
  const ALin al{(const bf16_t*)(p.ws + OFF_XB), D_, T_}; const bf16_t* Bt = lw(p.ws, l, LW_WOUT); const EpiResid epi{p.out, p.out, 1.0f};
  for (int t = blockIdx.x; t < 128 * 8; t += gridDim.x) { const int nt = t & 7, mt = t >> 3; gemm_tile(p.tid, al, Bt, D_, D_, D_, mt * 128, nt * 128, epi, smem); }
}
DI void phase_ln(const Ctx& p, int l, int j, bool zero_o) {
  const int lane = p.tid & 63, wave = p.tid >> 6; const float* gp = p.ln_g + (size_t)(l * 3 + j) * D_; const float* bp = p.ln_b + (size_t)(l * 3 + j) * D_;
  bf16_t* xb = (bf16_t*)(p.ws + OFF_XB);
  for (int t = blockIdx.x; t < T_ / 4; t += gridDim.x) {
    const int row = t * 4 + wave; float* yr = p.out + (size_t)row * D_; f32x4 v[4]; float s = 0.f;
#pragma unroll
    for (int i = 0; i < 4; ++i) { v[i] = *(const f32x4*)(yr + i * 256 + lane * 4); s += (v[i][0] + v[i][1]) + (v[i][2] + v[i][3]); }
#pragma unroll
    for (int o = 1; o < 64; o <<= 1) s += __shfl_xor(s, o);
    const float mu = s * (1.f / D_); float q = 0.f;
#pragma unroll
    for (int i = 0; i < 4; ++i)
#pragma unroll
      for (int e = 0; e < 4; ++e) { const float d = v[i][e] - mu; q += d * d; }
#pragma unroll
    for (int o = 1; o < 64; o <<= 1) q += __shfl_xor(q, o);
    const float rstd = rsqrtf(q * (1.f / D_) + 1e-5f);
#pragma unroll
    for (int i = 0; i < 4; ++i) { const int c = i * 256 + lane * 4; const f32x4 gg = *(const f32x4*)(gp + c), bb = *(const f32x4*)(bp + c); f32x4 r;
#pragma unroll
      for (int e = 0; e < 4; ++e) r[e] = (v[i][e] - mu) * rstd * gg[e] + bb[e];
      *(f32x4*)(yr + c) = r; u32x2 w; w[0] = pk2(r[0], r[1]); w[1] = pk2(r[2], r[3]); *(u32x2*)(xb + (size_t)row * D_ + c) = w; }
  }
}
DI void phase_win(const Ctx& p, int l, char* smem) {
  const ALin al{(const bf16_t*)(p.ws + OFF_XB), D_, T_}; const bf16_t* Bt = lw(p.ws, l, LW_WIN);
  const EpiProj epi{(bf16_t*)(p.ws + OFF_BIG), (bf16_t*)(p.ws + OFF_KA), (const float*)(p.ws + OFF_C64), (const float*)(p.ws + OFF_S64), (const float*)(p.ws + OFF_C32), (const float*)(p.ws + OFF_S32)};
  for (int t = blockIdx.x; t < 128 * 25; t += gridDim.x) { const int nt = t % 25, mt = t / 25; gemm_tile(p.tid, al, Bt, D_, PW, D_, mt * 128, nt * 128, epi, smem); }
}

DI int next_item(const int tid, unsigned* ctr, char* smem) {
  int* slot = (int*)(smem + 69632 - 16);
  __syncthreads();
  if (tid == 0) *slot = (int)atomicAdd(ctr, 1u);
  __syncthreads();
  return *slot;
}

DI void item_dilated(const Ctx& p, int id, char* smem) {
  const int pat = id / 768, r1 = id % 768, b = r1 / 384, r2 = r1 % 384, h = r2 >> 6, blk = r2 & 63;
  const int dil = pat == 0 ? 1 : (pat == 1 ? 4 : 16), nsub = 64 / dil, rho = blk / nsub, i = blk % nsub;
  const bf16_t* proj = (const bf16_t*)(p.ws + OFF_BIG); const bf16_t* base = proj + (size_t)(b * S_ + rho) * PW; const long rs = (long)dil * PW;
  bf16_t* dst = (bf16_t*)(p.ws + OFF_DILO) + ((size_t)pat * T_ + b * S_ + rho + (size_t)dil * 128 * i) * 384 + h * 64;
  float* lse = (float*)(p.ws + OFF_DILL) + ((size_t)pat * T_ + b * S_ + rho + (size_t)dil * 128 * i) * 6 + h;
  const OutSet out{dst, (long)dil * 384, nullptr, 0, lse, (long)dil * 6}; float mm[2], ll[2];
  attn_core<64, 1>(p.tid, base + C_DQ + h * 64, rs, base + C_DK + h * 64, rs, base + C_DV + h * 64, rs, 128 * i, 128 * i - 128, S_ / dil - 1, 4, nullptr,
                   0.125f * 1.44269504089f, 128, nullptr, nullptr, false, mm, ll, out, smem);
}
DI void item_nsawin(const Ctx& p, int id, char* smem) {
  const int b = id / 384, r = id % 384, h = r >> 6, i = r & 63, g = h / 3;
  const bf16_t* proj = (const bf16_t*)(p.ws + OFF_BIG); const bf16_t* base = proj + (size_t)(b * S_) * PW;
  bf16_t* o = (bf16_t*)(p.ws + OFF_XB) + (size_t)(b * S_ + 128 * i) * D_ + 640 + h * 64;
  const OutSet out{o, D_, base + (size_t)(128 * i) * PW + C_GL + h * 3 + 2, PW, nullptr, 0}; float mm[2], ll[2];
  attn_core<64, 1>(p.tid, base + C_NQR + h * 64, PW, base + C_KW + g * 64, PW, base + C_VW + g * 64, PW, 128 * i, 128 * i - 512, S_ - 1, 10, nullptr,
                   0.125f * 1.44269504089f, 512, nullptr, nullptr, false, mm, ll, out, smem);
}
DI void item_expand(const Ctx& p, int l, int id, char* smem) {
  const bf16_t* proj = (const bf16_t*)(p.ws + OFF_BIG); float* rs = (float*)(smem + 65536);
  const bool isq = id < 384; const int lid = isq ? id : id - 384; const int mt = isq ? lid / 3 : lid >> 2, nt = isq ? lid % 3 : lid & 3;
  const int K = isq ? 256 : 128, cb = isq ? C_CQ : C_CKV, tid = p.tid;
  { const int row = tid >> 1, half = tid & 1; const bf16_t* rp = proj + (size_t)(mt * 128 + row) * PW + cb + half * (K / 2); float ss = 0.f;
    for (int c = 0; c < K / 2; c += 8) { const u32x4 w = *(const u32x4*)(rp + c);
#pragma unroll
      for (int e = 0; e < 4; ++e) { const float a = __uint_as_float(w[e] << 16), b2 = __uint_as_float(w[e] & 0xffff0000u); ss += a * a + b2 * b2; } }
    ss += __shfl_xor(ss, 1); if (half == 0) rs[row] = rsqrtf(ss / (float)K + 1e-6f); }
  __syncthreads();
  const ALin al{proj + cb, PW, T_};
  if (isq) { const EpiMLAq epi{(bf16_t*)(p.ws + OFF_QA), rs, mt * 128, (const float*)(p.ws + OFF_C32), (const float*)(p.ws + OFF_S32)};
    gemm_tile(p.tid, al, lw(p.ws, l, LW_UQ), 256, 384, 256, mt * 128, nt * 128, epi, smem); }
  else { const EpiMLAkv epi{(bf16_t*)(p.ws + OFF_KA), (bf16_t*)(p.ws + OFF_VA), rs, mt * 128};
    gemm_tile(p.tid, al, lw(p.ws, l, LW_UKV), 128, 512, 128, mt * 128, nt * 128, epi, smem); }
}
DI void item_cmp1(const Ctx& p, int l, int id, char* smem) {
  const int kv = id >> 5, mt = (id >> 1) & 15, nt = id & 1; const ACmp al{(const bf16_t*)(p.ws + OFF_BIG), kv ? C_VC : C_KC};
  const EpiCmp1 epi{(bf16_t*)(p.ws + OFF_CHID) + (size_t)kv * 2048 * 256, (const float*)(p.ws + OFF_CBIAS) + (l * 2 + kv) * 256};
  gemm_tile(p.tid, al, lw(p.ws, l, LW_C1 + kv * SZ_C1), 2048, 256, 2048, mt * 128, nt * 128, epi, smem);
}
DI void item_cmp2(const Ctx& p, int l, int id, char* smem) {
  const int kv = id >> 4, mt = id & 15; const ALin al{(const bf16_t*)(p.ws + OFF_CHID) + (size_t)kv * 2048 * 256, 256, 2048};
  const EpiCmp2 epi{(bf16_t*)(p.ws + OFF_KCVC) + (size_t)kv * 2048 * 64};
  gemm_tile(p.tid, al, lw(p.ws, l, LW_C2 + kv * SZ_C2), 256, 64, 256, mt * 128, 0, epi, smem);
}
DI void item_mla(const Ctx& p, int id, char* smem) {
  const int i = 63 - (id >> 3), bh = id & 7, b = bh >> 2, h = bh & 3;
  const bf16_t* qa = (const bf16_t*)(p.ws + OFF_QA) + (size_t)(b * S_) * 384 + h * 96; const bf16_t* ka = (const bf16_t*)(p.ws + OFF_KA) + (size_t)(b * S_) * 384 + h * 96;
  const bf16_t* va = (const bf16_t*)(p.ws + OFF_VA) + (size_t)(b * S_) * 256 + h * 64;
  bf16_t* o = (bf16_t*)(p.ws + OFF_XB) + (size_t)(b * S_ + 128 * i) * D_ + h * 64; const OutSet out{o, D_, nullptr, 0, nullptr, 0}; float mm[2], ll[2];
  attn_core<96, 0>(p.tid, qa, 384, ka, 384, va, 256, 128 * i, 0, S_ - 1, 2 * (i + 1), nullptr, 0.10206207261f * 1.44269504089f, 0, nullptr, nullptr, false, mm, ll, out, smem);
}
DI void item_nsacmp(const Ctx& p, int id, char* smem) {
  const int i = 63 - (id >> 2), bg = id & 3, b = bg >> 1, g = bg & 1, tid = p.tid;
  const bf16_t* proj = (const bf16_t*)(p.ws + OFF_BIG); const bf16_t* base = proj + (size_t)(b * S_) * PW;
  const bf16_t* kc = (const bf16_t*)(p.ws + OFF_KCVC) + (size_t)((b * 2 + g) * NCMP) * 64; const bf16_t* vc = kc + (size_t)2048 * 64;
  float* imp = (float*)(p.ws + OFF_IMP) + ((size_t)((b * 2 + g) * S_) + 128 * i) * 128;
  const int nkt = (i + 8) >> 3;
#pragma unroll 1
  for (int hh = 0; hh < 3; ++hh) { const int h = g * 3 + hh; float mm[2], ll[2];
    bf16_t* o = (bf16_t*)(p.ws + OFF_XB) + (size_t)(b * S_ + 128 * i) * D_ + 640 + h * 64;
    const OutAdd out{o, D_, base + (size_t)(128 * i) * PW + C_GL + h * 3 + 0, PW};
    attn_core<64, 2>(p.tid, base + C_NQ + h * 64, PW, kc, 64, vc, 64, 128 * i, 0, NCMP - 1, nkt, nullptr, 0.125f * 1.44269504089f, 0, nullptr, nullptr, false, mm, ll, out, smem);
    attn_core<64, 3>(p.tid, base + C_NQ + h * 64, PW, kc, 64, vc, 64, 128 * i, 0, NCMP - 1, nkt, nullptr, 0.125f * 1.44269504089f, 0, nullptr, imp, hh == 0, mm, ll, out, smem);
  }
  __syncthreads();
  float* sc = (float*)smem;
  const int q = tid >> 1, half = tid & 1, qpos = 128 * i + q, cur = qpos >> 6;
#pragma unroll 2
  for (int j = half * 64; j < half * 64 + 64; ++j) { const float v = (j < nkt * 16) ? imp[(size_t)q * 128 + j] : 0.f; const bool forced = (j == 0) || (j == cur) || (j == cur - 1);
    sc[q * 129 + j] = forced ? 1e4f : (j <= cur ? v : -1e4f); }
  unsigned m0 = 0, m1 = 0, m2 = 0, m3 = 0;
#pragma unroll 1
  for (int rd = 0; rd < 16; ++rd) {
    float bv = -3e38f; int bj = half * 64;
#pragma unroll 4
    for (int j = half * 64; j < half * 64 + 64; ++j) { const float v = sc[q * 129 + j]; if (v > bv) { bv = v; bj = j; } }
    const float ov = __shfl_xor(bv, 1); const int oj = __shfl_xor(bj, 1);
    if (ov > bv || (ov == bv && oj < bj)) { bv = ov; bj = oj; }
    if ((bj >> 6) == half) sc[q * 129 + bj] = -3.2e38f;
    if (bj <= cur) { const unsigned bit = 1u << (bj & 31); const int w = bj >> 5; m0 |= (w == 0) ? bit : 0u; m1 |= (w == 1) ? bit : 0u; m2 |= (w == 2) ? bit : 0u; m3 |= (w == 3) ? bit : 0u; }
  }
  if (half == 0) { u32x4 w; w[0] = m0; w[1] = m1; w[2] = m2; w[3] = m3; *(u32x4*)((unsigned*)(p.ws + OFF_SEL) + ((size_t)(b * S_ + qpos) * 2 + g) * 4) = w; }
  __syncthreads();
}
DI void item_dilcombine(const Ctx& p, int id) {
  const size_t e = (size_t)id * 256 + p.tid; const int tok = (int)(e / 48), r = (int)(e % 48), h = r >> 3, d0 = (r & 7) * 8;
  const float* L = (const float*)(p.ws + OFF_DILL); const bf16_t* O = (const bf16_t*)(p.ws + OFF_DILO);
  const float l0 = L[(size_t)tok * 6 + h], l1 = L[((size_t)T_ + tok) * 6 + h], l2 = L[((size_t)2 * T_ + tok) * 6 + h]; const float mx = fmaxf(l0, fmaxf(l1, l2));
  float w0 = __expf(l0 - mx), w1 = __expf(l1 - mx), w2 = __expf(l2 - mx); const float inv = 1.f / (w0 + w1 + w2); w0 *= inv; w1 *= inv; w2 *= inv;
  const u32x4 a = *(const u32x4*)(O + (size_t)tok * 384 + h * 64 + d0), b = *(const u32x4*)(O + ((size_t)T_ + tok) * 384 + h * 64 + d0), c = *(const u32x4*)(O + ((size_t)2 * T_ + tok) * 384 + h * 64 + d0);
  u32x4 w;
#pragma unroll
  for (int k = 0; k < 4; ++k) { const float lo = w0 * __uint_as_float(a[k] << 16) + w1 * __uint_as_float(b[k] << 16) + w2 * __uint_as_float(c[k] << 16);
    const float hi = w0 * __uint_as_float(a[k] & 0xffff0000u) + w1 * __uint_as_float(b[k] & 0xffff0000u) + w2 * __uint_as_float(c[k] & 0xffff0000u); w[k] = pk2(lo, hi); }
  *(u32x4*)((bf16_t*)(p.ws + OFF_XB) + (size_t)tok * D_ + 256 + h * 64 + d0) = w;
}
DI void item_nsaslc(const Ctx& p, int id, char* smem) {
  const int i = 63 - id / 12, r = id % 12, b = r / 6, h = r % 6, g = h / 3, tid = p.tid;
  const bf16_t* proj = (const bf16_t*)(p.ws + OFF_BIG); const bf16_t* base = proj + (size_t)(b * S_) * PW;
  unsigned* selw = (unsigned*)(smem + 49152 + 2048); int* tlist = (int*)(smem + 49152); unsigned* un = (unsigned*)(smem + 49152 + 1024);
  __syncthreads();
  if (tid < 4) un[tid] = 0u;
  __syncthreads();
  if (tid < 128) { const u32x4 w = *(const u32x4*)((const unsigned*)(p.ws + OFF_SEL) + ((size_t)(b * S_ + 128 * i + tid) * 2 + g) * 4);
    selw[tid * 4 + 0] = w[0]; selw[tid * 4 + 1] = w[1]; selw[tid * 4 + 2] = w[2]; selw[tid * 4 + 3] = w[3];
    atomicOr(&un[0], w[0]); atomicOr(&un[1], w[1]); atomicOr(&un[2], w[2]); atomicOr(&un[3], w[3]); }
  __syncthreads();
  if (tid == 0) { int n = 0; for (int jt = 0; jt < 2 * (i + 1); ++jt) if ((un[jt >> 5] >> (jt & 31)) & 1u) tlist[n++] = jt; tlist[255] = n; }
  __syncthreads();
  const int nt = tlist[255];
  bf16_t* o = (bf16_t*)(p.ws + OFF_XB) + (size_t)(b * S_ + 128 * i) * D_ + 640 + h * 64;
  const OutAdd out{o, D_, base + (size_t)(128 * i) * PW + C_GL + h * 3 + 1, PW}; float mm[2], ll[2];
  attn_core<64, 4>(p.tid, base + C_NQR + h * 64, PW, base + C_KSL + g * 64, PW, base + C_VSL + g * 64, PW, 128 * i, 0, S_ - 1, nt, tlist, 0.125f * 1.44269504089f, 0, selw, nullptr, false, mm, ll, out, smem);
}

DI void phase_mix_a(const Ctx& p0, int l, char* smem) {
  unsigned* ctr = (unsigned*)(p0.ws + OFF_CTRL) + l * 8 + 0; const int total = 768 + 2304 + 896 + 64;
  for (;;) { Ctx q = p0; asm volatile("" : "+v"(q.tid)); const Ctx& p = q; const int t = next_item(p.tid, ctr, smem); if (t >= total) break;
    if (t < 768) item_nsawin(p, t, smem); else if (t < 768 + 2304) item_dilated(p, t - 768, smem);
    else if (t < 768 + 2304 + 896) item_expand(p, l, t - 768 - 2304, smem); else item_cmp1(p, l, t - 768 - 2304 - 896, smem); }
}
DI void phase_mix_b(const Ctx& p0, int l, char* smem) {
  unsigned* ctr = (unsigned*)(p0.ws + OFF_CTRL) + l * 8 + 1; const int total = 512 + 32;
  for (;;) { Ctx q = p0; asm volatile("" : "+v"(q.tid)); const Ctx& p = q; const int t = next_item(p.tid, ctr, smem); if (t >= total) break; if (t < 512) item_mla(p, t, smem); else item_cmp2(p, l, t - 512, smem); }
}
DI void phase_mix_c(const Ctx& p0, int l, char* smem) {
  unsigned* ctr = (unsigned*)(p0.ws + OFF_CTRL) + l * 8 + 2; const int total = 256 + 3072;
  for (;;) { Ctx q = p0; asm volatile("" : "+v"(q.tid)); const Ctx& p = q; const int t = next_item(p.tid, ctr, smem); if (t >= total) break; if (t < 256) item_nsacmp(p, t, smem); else item_dilcombine(p, t - 256); }
}
DI void phase_mix_d(const Ctx& p0, int l, char* smem) {
  unsigned* ctr = (unsigned*)(p0.ws + OFF_CTRL) + l * 8 + 3; const int total = 768;
  for (;;) { Ctx q = p0; asm volatile("" : "+v"(q.tid)); const Ctx& p = q; const int t = next_item(p.tid, ctr, smem); if (t >= total) break; item_nsaslc(p, t, smem); }
}
DI void phase_zero_o(const Ctx& p) {
  u32x4* o = (u32x4*)(p.ws + OFF_XB); const u32x4 z = (u32x4){0u, 0u, 0u, 0u};
  for (size_t e = (size_t)blockIdx.x * 256 + p.tid; e < (size_t)T_ * D_ / 8; e += (size_t)gridDim.x * 256) o[e] = z;
}

DI void run_phase(const Params& P, int ph, char* smem) {
  Ctx p; p.x = P.x; p.ln_g = P.ln_g; p.ln_b = P.ln_b; p.cmp_pos = P.cmp_pos; p.cmp_w1 = P.cmp_w1; p.out = P.out; p.ws = P.ws; p.tid = threadIdx.x;
  asm volatile("" : "+v"(p.tid));
  if (ph == 0) { phase_prologue(P, p, smem); return; }
  const int l = (ph - 1) / 13; int s = (ph - 1) % 13;
#ifdef ONLY_S
  if (s != ONLY_S) return;
  s = ONLY_S;
#endif
  switch (s) {
    case 0: phase_ffn_up(p, l, 0, smem); break;
    case 1: phase_ffn_down(p, l, 0, smem); break;
    case 2: phase_ln(p, l, 0, false); break;
#if ENABLE_MIX
    case 3: phase_win(p, l, smem); break;
    case 4: phase_mix_a(p, l, smem); break;
    case 5: phase_mix_b(p, l, smem); break;
    case 6: phase_mix_c(p, l, smem); break;
    case 7: phase_mix_d(p, l, smem); break;
#else
    case 3: phase_zero_o(p); break;
    case 4: case 5: case 6: case 7: break;
#endif
    case 8: phase_wout(p, l, smem); break;
    case 9: phase_ln(p, l, 1, false); break;
    case 10: phase_ffn_up(p, l, 1, smem); break;
    case 11: phase_ffn_down(p, l, 1, smem); break;
    case 12: phase_ln(p, l, 2, false); break;
  }
}
constexpr int NPHASE = 27;

#if ONE_LAUNCH
DI unsigned xb_ld(unsigned* p) { return __hip_atomic_load(p, __ATOMIC_RELAXED, __HIP_MEMORY_SCOPE_AGENT); }
DI unsigned xb_add(unsigned* p, unsigned v) { return __hip_atomic_fetch_add(p, v, __ATOMIC_RELAXED, __HIP_MEMORY_SCOPE_AGENT); }
DI void xb_st(unsigned* p, unsigned v) { __hip_atomic_store(p, v, __ATOMIC_RELAXED, __HIP_MEMORY_SCOPE_AGENT); }
constexpr int XB_CNT = 256, XB_SUB = 256 + 64 * 16, XB_GEN = 256 + 64 * 32, XB_TOP = 256 + 64 * 48, XB_TOPGEN = 256 + 64 * 49, XB_WORDS = 256 + 64 * 50;
DI void grid_bar(const Params& P, unsigned idx, char* smem) {
  asm volatile("s_waitcnt vmcnt(0)" ::: "memory");
  __syncthreads();
  int t = threadIdx.x; asm volatile("" : "+v"(t));
  if (t == 0) {
    unsigned* bar = (unsigned*)(P.ws + OFF_CTRL);
    volatile unsigned* st = (volatile unsigned*)(smem + 69632 - 16);
    const unsigned x = st[1], nloc = st[2], nx = st[3];
    const unsigned old = xb_add(&bar[XB_SUB + 64 * x], 1u);
    if (old + 1u == idx * nloc) {
      __builtin_amdgcn_fence(__ATOMIC_RELEASE, "agent");
      asm volatile("s_waitcnt vmcnt(0)" ::: "memory");
      const unsigned og = xb_add(&bar[XB_TOP], 1u);
      if (og + 1u == idx * nx) xb_st(&bar[XB_TOPGEN], idx);
      else { while (xb_ld(&bar[XB_TOPGEN]) < idx) __builtin_amdgcn_s_sleep(1); }
      xb_st(&bar[XB_GEN + 64 * x], idx);
    } else { while (xb_ld(&bar[XB_GEN + 64 * x]) < idx) __builtin_amdgcn_s_sleep(1); }
    __builtin_amdgcn_fence(__ATOMIC_ACQUIRE, "agent");
    asm volatile("s_waitcnt vmcnt(0)" ::: "memory");
  }
  __syncthreads();
}
template <int PH> DI void run_all(const Params& p, char* smem) {
  run_phase(p, PH, smem);
  if constexpr (PH + 1 < NPHASE) { grid_bar(p, PH + 1, smem); run_all<PH + 1>(p, smem); }
}
__global__ void __launch_bounds__(256, 2) mega_kernel(Params p) {
  __shared__ __attribute__((aligned(16))) char smem[69632];
  {
    unsigned* bar = (unsigned*)(p.ws + OFF_CTRL); volatile unsigned* st = (volatile unsigned*)(smem + 69632 - 16);
    const unsigned x = (unsigned)__builtin_amdgcn_s_getreg((3 << 11) | 20) & 0xFu;
    if (threadIdx.x == 0) xb_add(&bar[XB_CNT + 64 * x], 1u);
    cg::this_grid().sync();
    if (threadIdx.x == 0) { unsigned nx = 0, mine = 1;
      for (unsigned j = 0; j < 16; ++j) { const unsigned c = xb_ld(&bar[XB_CNT + 64 * j]); nx += (c > 0u) ? 1u : 0u; if (j == x) mine = c; }
      st[1] = x; st[2] = mine; st[3] = nx; }
    __syncthreads();
  }
  run_all<0>(p, smem);
}
#define MAIN_KERNEL mega_kernel
#else
#define MAIN_KERNEL phase_kernel
#endif
__global__ void __launch_bounds__(256, 2) phase_kernel(Params p, int ph) {
  __shared__ __attribute__((aligned(16))) char smem[69632];
  run_phase(p, ph, smem);
}

extern "C" void kernel_launch(void* const* d_in, const int* in_sizes, int n_in, void* d_out, int out_size, void* d_ws, size_t ws_size, hipStream_t stream) {
  static int grid_blocks = 0;
  if (!grid_blocks) { int dev = 0, cus = 0, per_cu = 0; hipGetDevice(&dev); hipDeviceGetAttribute(&cus, hipDeviceAttributeMultiprocessorCount, dev);
    hipOccupancyMaxActiveBlocksPerMultiprocessor(&per_cu, MAIN_KERNEL, 256, 0); if (per_cu > 2) per_cu = 2; if (per_cu < 1) per_cu = 1; grid_blocks = cus * per_cu; }
  if (ws_size < OFF_END) { fprintf(stderr, "workspace too small: %zu < %zu\n", ws_size, (size_t)OFF_END); return; }
  Params p; memset(&p, 0, sizeof(p));
  const float* x = (const float*)d_in[0]; const float* ffn_in = (const float*)d_in[1]; const float* ffn_out = (const float*)d_in[2];
  const float* w_in = (const float*)d_in[5]; const float* w_out = (const float*)d_in[6]; const float* qn = (const float*)d_in[7]; const float* kvn = (const float*)d_in[8];
  const float* wuq = (const float*)d_in[9]; const float* wukv = (const float*)d_in[10]; const float* cw1 = (const float*)d_in[12]; const float* cw2 = (const float*)d_in[13];
  p.x = x; p.ln_g = (const float*)d_in[3]; p.ln_b = (const float*)d_in[4]; p.cmp_pos = (const float*)d_in[11]; p.cmp_w1 = cw1; p.out = (float*)d_out; p.ws = (char*)d_ws;
  int tile0 = 0, di = 0;
  auto add = [&](const float* src, size_t dst_off, const float* ksc, int K, int Nsrc, int Ndst, int map) {
    WDesc& d = p.wd[di++]; d.src = src; d.dst = (bf16_t*)((char*)d_ws + dst_off); d.kscale = ksc; d.K = K; d.Nsrc = Nsrc; d.Ndst = Ndst; d.map = map; d.tile0 = tile0; d.ntn = Ndst / 64;
    tile0 += (Ndst / 64) * (K / 64); };
  for (int l = 0; l < 2; ++l) { const size_t wb = OFF_W + (size_t)l * LW_SIZE;
    for (int j = 0; j < 2; ++j) add(ffn_in + (size_t)(l * 2 + j) * 1024 * 5632, wb + LW_FIN + j * SZ_FIN, nullptr, 1024, 5632, 5632, 1);
    for (int j = 0; j < 2; ++j) add(ffn_out + (size_t)(l * 2 + j) * 2816 * 1024, wb + LW_FOUT + j * SZ_FOUT, nullptr, 2816, 1024, 1024, 0);
    add(w_in + (size_t)l * 1024 * 2738, wb + LW_WIN, nullptr, 1024, 2738, PW, 2);
    add(w_out + (size_t)l * 1024 * 1024, wb + LW_WOUT, nullptr, 1024, 1024, 1024, 0);
    add(wuq + (size_t)l * 256 * 384, wb + LW_UQ, qn + l * 256, 256, 384, 384, 0);
    add(wukv + (size_t)l * 128 * 512, wb + LW_UKV, kvn + l * 128, 128, 512, 512, 0);
    for (int kv = 0; kv < 2; ++kv) add(cw1 + (size_t)(l * 2 + kv) * 2048 * 256, wb + LW_C1 + kv * SZ_C1, nullptr, 2048, 256, 256, 0);
    for (int kv = 0; kv < 2; ++kv) add(cw2 + (size_t)(l * 2 + kv) * 256 * 64, wb + LW_C2 + kv * SZ_C2, nullptr, 256, 64, 64, 0);
  }
  p.n_wtiles = tile0;
  hipMemsetAsync((char*)d_ws + OFF_CTRL, 0, 16384, stream);
#if ONE_LAUNCH
  void* args[] = {&p};
  hipError_t e = hipLaunchCooperativeKernel((void*)mega_kernel, dim3(grid_blocks), dim3(256), args, 0, stream);
  if (e != hipSuccess) fprintf(stderr, "cooperative launch failed: %s (grid %d)\n", hipGetErrorString(e), grid_blocks);
#else
  for (int ph = 0; ph < NPHASE; ++ph) phase_kernel<<<dim3(grid_blocks), dim3(256), 0, stream>>>(p, ph);
#endif
}
```

```cpp
#include <hip/hip_runtime.h>
#include <hip/hip_cooperative_groups.h>
#include <cstdio>
#include <cstdint>
#include <cstring>
namespace cg = cooperative_groups;

typedef unsigned short bf16_t;
typedef short bf16x8 __attribute__((ext_vector_type(8)));
typedef short s16x4 __attribute__((ext_vector_type(4)));
typedef float f32x4 __attribute__((ext_vector_type(4)));
typedef unsigned u32x4 __attribute__((ext_vector_type(4)));
typedef unsigned u32x2 __attribute__((ext_vector_type(2)));
#define DI __device__ __forceinline__
#define LDSP(T, p) ((__attribute__((address_space(3))) T*)(p))

#ifndef ENABLE_MIX
#define ENABLE_MIX 1
#endif
#ifndef PROBE_REP
#define PROBE_REP 0
#endif
#ifndef ONE_LAUNCH
#define ONE_LAUNCH 1
#endif

constexpr int T_ = 16384, S_ = 8192, D_ = 1024, F_ = 2816, PW = 3200;
constexpr float ALPHA = 1.41421356237f;
constexpr int C_CQ = 0, C_CKV = 256, C_DQ = 384, C_DK = 768, C_DV = 1152, C_NQ = 1536, C_NQR = 1920, C_KC = 2304, C_VC = 2432,
              C_KSL = 2560, C_VSL = 2688, C_KW = 2816, C_VW = 2944, C_KPE = 3072, C_GL = 3104;
constexpr int NCMP = 511;

constexpr size_t SZ_FIN = 5632ull * 1024 * 2, SZ_FOUT = 1024ull * 2816 * 2, SZ_WIN = (size_t)PW * 1024 * 2, SZ_WOUT = 1024ull * 1024 * 2,
                 SZ_UQ = 384ull * 256 * 2, SZ_UKV = 512ull * 128 * 2, SZ_C1 = 256ull * 2048 * 2, SZ_C2 = 64ull * 256 * 2;
constexpr size_t LW_FIN = 0, LW_FOUT = LW_FIN + 2 * SZ_FIN, LW_WIN = LW_FOUT + 2 * SZ_FOUT, LW_WOUT = LW_WIN + SZ_WIN, LW_UQ = LW_WOUT + SZ_WOUT,
                 LW_UKV = LW_UQ + SZ_UQ, LW_C1 = LW_UKV + SZ_UKV, LW_C2 = LW_C1 + 2 * SZ_C1, LW_SIZE = LW_C2 + 2 * SZ_C2;
constexpr size_t OFF_CTRL = 0, OFF_C64 = 16384, OFF_S64 = OFF_C64 + 8192ull * 32 * 4, OFF_C32 = OFF_S64 + 8192ull * 32 * 4, OFF_S32 = OFF_C32 + 8192ull * 16 * 4,
                 OFF_CBIAS = OFF_S32 + 8192ull * 16 * 4, OFF_W = OFF_CBIAS + 4096, OFF_XB = OFF_W + 2 * LW_SIZE, OFF_BIG = OFF_XB + (size_t)T_ * D_ * 2,
                 OFF_QA = OFF_BIG + (size_t)T_ * PW * 2, OFF_KA = OFF_QA + (size_t)T_ * 384 * 2, OFF_VA = OFF_KA + (size_t)T_ * 384 * 2,
                 OFF_DILO = OFF_VA + (size_t)T_ * 256 * 2, OFF_DILL = OFF_DILO + 3ull * T_ * 384 * 2, OFF_CHID = OFF_DILL + 3ull * T_ * 6 * 4,
                 OFF_KCVC = OFF_CHID + 2ull * 2048 * 256 * 2, OFF_SEL = OFF_KCVC + 2ull * 2048 * 64 * 2, OFF_IMP = OFF_SEL + (size_t)T_ * 2 * 4 * 4,
                 OFF_END = OFF_IMP + (size_t)T_ * 2 * 128 * 4;

struct WDesc { const float* src; bf16_t* dst; const float* kscale; int K, Nsrc, Ndst, map, tile0, ntn; };
struct Params {
  const float* x; const float* ln_g; const float* ln_b; const float* cmp_pos; const float* cmp_w1;
  float* out; char* ws;
  WDesc wd[24];
  int n_wtiles; int pad0;
};
struct Ctx { const float* x; const float* ln_g; const float* ln_b; const float* cmp_pos; const float* cmp_w1; float* out; char* ws; int tid; };

DI bf16_t f2bf(float x) { unsigned u = __float_as_uint(x); u += 0x7fffu + ((u >> 16) & 1u); return (bf16_t)(u >> 16); }
DI float bf2f(bf16_t v) { return __uint_as_float(((unsigned)v) << 16); }
DI unsigned pk2(float a, float b) { return (unsigned)f2bf(a) | ((unsigned)f2bf(b) << 16); }
DI float fast_exp2(float x) { return __builtin_amdgcn_exp2f(x); }
DI float silu(float v) { return v * __builtin_amdgcn_rcpf(1.f + __expf(-v)); }
DI f32x4 mfma16(bf16x8 a, bf16x8 b, f32x4 c) { return __builtin_amdgcn_mfma_f32_16x16x32_bf16(a, b, c, 0, 0, 0); }

DI void sincos_rr(float ang, float& c, float& s) {
  const double rev = (double)ang * 0.15915494309189533577; const float fr = (float)(rev - rint(rev));
  c = __builtin_amdgcn_cosf(fr); s = __builtin_amdgcn_sinf(fr);
}

struct ALin { const bf16_t* A; int lda; int mmax; DI const bf16_t* ptr(int row, int k) const { row = row < mmax ? row : mmax - 1; return A + (size_t)row * lda + k; } };
struct ACmp {
  const bf16_t* proj; int colbase;
  DI const bf16_t* ptr(int m, int k) const { if (m > 2043) m = 2043; int b = m / 1022, rem = m - b * 1022, g = rem / 511, c = rem - g * 511;
    return proj + (size_t)(b * S_ + 16 * c + (k >> 6)) * PW + colbase + g * 64 + (k & 63); } };

template <class AL, class EPI>
DI void gemm_tile(const int tid, const AL al, const bf16_t* __restrict__ Bt, int ldb, int nvalid, int K, int m0, int n0, const EPI epi, char* smem) {
  const int lane = tid & 63, wave = tid >> 6, wr = wave >> 1, wc = wave & 1, g = lane >> 4;
  f32x4 acc[4][4];
#pragma unroll
  for (int i = 0; i < 4; ++i)
#pragma unroll
    for (int j = 0; j < 4; ++j) acc[i][j] = (f32x4){0.f, 0.f, 0.f, 0.f};
  const int srow = wave * 32 + (lane >> 3), sc8 = ((lane & 7) ^ (lane >> 3)) * 8;
  const bf16_t* bp[4];
#pragma unroll
  for (int i = 0; i < 4; ++i) { int r = n0 + srow + 8 * i; r = r < nvalid ? r : nvalid - 1; bp[i] = Bt + (size_t)r * ldb + sc8; }
  const int offA = (wr * 64 + (lane & 15)) * 128 + ((g ^ (lane & 7)) << 4);
  const int offB = (wc * 64 + (lane & 15)) * 128 + ((g ^ (lane & 7)) << 4);
  const int nk = K >> 6;
  auto stage = [&](int kt, int buf) {
    char* da = smem + buf * 32768 + wave * 4096; const int k0 = kt << 6;
#pragma unroll
    for (int i = 0; i < 4; ++i) {
      __builtin_amdgcn_global_load_lds((const unsigned*)al.ptr(m0 + srow + 8 * i, k0 + sc8), LDSP(unsigned, da + i * 1024), 16, 0, 0);
      __builtin_amdgcn_global_load_lds((const unsigned*)(bp[i] + k0), LDSP(unsigned, da + 16384 + i * 1024), 16, 0, 0);
    }
  };
  stage(0, 0);
  asm volatile("s_waitcnt vmcnt(0)" ::: "memory");
  __syncthreads();
  for (int kt = 0; kt < nk; ++kt) {
    if (kt + 1 < nk) stage(kt + 1, (kt + 1) & 1);
    const char* sa = smem + (kt & 1) * 32768; const char* sb = sa + 16384;
#pragma unroll
    for (int ks = 0; ks < 2; ++ks) {
      bf16x8 af[4], bfr[4];
#pragma unroll
      for (int i = 0; i < 4; ++i) { af[i] = *(const bf16x8*)(sa + ((offA + i * 2048) ^ (ks << 6))); bfr[i] = *(const bf16x8*)(sb + ((offB + i * 2048) ^ (ks << 6))); }
#pragma unroll
      for (int i = 0; i < 4; ++i)
#pragma unroll
        for (int j = 0; j < 4; ++j) acc[i][j] = mfma16(af[i], bfr[j], acc[i][j]);
    }
    asm volatile("s_waitcnt vmcnt(0)" ::: "memory");
    __syncthreads();
  }
  epi(acc, m0 + wr * 64, n0 + wc * 64, lane);
}

DI void store_plain(bf16_t* dst, int ld, const f32x4 (&acc)[4][4], int row0, int col0, int lane, float sc) {
#pragma unroll
  for (int mi = 0; mi < 4; ++mi)
#pragma unroll
    for (int r = 0; r < 4; ++r) { const int row = row0 + mi * 16 + (lane >> 4) * 4 + r;
#pragma unroll
      for (int ni = 0; ni < 4; ++ni) dst[(size_t)row * ld + col0 + ni * 16 + (lane & 15)] = f2bf(acc[mi][ni][r] * sc); }
}

struct EpiSwiGLU { bf16_t* H;
  DI void operator()(const f32x4 (&acc)[4][4], int row0, int col0, int lane) const {
#pragma unroll
    for (int mi = 0; mi < 4; ++mi)
#pragma unroll
      for (int r = 0; r < 4; ++r) { const int row = row0 + mi * 16 + (lane >> 4) * 4 + r;
#pragma unroll
        for (int pr = 0; pr < 2; ++pr) { const float gt = acc[mi][2 * pr][r], up = acc[mi][2 * pr + 1][r];
          H[(size_t)row * F_ + ((col0 >> 5) + pr) * 16 + (lane & 15)] = f2bf(silu(gt) * up); } }
  } };
struct EpiResid { const float* xin; float* y; float scale;
  DI void operator()(const f32x4 (&acc)[4][4], int row0, int col0, int lane) const {
#pragma unroll
    for (int mi = 0; mi < 4; ++mi)
#pragma unroll
      for (int r = 0; r < 4; ++r) { const int row = row0 + mi * 16 + (lane >> 4) * 4 + r;
#pragma unroll
        for (int ni = 0; ni < 4; ++ni) { const size_t ix = (size_t)row * D_ + col0 + ni * 16 + (lane & 15); y[ix] = ALPHA * xin[ix] + scale * acc[mi][ni][r]; } }
  } };
struct EpiProj { bf16_t* proj; bf16_t* ka; const float* c64; const float* s64; const float* c32; const float* s32;
  DI void operator()(const f32x4 (&acc)[4][4], int row0, int col0, int lane) const {
    const bool rope = (col0 >= C_DQ && col0 < C_DV) || (col0 >= C_NQR && col0 < C_KC) || (col0 >= C_KSL && col0 < C_VSL) || (col0 >= C_KW && col0 < C_VW);
    if (rope) {
#pragma unroll
      for (int mi = 0; mi < 4; ++mi)
#pragma unroll
        for (int r = 0; r < 4; ++r) { const int row = row0 + mi * 16 + (lane >> 4) * 4 + r, pos = row & (S_ - 1);
#pragma unroll
          for (int ni = 0; ni < 2; ++ni) { const int i = ni * 16 + (lane & 15); const float c = c64[pos * 32 + i], s = s64[pos * 32 + i];
            const float x1 = acc[mi][ni][r], x2 = acc[mi][ni + 2][r];
            proj[(size_t)row * PW + col0 + i] = f2bf(x1 * c - x2 * s); proj[(size_t)row * PW + col0 + 32 + i] = f2bf(x1 * s + x2 * c); } }
    } else if (col0 == C_KPE) {
#pragma unroll
      for (int mi = 0; mi < 4; ++mi)
#pragma unroll
        for (int r = 0; r < 4; ++r) { const int row = row0 + mi * 16 + (lane >> 4) * 4 + r, pos = row & (S_ - 1); const int i = lane & 15;
          const float c = c32[pos * 16 + i], s = s32[pos * 16 + i]; const float x1 = acc[mi][0][r], x2 = acc[mi][1][r];
          const bf16_t o1 = f2bf(x1 * c - x2 * s), o2 = f2bf(x1 * s + x2 * c);
#pragma unroll
          for (int h = 0; h < 4; ++h) { ka[(size_t)row * 384 + h * 96 + 64 + i] = o1; ka[(size_t)row * 384 + h * 96 + 80 + i] = o2; }
#pragma unroll
          for (int ni = 2; ni < 4; ++ni) { const float v = acc[mi][ni][r]; proj[(size_t)row * PW + col0 + ni * 16 + i] = f2bf(1.f / (1.f + __expf(-v))); } }
    } else store_plain(proj, PW, acc, row0, col0, lane, 1.f);
  } };
struct EpiMLAq { bf16_t* qa; const float* rs; int m0; const float* c32; const float* s32;
  DI void operator()(const f32x4 (&acc)[4][4], int row0, int col0, int lane) const {
#pragma unroll
    for (int mi = 0; mi < 4; ++mi)
#pragma unroll
      for (int r = 0; r < 4; ++r) { const int row = row0 + mi * 16 + (lane >> 4) * 4 + r, pos = row & (S_ - 1); const float sc = rs[row - m0]; const int i = lane & 15;
#pragma unroll
        for (int ch = 0; ch < 2; ++ch) { const int gc = col0 + 32 * ch; const float x1 = acc[mi][2 * ch][r] * sc, x2 = acc[mi][2 * ch + 1][r] * sc;
          if (((gc >> 5) % 3) == 2) { const float c = c32[pos * 16 + i], s = s32[pos * 16 + i];
            qa[(size_t)row * 384 + gc + i] = f2bf(x1 * c - x2 * s); qa[(size_t)row * 384 + gc + 16 + i] = f2bf(x1 * s + x2 * c); }
          else { qa[(size_t)row * 384 + gc + i] = f2bf(x1); qa[(size_t)row * 384 + gc + 16 + i] = f2bf(x2); } } }
  } };
struct EpiMLAkv { bf16_t* ka; bf16_t* va; const float* rs; int m0;
  DI void operator()(const f32x4 (&acc)[4][4], int row0, int col0, int lane) const {
    const int h = col0 >> 7, part = (col0 >> 6) & 1;
#pragma unroll
    for (int mi = 0; mi < 4; ++mi)
#pragma unroll
      for (int r = 0; r < 4; ++r) { const int row = row0 + mi * 16 + (lane >> 4) * 4 + r; const float sc = rs[row - m0];
#pragma unroll
        for (int ni = 0; ni < 4; ++ni) { const int j = ni * 16 + (lane & 15); const bf16_t v = f2bf(acc[mi][ni][r] * sc);
          if (part == 0) ka[(size_t)row * 384 + h * 96 + j] = v; else va[(size_t)row * 256 + h * 64 + j] = v; } }
  } };
struct EpiCmp1 { bf16_t* hid; const float* bias;
  DI void operator()(const f32x4 (&acc)[4][4], int row0, int col0, int lane) const {
#pragma unroll
    for (int mi = 0; mi < 4; ++mi)
#pragma unroll
      for (int r = 0; r < 4; ++r) { const int row = row0 + mi * 16 + (lane >> 4) * 4 + r;
#pragma unroll
        for (int ni = 0; ni < 4; ++ni) { const int col = col0 + ni * 16 + (lane & 15); hid[(size_t)row * 256 + col] = f2bf(silu(acc[mi][ni][r] + bias[col])); } }
  } };
struct EpiCmp2 { bf16_t* kc;
  DI void operator()(const f32x4 (&acc)[4][4], int row0, int col0, int lane) const {
    if (col0 >= 64) return;
#pragma unroll
    for (int mi = 0; mi < 4; ++mi)
#pragma unroll
      for (int r = 0; r < 4; ++r) { const int row = row0 + mi * 16 + (lane >> 4) * 4 + r;
        if (row < 2044) {
#pragma unroll
          for (int ni = 0; ni < 4; ++ni) kc[(size_t)row * 64 + col0 + ni * 16 + (lane & 15)] = f2bf(acc[mi][ni][r]); } }
  } };

template <int DQ, int MODE, class OUT>
DI void attn_core(const int tid, const bf16_t* __restrict__ Qb, long qs, const bf16_t* __restrict__ Kb, long kst, const bf16_t* __restrict__ Vb, long vst,
                  int q0, int k0, int kmax, int ntiles, const int* tlist, float sl2, int window,
                  const unsigned* selw, float* impg, bool first_head, float (&m_io)[2], float (&l_io)[2], const OUT out, char* smem) {
  constexpr int NKD = DQ / 32, CPR = DQ / 8, KST = (DQ == 64) ? 128 : 256, NKC = 64 * CPR / 256;
  const int lane = tid & 63, wave = tid >> 6, g = lane >> 4, li = lane & 15;
  bf16x8 qf[2][NKD];
#pragma unroll
  for (int qt = 0; qt < 2; ++qt)
#pragma unroll
    for (int kd = 0; kd < NKD; ++kd) qf[qt][kd] = *(const bf16x8*)(Qb + (long)(q0 + wave * 32 + qt * 16 + li) * qs + kd * 32 + g * 8);
  int qidx[2]; qidx[0] = q0 + wave * 32 + li; qidx[1] = qidx[0] + 16;
  f32x4 o[4][2];
#pragma unroll
  for (int i = 0; i < 4; ++i) { o[i][0] = (f32x4){0.f, 0.f, 0.f, 0.f}; o[i][1] = (f32x4){0.f, 0.f, 0.f, 0.f}; }
  float mrun[2], lrun[2], invl[2], prev3[2];
#pragma unroll
  for (int qt = 0; qt < 2; ++qt) { prev3[qt] = 0.f;
    if (MODE == 3) { mrun[qt] = m_io[qt]; lrun[qt] = 0.f; invl[qt] = l_io[qt] > 0.f ? 1.f / l_io[qt] : 0.f; } else { mrun[qt] = -1e30f; lrun[qt] = 0.f; invl[qt] = 0.f; } }
  u32x4 rk[NKC], rv[2];
  auto gload = [&](int jt) {
    const int kb = k0 + jt * 64;
#pragma unroll
    for (int i = 0; i < NKC; ++i) { const int id = tid + 256 * i, row = id / CPR, c = id - row * CPR; int ix = kb + row; ix = ix < 0 ? 0 : (ix > kmax ? kmax : ix);
      rk[i] = *(const u32x4*)(Kb + (long)ix * kst + c * 8); }
    if (MODE != 2) {
#pragma unroll
      for (int i = 0; i < 2; ++i) { const int id = tid + 256 * i, row = id >> 3, c = id & 7; int ix = kb + row; ix = ix < 0 ? 0 : (ix > kmax ? kmax : ix);
        rv[i] = *(const u32x4*)(Vb + (long)ix * vst + c * 8); }
    }
  };
  auto lstore = [&](int buf) {
    char* kbuf = smem + buf * 16384; char* vbuf = smem + 32768 + buf * 8192;
#pragma unroll
    for (int i = 0; i < NKC; ++i) { const int id = tid + 256 * i, row = id / CPR, c = id - row * CPR; *(u32x4*)(kbuf + row * KST + ((c ^ (row & 7)) << 4)) = rk[i]; }
    if (MODE != 2) {
#pragma unroll
      for (int i = 0; i < 2; ++i) { const int id = tid + 256 * i, row = id >> 3, c = id & 7;
        *(u32x4*)(vbuf + row * 128 + (((((c >> 1) ^ ((row >> 1) & 3)) << 1) | (c & 1)) << 4)) = rv[i]; }
    }
  };
  if (ntiles > 0) { gload(tlist ? tlist[0] : 0); lstore(0); }
  __syncthreads();
  for (int it = 0; it < ntiles; ++it) {
    const int jt = tlist ? tlist[it] : it;
    const bool more = it + 1 < ntiles;
    if (more) gload(tlist ? tlist[it + 1] : it + 1);
    const char* kbuf = smem + (it & 1) * 16384; const char* vbuf = smem + 32768 + (it & 1) * 8192;
    f32x4 st[4][2];
#pragma unroll
    for (int kt4 = 0; kt4 < 4; ++kt4) {
      bf16x8 kf[NKD]; const int row = kt4 * 16 + li;
#pragma unroll
      for (int kd = 0; kd < NKD; ++kd) kf[kd] = *(const bf16x8*)(kbuf + row * KST + (((kd * 4 + g) ^ (row & 7)) << 4));
#pragma unroll
      for (int qt = 0; qt < 2; ++qt) { f32x4 a = (f32x4){0.f, 0.f, 0.f, 0.f};
#pragma unroll
        for (int kd = 0; kd < NKD; ++kd) a = mfma16(kf[kd], qf[qt][kd], a);
        st[kt4][qt] = a; }
    }
    const int kbase = k0 + jt * 64;
    bool sb[2] = {true, true};
    if (MODE == 4) { sb[0] = (selw[(wave * 32 + li) * 4 + (jt >> 5)] >> (jt & 31)) & 1u; sb[1] = (selw[(wave * 32 + 16 + li) * 4 + (jt >> 5)] >> (jt & 31)) & 1u; }
    float alpha[2];
#pragma unroll
    for (int qt = 0; qt < 2; ++qt) {
      float mx = -1e30f;
#pragma unroll
      for (int kt4 = 0; kt4 < 4; ++kt4)
#pragma unroll
        for (int r = 0; r < 4; ++r) { const int kidx = kbase + kt4 * 16 + g * 4 + r; bool v;
          if (MODE == 0) v = kidx <= qidx[qt];
          else if (MODE == 1) v = (kidx >= 0) && (kidx <= qidx[qt]) && (qidx[qt] - kidx <= window);
          else if (MODE == 2 || MODE == 3) v = (kidx <= kmax) && (16 * kidx + 31 <= qidx[qt]);
          else v = (kidx <= qidx[qt]) && sb[qt];
          const float s = v ? st[kt4][qt][r] * sl2 : -1e30f; st[kt4][qt][r] = s; mx = fmaxf(mx, s); }
      if (MODE != 3) {
        mx = fmaxf(mx, __shfl_xor(mx, 16)); mx = fmaxf(mx, __shfl_xor(mx, 32));
        const float mn = fmaxf(mrun[qt], mx); alpha[qt] = fast_exp2(mrun[qt] - mn); mrun[qt] = mn;
      } else alpha[qt] = 1.f;
      float ls = 0.f;
#pragma unroll
      for (int kt4 = 0; kt4 < 4; ++kt4)
#pragma unroll
        for (int r = 0; r < 4; ++r) { const float s = st[kt4][qt][r]; float p = (s > -5e29f) ? fast_exp2(s - mrun[qt]) : 0.f; if (MODE == 3) p *= invl[qt]; st[kt4][qt][r] = p; ls += p; }
      lrun[qt] = lrun[qt] * alpha[qt] + ls;
    }
    if (MODE == 3) {
#pragma unroll
      for (int qt = 0; qt < 2; ++qt)
#pragma unroll
        for (int kt4 = 0; kt4 < 4; ++kt4) { const float p3 = st[kt4][qt][3]; const float a = (st[kt4][qt][0] + st[kt4][qt][1]) + (st[kt4][qt][2] + p3);
          const float give = (g == 3) ? prev3[qt] : p3; const float up = __shfl(give, (lane + 48) & 63); prev3[qt] = p3;
          float* ip = impg + (size_t)(wave * 32 + qt * 16 + li) * 128 + jt * 16 + kt4 * 4 + g; const float val = a + up;
          if (first_head) *ip = val; else *ip += val; }
    }
    if (MODE != 2) {
      if (MODE != 3) {
#pragma unroll
        for (int dt = 0; dt < 4; ++dt) { o[dt][0] *= alpha[0]; o[dt][1] *= alpha[1]; }
      }
#pragma unroll
      for (int ks2 = 0; ks2 < 2; ++ks2) {
        bf16x8 pf[2];
#pragma unroll
        for (int qt = 0; qt < 2; ++qt) { u32x4 w; w[0] = pk2(st[2 * ks2][qt][0], st[2 * ks2][qt][1]); w[1] = pk2(st[2 * ks2][qt][2], st[2 * ks2][qt][3]);
          w[2] = pk2(st[2 * ks2 + 1][qt][0], st[2 * ks2 + 1][qt][1]); w[3] = pk2(st[2 * ks2 + 1][qt][2], st[2 * ks2 + 1][qt][3]); pf[qt] = __builtin_bit_cast(bf16x8, w); }
        const int rowA = 32 * ks2 + 4 * g + (li >> 2), p_ = li & 3;
#pragma unroll
        for (int dt = 0; dt < 4; ++dt) {
          const int off = rowA * 128 + ((((dt ^ ((rowA >> 1) & 3)) << 1) | (p_ >> 1)) << 4) + 8 * (p_ & 1);
          const s16x4 lo = __builtin_amdgcn_ds_read_tr16_b64_v4i16(LDSP(s16x4, vbuf + off));
          const s16x4 hi = __builtin_amdgcn_ds_read_tr16_b64_v4i16(LDSP(s16x4, vbuf + off + 2048));
          const bf16x8 vf = __builtin_shufflevector(lo, hi, 0, 1, 2, 3, 4, 5, 6, 7);
          o[dt][0] = mfma16(vf, pf[0], o[dt][0]); o[dt][1] = mfma16(vf, pf[1], o[dt][1]);
        }
      }
    }
    if (more) lstore((it + 1) & 1);
    __syncthreads();
  }
#pragma unroll
  for (int qt = 0; qt < 2; ++qt) {
    float lt = lrun[qt]; lt += __shfl_xor(lt, 16); lt += __shfl_xor(lt, 32);
    if (MODE == 2) { m_io[qt] = mrun[qt]; l_io[qt] = lt; }
    else {
      const float inv = (MODE == 3) ? 1.f : (lt > 0.f ? 1.f / lt : 0.f);
#pragma unroll
      for (int dt = 0; dt < 4; ++dt) out(wave * 32 + qt * 16 + li, dt * 16 + g * 4, o[dt][qt] * inv, mrun[qt], lt);
    }
  }
}

struct OutSet { bf16_t* dst; long ld; const bf16_t* gate; long gld; float* lse; long lld;
  DI void operator()(int ql, int d0, f32x4 v, float m, float l) const {
    float gs = 1.f; if (gate) gs = bf2f(gate[ql * gld]);
    u32x2 w; w[0] = pk2(v[0] * gs, v[1] * gs); w[1] = pk2(v[2] * gs, v[3] * gs); *(u32x2*)(dst + ql * ld + d0) = w;
    if (lse && d0 == 0) lse[ql * lld] = (m + __log2f(l)) * 0.69314718056f;
  } };
struct OutAdd { bf16_t* dst; long ld; const bf16_t* gate; long gld;
  DI void operator()(int ql, int d0, f32x4 v, float m, float l) const {
    const float gs = bf2f(gate[ql * gld]); u32x2* p = (u32x2*)(dst + ql * ld + d0); const u32x2 old = *p;
    u32x2 w; w[0] = pk2(__uint_as_float(old[0] << 16) + v[0] * gs, __uint_as_float(old[0] & 0xffff0000u) + v[1] * gs);
    w[1] = pk2(__uint_as_float(old[1] << 16) + v[2] * gs, __uint_as_float(old[1] & 0xffff0000u) + v[3] * gs); *p = w;
  } };

DI bf16_t* lw(char* ws, int l, size_t off) { return (bf16_t*)(ws + OFF_W + (size_t)l * LW_SIZE + off); }

DI int colmap(int map, int n, int nsrc) {
  if (map == 0) return n < nsrc ? n : -1;
  if (map == 1) { const int t = n >> 5, i = n & 31; return i < 16 ? 16 * t + i : 2816 + 16 * t + (i - 16); }
  if (n < 384) return n;
  if (n < C_DV + 384) return 416 + (n - C_DQ);
  if (n < C_NQR) return 1568 + (n - C_NQ);
  if (n < C_KC) return 1568 + (n - C_NQR);
  if (n < C_KPE) return 1952 + (n - C_KC);
  if (n < C_GL) return 384 + (n - C_KPE);
  if (n < C_GL + 18) return 2720 + (n - C_GL);
  return -1;
}

DI void phase_prologue(const Params& P, const Ctx& p, char* smem) {
  const int tid = p.tid;
  const int n_w = P.n_wtiles, n_cb = 4, n_r64 = 256, n_r32 = 128, n_xb = 4096;
  const int total = n_w + n_cb + n_r64 + n_r32 + n_xb;
  for (int t = blockIdx.x; t < total; t += gridDim.x) {
    if (t < n_w) {
      int di = 0;
#pragma unroll 1
      for (int i = 1; i < 24; ++i) if (t >= P.wd[i].tile0) di = i;
      const WDesc d = P.wd[di]; const int lt = t - d.tile0, tn = lt % d.ntn, tk = lt / d.ntn, n0 = tn * 64, k0 = tk * 64;
      float* tile = (float*)smem;
      const int nn = tid & 63; const int sc = colmap(d.map, n0 + nn, d.Nsrc);
#pragma unroll 4
      for (int i = 0; i < 16; ++i) { const int kk = (tid >> 6) + 4 * i; float v = 0.f;
        if (sc >= 0) { v = d.src[(size_t)(k0 + kk) * d.Nsrc + sc]; if (d.kscale) v *= d.kscale[k0 + kk]; }
        tile[kk * 65 + nn] = v; }
      __syncthreads();
      { const int on = tid >> 2, kq = tid & 3; u32x4 w0, w1;
#pragma unroll
        for (int j = 0; j < 4; ++j) { w0[j] = pk2(tile[(kq * 16 + 2 * j) * 65 + on], tile[(kq * 16 + 2 * j + 1) * 65 + on]);
          w1[j] = pk2(tile[(kq * 16 + 8 + 2 * j) * 65 + on], tile[(kq * 16 + 8 + 2 * j + 1) * 65 + on]); }
        bf16_t* dp = d.dst + (size_t)(n0 + on) * d.K + k0 + kq * 16; *(u32x4*)dp = w0; *(u32x4*)(dp + 8) = w1; }
      __syncthreads();
    } else if (t < n_w + n_cb) {
      const int id = t - n_w; const float* pos = p.cmp_pos + (size_t)id * 2048; const float* w1 = p.cmp_w1 + (size_t)id * 2048 * 256; float a = 0.f;
      for (int k = 0; k < 2048; ++k) a += pos[k] * w1[(size_t)k * 256 + tid];
      ((float*)(p.ws + OFF_CBIAS))[id * 256 + tid] = a;
    } else if (t < n_w + n_cb + n_r64) {
      const int e0 = (t - n_w - n_cb) * 1024; float* C = (float*)(p.ws + OFF_C64); float* Sn = (float*)(p.ws + OFF_S64);
      for (int e = e0 + tid; e < e0 + 1024; e += 256) { const int pos = e >> 5, i = e & 31; const float inv = exp2f(-(float)(2 * i) / 64.f * 13.287712379549449f); const float ang = (float)pos * inv;
        sincos_rr(ang, C[e], Sn[e]); }
    } else if (t < n_w + n_cb + n_r64 + n_r32) {
      const int e0 = (t - n_w - n_cb - n_r64) * 1024; float* C = (float*)(p.ws + OFF_C32); float* Sn = (float*)(p.ws + OFF_S32);
      for (int e = e0 + tid; e < e0 + 1024; e += 256) { const int pos = e >> 4, i = e & 15; const float inv = exp2f(-(float)(2 * i) / 32.f * 13.287712379549449f); const float ang = (float)pos * inv;
        sincos_rr(ang, C[e], Sn[e]); }
    } else {
      const size_t e0 = (size_t)(t - n_w - n_cb - n_r64 - n_r32) * 4096 + tid * 16; bf16_t* xb = (bf16_t*)(p.ws + OFF_XB);
      const f32x4 a = *(const f32x4*)(p.x + e0), b = *(const f32x4*)(p.x + e0 + 4), c = *(const f32x4*)(p.x + e0 + 8), d = *(const f32x4*)(p.x + e0 + 12);
      u32x4 w0, w1; w0[0] = pk2(a[0], a[1]); w0[1] = pk2(a[2], a[3]); w0[2] = pk2(b[0], b[1]); w0[3] = pk2(b[2], b[3]);
      w1[0] = pk2(c[0], c[1]); w1[1] = pk2(c[2], c[3]); w1[2] = pk2(d[0], d[1]); w1[3] = pk2(d[2], d[3]);
      *(u32x4*)(xb + e0) = w0; *(u32x4*)(xb + e0 + 8) = w1;
    }
  }
}

DI bool tile_seq(int k, int NT, int total, int& mt, int& nt) {
  const int G = gridDim.x, b = blockIdx.x; const int s = k * G + (b & 7) * (G >> 3) + (b >> 3);
  if (s >= total) return false;
  const int band = s / (16 * NT), r = s - band * 16 * NT; nt = r >> 4; mt = band * 16 + (r & 15); return true;
}
DI void phase_ffn_up(const Ctx& p, int l, int j, char* smem) {
  const ALin al{(const bf16_t*)(p.ws + OFF_XB), D_, T_}; const bf16_t* Bt = lw(p.ws, l, LW_FIN + j * SZ_FIN); const EpiSwiGLU epi{(bf16_t*)(p.ws + OFF_BIG)};
  for (int k = 0;; ++k) { int mt, nt; if (!tile_seq(k, 44, 128 * 44, mt, nt)) break; gemm_tile(p.tid, al, Bt, D_, 5632, D_, mt * 128, nt * 128, epi, smem); }
}
DI void phase_ffn_down(const Ctx& p, int l, int j, char* smem) {
  const ALin al{(const bf16_t*)(p.ws + OFF_BIG), F_, T_}; const bf16_t* Bt = lw(p.ws, l, LW_FOUT + j * SZ_FOUT);
  const EpiResid epi{(l == 0 && j == 0) ? p.x : p.out, p.out, 0.5f};
  for (int k = 0;; ++k) { int mt, nt; if (!tile_seq(k, 8, 128 * 8, mt, nt)) break; gemm_tile(p.tid, al, Bt, F_, D_, F_, mt * 128, nt * 128, epi, smem); }
}
DI void phase_wout(const Ctx& p, int l, char* smem) {
  const ALin al{(const bf16_t*)(p.ws + OFF_XB), D_, T_}; const bf16_t* Bt = lw(p.ws, l, LW_WOUT); const EpiResid epi{p.out, p.out, 1.0f};
  for (int k = 0;; ++k) { int mt, nt; if (!tile_seq(k, 8, 128 * 8, mt, nt)) break; gemm_tile(p.tid, al, Bt, D_, D_, D_, mt * 128, nt * 128, epi, smem); }
}
DI void phase_ln(const Ctx& p, int l, int j, bool zero_o) {
  const int lane = p.tid & 63, wave = p.tid >> 6; const float* gp = p.ln_g + (size_t)(l * 3 + j) * D_; const float* bp = p.ln_b + (size_t)(l * 3 + j) * D_;
  bf16_t* xb = (bf16_t*)(p.ws + OFF_XB);
  for (int t = blockIdx.x; t < T_ / 4; t += gridDim.x) {
    const int row = t * 4 + wave; float* yr = p.out + (size_t)row * D_; f32x4 v[4]; float s = 0.f;
#pragma unroll
    for (int i = 0; i < 4; ++i) { v[i] = *(const f32x4*)(yr + i * 256 + lane * 4); s += (v[i][0] + v[i][1]) + (v[i][2] + v[i][3]); }
#pragma unroll
    for (int o = 1; o < 64; o <<= 1) s += __shfl_xor(s, o);
    const float mu = s * (1.f / D_); float q = 0.f;
#pragma unroll
    for (int i = 0; i < 4; ++i)
#pragma unroll
      for (int e = 0; e < 4; ++e) { const float d = v[i][e] - mu; q += d * d; }
#pragma unroll
    for (int o = 1; o < 64; o <<= 1) q += __shfl_xor(q, o);
    const float rstd = rsqrtf(q * (1.f / D_) + 1e-5f);
#pragma unroll
    for (int i = 0; i < 4; ++i) { const int c = i * 256 + lane * 4; const f32x4 gg = *(const f32x4*)(gp + c), bb = *(const f32x4*)(bp + c); f32x4 r;
#pragma unroll
      for (int e = 0; e < 4; ++e) r[e] = (v[i][e] - mu) * rstd * gg[e] + bb[e];
      *(f32x4*)(yr + c) = r; u32x2 w; w[0] = pk2(r[0], r[1]); w[1] = pk2(r[2], r[3]); *(u32x2*)(xb + (size_t)row * D_ + c) = w; }
  }
}
DI void phase_win(const Ctx& p, int l, char* smem) {
  const ALin al{(const bf16_t*)(p.ws + OFF_XB), D_, T_}; const bf16_t* Bt = lw(p.ws, l, LW_WIN);
  const EpiProj epi{(bf16_t*)(p.ws + OFF_BIG), (bf16_t*)(p.ws + OFF_KA), (const float*)(p.ws + OFF_C64), (const float*)(p.ws + OFF_S64), (const float*)(p.ws + OFF_C32), (const float*)(p.ws + OFF_S32)};
  for (int k = 0;; ++k) { int mt, nt; if (!tile_seq(k, 25, 128 * 25, mt, nt)) break; gemm_tile(p.tid, al, Bt, D_, PW, D_, mt * 128, nt * 128, epi, smem); }
}

DI int next_item(const int tid, unsigned* ctr, char* smem) {
  int* slot = (int*)(smem + 69632 - 16);
  __syncthreads();
  if (tid == 0) *slot = (int)atomicAdd(ctr, 1u);
  __syncthreads();
  return *slot;
}

DI void item_dilated(const Ctx& p, int id, char* smem) {
  const int pat = id / 768, r1 = id % 768, b = r1 / 384, r2 = r1 % 384, h = r2 >> 6, blk = r2 & 63;
  const int dil = pat == 0 ? 1 : (pat == 1 ? 4 : 16), nsub = 64 / dil, rho = blk / nsub, i = blk % nsub;
  const bf16_t* proj = (const bf16_t*)(p.ws + OFF_BIG); const bf16_t* base = proj + (size_t)(b * S_ + rho) * PW; const long rs = (long)dil * PW;
  bf16_t* dst = (bf16_t*)(p.ws + OFF_DILO) + ((size_t)pat * T_ + b * S_ + rho + (size_t)dil * 128 * i) * 384 + h * 64;
  float* lse = (float*)(p.ws + OFF_DILL) + ((size_t)pat * T_ + b * S_ + rho + (size_t)dil * 128 * i) * 6 + h;
  const OutSet out{dst, (long)dil * 384, nullptr, 0, lse, (long)dil * 6}; float mm[2], ll[2];
  attn_core<64, 1>(p.tid, base + C_DQ + h * 64, rs, base + C_DK + h * 64, rs, base + C_DV + h * 64, rs, 128 * i, 128 * i - 128, S_ / dil - 1, 4, nullptr,
                   0.125f * 1.44269504089f, 128, nullptr, nullptr, false, mm, ll, out, smem);
}
DI void item_nsawin(const Ctx& p, int id, char* smem) {
  const int b = id / 384, r = id % 384, h = r >> 6, i = r & 63, g = h / 3;
  const bf16_t* proj = (const bf16_t*)(p.ws + OFF_BIG); const bf16_t* base = proj + (size_t)(b * S_) * PW;
  bf16_t* o = (bf16_t*)(p.ws + OFF_XB) + (size_t)(b * S_ + 128 * i) * D_ + 640 + h * 64;
  const OutSet out{o, D_, base + (size_t)(128 * i) * PW + C_GL + h * 3 + 2, PW, nullptr, 0}; float mm[2], ll[2];
  attn_core<64, 1>(p.tid, base + C_NQR + h * 64, PW, base + C_KW + g * 64, PW, base + C_VW + g * 64, PW, 128 * i, 128 * i - 512, S_ - 1, 10, nullptr,
                   0.125f * 1.44269504089f, 512, nullptr, nullptr, false, mm, ll, out, smem);
}
DI void item_expand(const Ctx& p, int l, int id, char* smem) {
  const bf16_t* proj = (const bf16_t*)(p.ws + OFF_BIG); float* rs = (float*)(smem + 65536);
  const bool isq = id < 384; const int lid = isq ? id : id - 384; const int mt = isq ? lid / 3 : lid >> 2, nt = isq ? lid % 3 : lid & 3;
  const int K = isq ? 256 : 128, cb = isq ? C_CQ : C_CKV, tid = p.tid;
  { const int row = tid >> 1, half = tid & 1; const bf16_t* rp = proj + (size_t)(mt * 128 + row) * PW + cb + half * (K / 2); float ss = 0.f;
    for (int c = 0; c < K / 2; c += 8) { const u32x4 w = *(const u32x4*)(rp + c);
#pragma unroll
      for (int e = 0; e < 4; ++e) { const float a = __uint_as_float(w[e] << 16), b2 = __uint_as_float(w[e] & 0xffff0000u); ss += a * a + b2 * b2; } }
    ss += __shfl_xor(ss, 1); if (half == 0) rs[row] = rsqrtf(ss / (float)K + 1e-6f); }
  __syncthreads();
  const ALin al{proj + cb, PW, T_};
  if (isq) { const EpiMLAq epi{(bf16_t*)(p.ws + OFF_QA), rs, mt * 128, (const float*)(p.ws + OFF_C32), (const float*)(p.ws + OFF_S32)};
    gemm_tile(p.tid, al, lw(p.ws, l, LW_UQ), 256, 384, 256, mt * 128, nt * 128, epi, smem); }
  else { const EpiMLAkv epi{(bf16_t*)(p.ws + OFF_KA), (bf16_t*)(p.ws + OFF_VA), rs, mt * 128};
    gemm_tile(p.tid, al, lw(p.ws, l, LW_UKV), 128, 512, 128, mt * 128, nt * 128, epi, smem); }
}
DI void item_cmp1(const Ctx& p, int l, int id, char* smem) {
  const int kv = id >> 5, mt = (id >> 1) & 15, nt = id & 1; const ACmp al{(const bf16_t*)(p.ws + OFF_BIG), kv ? C_VC : C_KC};
  const EpiCmp1 epi{(bf16_t*)(p.ws + OFF_CHID) + (size_t)kv * 2048 * 256, (const float*)(p.ws + OFF_CBIAS) + (l * 2 + kv) * 256};
  gemm_tile(p.tid, al, lw(p.ws, l, LW_C1 + kv * SZ_C1), 2048, 256, 2048, mt * 128, nt * 128, epi, smem);
}
DI void item_cmp2(const Ctx& p, int l, int id, char* smem) {
  const int kv = id >> 4, mt = id & 15; const ALin al{(const bf16_t*)(p.ws + OFF_CHID) + (size_t)kv * 2048 * 256, 256, 2048};
  const EpiCmp2 epi{(bf16_t*)(p.ws + OFF_KCVC) + (size_t)kv * 2048 * 64};
  gemm_tile(p.tid, al, lw(p.ws, l, LW_C2 + kv * SZ_C2), 256, 64, 256, mt * 128, 0, epi, smem);
}
DI void item_mla(const Ctx& p, int id, char* smem) {
  const int i = 63 - (id >> 3), bh = id & 7, b = bh >> 2, h = bh & 3;
  const bf16_t* qa = (const bf16_t*)(p.ws + OFF_QA) + (size_t)(b * S_) * 384 + h * 96; const bf16_t* ka = (const bf16_t*)(p.ws + OFF_KA) + (size_t)(b * S_) * 384 + h * 96;
  const bf16_t* va = (const bf16_t*)(p.ws + OFF_VA) + (size_t)(b * S_) * 256 + h * 64;
  bf16_t* o = (bf16_t*)(p.ws + OFF_XB) + (size_t)(b * S_ + 128 * i) * D_ + h * 64; const OutSet out{o, D_, nullptr, 0, nullptr, 0}; float mm[2], ll[2];
  attn_core<96, 0>(p.tid, qa, 384, ka, 384, va, 256, 128 * i, 0, S_ - 1, 2 * (i + 1), nullptr, 0.10206207261f * 1.44269504089f, 0, nullptr, nullptr, false, mm, ll, out, smem);
}
DI void item_nsacmp(const Ctx& p, int id, char* smem) {
  const int i = 63 - (id >> 2), bg = id & 3, b = bg >> 1, g = bg & 1, tid = p.tid;
  const bf16_t* proj = (const bf16_t*)(p.ws + OFF_BIG); const bf16_t* base = proj + (size_t)(b * S_) * PW;
  const bf16_t* kc = (const bf16_t*)(p.ws + OFF_KCVC) + (size_t)((b * 2 + g) * NCMP) * 64; const bf16_t* vc = kc + (size_t)2048 * 64;
  float* imp = (float*)(p.ws + OFF_IMP) + ((size_t)((b * 2 + g) * S_) + 128 * i) * 128;
  const int nkt = (i + 8) >> 3;
#pragma unroll 1
  for (int hh = 0; hh < 3; ++hh) { const int h = g * 3 + hh; float mm[2], ll[2];
    bf16_t* o = (bf16_t*)(p.ws + OFF_XB) + (size_t)(b * S_ + 128 * i) * D_ + 640 + h * 64;
    const OutAdd out{o, D_, base + (size_t)(128 * i) * PW + C_GL + h * 3 + 0, PW};
    attn_core<64, 2>(p.tid, base + C_NQ + h * 64, PW, kc, 64, vc, 64, 128 * i, 0, NCMP - 1, nkt, nullptr, 0.125f * 1.44269504089f, 0, nullptr, nullptr, false, mm, ll, out, smem);
    attn_core<64, 3>(p.tid, base + C_NQ + h * 64, PW, kc, 64, vc, 64, 128 * i, 0, NCMP - 1, nkt, nullptr, 0.125f * 1.44269504089f, 0, nullptr, imp, hh == 0, mm, ll, out, smem);
  }
  __syncthreads();
  float* sc = (float*)smem;
  const int q = tid >> 1, half = tid & 1, qpos = 128 * i + q, cur = qpos >> 6;
#pragma unroll 2
  for (int j = half * 64; j < half * 64 + 64; ++j) { const float v = (j < nkt * 16) ? imp[(size_t)q * 128 + j] : 0.f; const bool forced = (j == 0) || (j == cur) || (j == cur - 1);
    sc[q * 129 + j] = forced ? 1e4f : (j <= cur ? v : -1e4f); }
  unsigned m0 = 0, m1 = 0, m2 = 0, m3 = 0;
#pragma unroll 1
  for (int rd = 0; rd < 16; ++rd) {
    float bv = -3e38f; int bj = half * 64;
#pragma unroll 4
    for (int j = half * 64; j < half * 64 + 64; ++j) { const float v = sc[q * 129 + j]; if (v > bv) { bv = v; bj = j; } }
    const float ov = __shfl_xor(bv, 1); const int oj = __shfl_xor(bj, 1);
    if (ov > bv || (ov == bv && oj < bj)) { bv = ov; bj = oj; }
    if ((bj >> 6) == half) sc[q * 129 + bj] = -3.2e38f;
    if (bj <= cur) { const unsigned bit = 1u << (bj & 31); const int w = bj >> 5; m0 |= (w == 0) ? bit : 0u; m1 |= (w == 1) ? bit : 0u; m2 |= (w == 2) ? bit : 0u; m3 |= (w == 3) ? bit : 0u; }
  }
  if (half == 0) { u32x4 w; w[0] = m0; w[1] = m1; w[2] = m2; w[3] = m3; *(u32x4*)((unsigned*)(p.ws + OFF_SEL) + ((size_t)(b * S_ + qpos) * 2 + g) * 4) = w; }
  __syncthreads();
}
DI void item_dilcombine(const Ctx& p, int id) {
  const size_t e = (size_t)id * 256 + p.tid; const int tok = (int)(e / 48), r = (int)(e % 48), h = r >> 3, d0 = (r & 7) * 8;
  const float* L = (const float*)(p.ws + OFF_DILL); const bf16_t* O = (const bf16_t*)(p.ws + OFF_DILO);
  const float l0 = L[(size_t)tok * 6 + h], l1 = L[((size_t)T_ + tok) * 6 + h], l2 = L[((size_t)2 * T_ + tok) * 6 + h]; const float mx = fmaxf(l0, fmaxf(l1, l2));
  float w0 = __expf(l0 - mx), w1 = __expf(l1 - mx), w2 = __expf(l2 - mx); const float inv = 1.f / (w0 + w1 + w2); w0 *= inv; w1 *= inv; w2 *= inv;
  const u32x4 a = *(const u32x4*)(O + (size_t)tok * 384 + h * 64 + d0), b = *(const u32x4*)(O + ((size_t)T_ + tok) * 384 + h * 64 + d0), c = *(const u32x4*)(O + ((size_t)2 * T_ + tok) * 384 + h * 64 + d0);
  u32x4 w;
#pragma unroll
  for (int k = 0; k < 4; ++k) { const float lo = w0 * __uint_as_float(a[k] << 16) + w1 * __uint_as_float(b[k] << 16) + w2 * __uint_as_float(c[k] << 16);
    const float hi = w0 * __uint_as_float(a[k] & 0xffff0000u) + w1 * __uint_as_float(b[k] & 0xffff0000u) + w2 * __uint_as_float(c[k] & 0xffff0000u); w[k] = pk2(lo, hi); }
  *(u32x4*)((bf16_t*)(p.ws + OFF_XB) + (size_t)tok * D_ + 256 + h * 64 + d0) = w;
}
DI void item_nsaslc(const Ctx& p, int id, char* smem) {
  const int i = 63 - id / 12, r = id % 12, b = r / 6, h = r % 6, g = h / 3, tid = p.tid;
  const bf16_t* proj = (const bf16_t*)(p.ws + OFF_BIG); const bf16_t* base = proj + (size_t)(b * S_) * PW;
  unsigned* selw = (unsigned*)(smem + 49152 + 2048); int* tlist = (int*)(smem + 49152); unsigned* un = (unsigned*)(smem + 49152 + 1024);
  __syncthreads();
  if (tid < 4) un[tid] = 0u;
  __syncthreads();
  if (tid < 128) { const u32x4 w = *(const u32x4*)((const unsigned*)(p.ws + OFF_SEL) + ((size_t)(b * S_ + 128 * i + tid) * 2 + g) * 4);
    selw[tid * 4 + 0] = w[0]; selw[tid * 4 + 1] = w[1]; selw[tid * 4 + 2] = w[2]; selw[tid * 4 + 3] = w[3];
    atomicOr(&un[0], w[0]); atomicOr(&un[1], w[1]); atomicOr(&un[2], w[2]); atomicOr(&un[3], w[3]); }
  __syncthreads();
  if (tid == 0) { int n = 0; for (int jt = 0; jt < 2 * (i + 1); ++jt) if ((un[jt >> 5] >> (jt & 31)) & 1u) tlist[n++] = jt; tlist[255] = n; }
  __syncthreads();
  const int nt = tlist[255];
  bf16_t* o = (bf16_t*)(p.ws + OFF_XB) + (size_t)(b * S_ + 128 * i) * D_ + 640 + h * 64;
  const OutAdd out{o, D_, base + (size_t)(128 * i) * PW + C_GL + h * 3 + 1, PW}; float mm[2], ll[2];
  attn_core<64, 4>(p.tid, base + C_NQR + h * 64, PW, base + C_KSL + g * 64, PW, base + C_VSL + g * 64, PW, 128 * i, 0, S_ - 1, nt, tlist, 0.125f * 1.44269504089f, 0, selw, nullptr, false, mm, ll, out, smem);
}

DI void phase_mix_a(const Ctx& p0, int l, char* smem, int ci) {
  unsigned* ctr = (unsigned*)(p0.ws + OFF_CTRL) + l * 8 + ci; const int total = 768 + 2304 + 896 + 64;
  for (;;) { Ctx q = p0; asm volatile("" : "+v"(q.tid)); const Ctx& p = q; const int t = next_item(p.tid, ctr, smem); if (t >= total) break;
    if (t < 768) item_nsawin(p, t, smem); else if (t < 768 + 2304) item_dilated(p, t - 768, smem);
    else if (t < 768 + 2304 + 896) item_expand(p, l, t - 768 - 2304, smem); else item_cmp1(p, l, t - 768 - 2304 - 896, smem); }
}
DI void phase_mix_b(const Ctx& p0, int l, char* smem, int ci) {
  unsigned* ctr = (unsigned*)(p0.ws + OFF_CTRL) + l * 8 + ci; const int total = 512 + 32;
  for (;;) { Ctx q = p0; asm volatile("" : "+v"(q.tid)); const Ctx& p = q; const int t = next_item(p.tid, ctr, smem); if (t >= total) break; if (t < 512) item_mla(p, t, smem); else item_cmp2(p, l, t - 512, smem); }
}
DI void phase_mix_c(const Ctx& p0, int l, char* smem) {
  unsigned* ctr = (unsigned*)(p0.ws + OFF_CTRL) + l * 8 + 2; const int total = 256 + 3072;
  for (;;) { Ctx q = p0; asm volatile("" : "+v"(q.tid)); const Ctx& p = q; const int t = next_item(p.tid, ctr, smem); if (t >= total) break; if (t < 256) item_nsacmp(p, t, smem); else item_dilcombine(p, t - 256); }
}
DI void phase_mix_d(const Ctx& p0, int l, char* smem) {
  unsigned* ctr = (unsigned*)(p0.ws + OFF_CTRL) + l * 8 + 3; const int total = 768;
  for (;;) { Ctx q = p0; asm volatile("" : "+v"(q.tid)); const Ctx& p = q; const int t = next_item(p.tid, ctr, smem); if (t >= total) break; item_nsaslc(p, t, smem); }
}
DI void phase_zero_o(const Ctx& p) {
  u32x4* o = (u32x4*)(p.ws + OFF_XB); const u32x4 z = (u32x4){0u, 0u, 0u, 0u};
  for (size_t e = (size_t)blockIdx.x * 256 + p.tid; e < (size_t)T_ * D_ / 8; e += (size_t)gridDim.x * 256) o[e] = z;
}

DI void run_phase(const Params& P, int ph, char* smem) {
  Ctx p; p.x = P.x; p.ln_g = P.ln_g; p.ln_b = P.ln_b; p.cmp_pos = P.cmp_pos; p.cmp_w1 = P.cmp_w1; p.out = P.out; p.ws = P.ws; p.tid = threadIdx.x;
  asm volatile("" : "+v"(p.tid));
  if (ph == 0) { phase_prologue(P, p, smem); return; }
  const int l = (ph - 1) / 13; int s = (ph - 1) % 13;
#ifdef ONLY_S
  if (s != ONLY_S) return;
  s = ONLY_S;
#endif
  switch (s) {
    case 0: phase_ffn_up(p, l, 0, smem);
#if PROBE_REP == 1
      __syncthreads(); phase_ffn_up(p, l, 0, smem);
#endif
      break;
    case 1: phase_ffn_down(p, l, 0, smem); break;
    case 2: phase_ln(p, l, 0, false); break;
#if ENABLE_MIX
    case 3: phase_win(p, l, smem); break;
    case 4: phase_mix_a(p, l, smem, 0);
#if PROBE_REP == 2
      phase_mix_a(p, l, smem, 4);
#endif
      break;
    case 5: phase_mix_b(p, l, smem, 1);
#if PROBE_REP == 3
      phase_mix_b(p, l, smem, 5);
#endif
      break;
    case 6: phase_mix_c(p, l, smem); break;
    case 7: phase_mix_d(p, l, smem); break;
#else
    case 3: phase_zero_o(p); break;
    case 4: case 5: case 6: case 7: break;
#endif
    case 8: phase_wout(p, l, smem); break;
    case 9: phase_ln(p, l, 1, false); break;
    case 10: phase_ffn_up(p, l, 1, smem);
#if PROBE_REP == 1
      __syncthreads(); phase_ffn_up(p, l, 1, smem);
#endif
      break;
    case 11: phase_ffn_down(p, l, 1, smem); break;
    case 12: phase_ln(p, l, 2, false); break;
  }
}
constexpr int NPHASE = 27;

#if ONE_LAUNCH
DI unsigned xb_ld(unsigned* p) { return __hip_atomic_load(p, __ATOMIC_RELAXED, __HIP_MEMORY_SCOPE_AGENT); }
DI unsigned xb_add(unsigned* p, unsigned v) { return __hip_atomic_fetch_add(p, v, __ATOMIC_RELAXED, __HIP_MEMORY_SCOPE_AGENT); }
DI void xb_st(unsigned* p, unsigned v) { __hip_atomic_store(p, v, __ATOMIC_RELAXED, __HIP_MEMORY_SCOPE_AGENT); }
constexpr int XB_CNT = 256, XB_SUB = 256 + 64 * 16, XB_GEN = 256 + 64 * 32, XB_TOP = 256 + 64 * 48, XB_TOPGEN = 256 + 64 * 49, XB_WORDS = 256 + 64 * 50;
DI void grid_bar(const Params& P, unsigned idx, char* smem) {
  asm volatile("s_waitcnt vmcnt(0)" ::: "memory");
  __syncthreads();
  int t = threadIdx.x; asm volatile("" : "+v"(t));
  if (t == 0) {
    unsigned* bar = (unsigned*)(P.ws + OFF_CTRL);
    volatile unsigned* st = (volatile unsigned*)(smem + 69632 - 16);
    const unsigned x = st[1], nloc = st[2], nx = st[3];
    const unsigned old = xb_add(&bar[XB_SUB + 64 * x], 1u);
    if (old + 1u == idx * nloc) {
      __builtin_amdgcn_fence(__ATOMIC_RELEASE, "agent");
      asm volatile("s_waitcnt vmcnt(0)" ::: "memory");
      const unsigned og = xb_add(&bar[XB_TOP], 1u);
      if (og + 1u == idx * nx) xb_st(&bar[XB_TOPGEN], idx);
      else { while (xb_ld(&bar[XB_TOPGEN]) < idx) __builtin_amdgcn_s_sleep(1); }
      xb_st(&bar[XB_GEN + 64 * x], idx);
    } else { while (xb_ld(&bar[XB_GEN + 64 * x]) < idx) __builtin_amdgcn_s_sleep(1); }
    __builtin_amdgcn_fence(__ATOMIC_ACQUIRE, "agent");
    asm volatile("s_waitcnt vmcnt(0)" ::: "memory");
  }
  __syncthreads();
}
template <int PH> DI void run_all(const Params& p, char* smem) {
  run_phase(p, PH, smem);
  if constexpr (PH + 1 < NPHASE) { grid_bar(p, PH + 1, smem); run_all<PH + 1>(p, smem); }
}
__global__ void __launch_bounds__(256, 2) mega_kernel(Params p) {
  __shared__ __attribute__((aligned(16))) char smem[69632];
  {
    unsigned* bar = (unsigned*)(p.ws + OFF_CTRL); volatile unsigned* st = (volatile unsigned*)(smem + 69632 - 16);
    const unsigned x = (unsigned)__builtin_amdgcn_s_getreg((3 << 11) | 20) & 0xFu;
    if (threadIdx.x == 0) xb_add(&bar[XB_CNT + 64 * x], 1u);
    cg::this_grid().sync();
    if (threadIdx.x == 0) { unsigned nx = 0, mine = 1;
      for (unsigned j = 0; j < 16; ++j) { const unsigned c = xb_ld(&bar[XB_CNT + 64 * j]); nx += (c > 0u) ? 1u : 0u; if (j == x) mine = c; }
      st[1] = x; st[2] = mine; st[3] = nx; }
    __syncthreads();
  }
  run_all<0>(p, smem);
}
#define MAIN_KERNEL mega_kernel
#else
#define MAIN_KERNEL phase_kernel
#endif
__global__ void __launch_bounds__(256, 2) phase_kernel(Params p, int ph) {
  __shared__ __attribute__((aligned(16))) char smem[69632];
  run_phase(p, ph, smem);
}

extern "C" void kernel_launch(void* const* d_in, const int* in_sizes, int n_in, void* d_out, int out_size, void* d_ws, size_t ws_size, hipStream_t stream) {
  static int grid_blocks = 0;
  if (!grid_blocks) { int dev = 0, cus = 0, per_cu = 0; hipGetDevice(&dev); hipDeviceGetAttribute(&cus, hipDeviceAttributeMultiprocessorCount, dev);
    hipOccupancyMaxActiveBlocksPerMultiprocessor(&per_cu, MAIN_KERNEL, 256, 0); if (per_cu > 2) per_cu = 2; if (per_cu < 1) per_cu = 1; grid_blocks = cus * per_cu; }
  if (ws_size < OFF_END) { fprintf(stderr, "workspace too small: %zu < %zu\n", ws_size, (size_t)OFF_END); return; }
  Params p; memset(&p, 0, sizeof(p));
  const float* x = (const float*)d_in[0]; const float* ffn_in = (const float*)d_in[1]; const float* ffn_out = (const float*)d_in[2];
  const float* w_in = (const float*)d_in[5]; const float* w_out = (const float*)d_in[6]; const float* qn = (const float*)d_in[7]; const float* kvn = (const float*)d_in[8];
  const float* wuq = (const float*)d_in[9]; const float* wukv = (const float*)d_in[10]; const float* cw1 = (const float*)d_in[12]; const float* cw2 = (const float*)d_in[13];
  p.x = x; p.ln_g = (const float*)d_in[3]; p.ln_b = (const float*)d_in[4]; p.cmp_pos = (const float*)d_in[11]; p.cmp_w1 = cw1; p.out = (float*)d_out; p.ws = (char*)d_ws;
  int tile0 = 0, di = 0;
  auto add = [&](const float* src, size_t dst_off, const float* ksc, int K, int Nsrc, int Ndst, int map) {
    WDesc& d = p.wd[di++]; d.src = src; d.dst = (bf16_t*)((char*)d_ws + dst_off); d.kscale = ksc; d.K = K; d.Nsrc = Nsrc; d.Ndst = Ndst; d.map = map; d.tile0 = tile0; d.ntn = Ndst / 64;
    tile0 += (Ndst / 64) * (K / 64); };
  for (int l = 0; l < 2; ++l) { const size_t wb = OFF_W + (size_t)l * LW_SIZE;
    for (int j = 0; j < 2; ++j) add(ffn_in + (size_t)(l * 2 + j) * 1024 * 5632, wb + LW_FIN + j * SZ_FIN, nullptr, 1024, 5632, 5632, 1);
    for (int j = 0; j < 2; ++j) add(ffn_out + (size_t)(l * 2 + j) * 2816 * 1024, wb + LW_FOUT + j * SZ_FOUT, nullptr, 2816, 1024, 1024, 0);
    add(w_in + (size_t)l * 1024 * 2738, wb + LW_WIN, nullptr, 1024, 2738, PW, 2);
    add(w_out + (size_t)l * 1024 * 1024, wb + LW_WOUT, nullptr, 1024, 1024, 1024, 0);
    add(wuq + (size_t)l * 256 * 384, wb + LW_UQ, qn + l * 256, 256, 384, 384, 0);
    add(wukv + (size_t)l * 128 * 512, wb + LW_UKV, kvn + l * 128, 128, 512, 512, 0);
    for (int kv = 0; kv < 2; ++kv) add(cw1 + (size_t)(l * 2 + kv) * 2048 * 256, wb + LW_C1 + kv * SZ_C1, nullptr, 2048, 256, 256, 0);
    for (int kv = 0; kv < 2; ++kv) add(cw2 + (size_t)(l * 2 + kv) * 256 * 64, wb + LW_C2 + kv * SZ_C2, nullptr, 256, 64, 64, 0);
  }
  p.n_wtiles = tile0;
  hipMemsetAsync((char*)d_ws + OFF_CTRL, 0, 16384, stream);
#if ONE_LAUNCH
  void* args[] = {&p};
  hipError_t e = hipLaunchCooperativeKernel((void*)mega_kernel, dim3(grid_blocks), dim3(256), args, 0, stream);
  if (e != hipSuccess) fprintf(stderr, "cooperative launch failed: %s (grid %d)\n", hipGetErrorString(e), grid_blocks);
#else
  for (int ph = 0; ph < NPHASE; ++ph) phase_kernel<<<dim3(grid_blocks), dim3(256), 0, stream>>>(p, ph);
#endif
}
```

```cpp
#include <hip/hip_runtime.h>
#include <hip/hip_cooperative_groups.h>
#include <cstdio>
#include <cstdint>
#include <cstring>
namespace cg = cooperative_groups;

typedef unsigned short bf16_t;
typedef short bf16x8 __attribute__((ext_vector_type(8)));
typedef short s16x4 __attribute__((ext_vector_type(4)));
typedef float f32x4 __attribute__((ext_vector_type(4)));
typedef unsigned u32x4 __attribute__((ext_vector_type(4)));
typedef unsigned u32x2 __attribute__((ext_vector_type(2)));
#define DI __device__ __forceinline__
#define LDSP(T, p) ((__attribute__((address_space(3))) T*)(p))

#ifndef ENABLE_MIX
#define ENABLE_MIX 1
#endif
#ifndef PROBE_REP
#define PROBE_REP 0
#endif
#ifndef ONE_LAUNCH
#define ONE_LAUNCH 1
#endif

constexpr int T_ = 16384, S_ = 8192, D_ = 1024, F_ = 2816, PW = 3200;
constexpr float ALPHA = 1.41421356237f;
constexpr int C_CQ = 0, C_CKV = 256, C_DQ = 384, C_DK = 768, C_DV = 1152, C_NQ = 1536, C_NQR = 1920, C_KC = 2304, C_VC = 2432,
              C_KSL = 2560, C_VSL = 2688, C_KW = 2816, C_VW = 2944, C_KPE = 3072, C_GL = 3104;
constexpr int NCMP = 511;

constexpr size_t SZ_FIN = 5632ull * 1024 * 2, SZ_FOUT = 1024ull * 2816 * 2, SZ_WIN = (size_t)PW * 1024 * 2, SZ_WOUT = 1024ull * 1024 * 2,
                 SZ_UQ = 384ull * 256 * 2, SZ_UKV = 512ull * 128 * 2, SZ_C1 = 256ull * 2048 * 2, SZ_C2 = 64ull * 256 * 2;
constexpr size_t LW_FIN = 0, LW_FOUT = LW_FIN + 2 * SZ_FIN, LW_WIN = LW_FOUT + 2 * SZ_FOUT, LW_WOUT = LW_WIN + SZ_WIN, LW_UQ = LW_WOUT + SZ_WOUT,
                 LW_UKV = LW_UQ + SZ_UQ, LW_C1 = LW_UKV + SZ_UKV, LW_C2 = LW_C1 + 2 * SZ_C1, LW_SIZE = LW_C2 + 2 * SZ_C2;
constexpr size_t OFF_CTRL = 0, OFF_C64 = 16384, OFF_S64 = OFF_C64 + 8192ull * 32 * 4, OFF_C32 = OFF_S64 + 8192ull * 32 * 4, OFF_S32 = OFF_C32 + 8192ull * 16 * 4,
                 OFF_CBIAS = OFF_S32 + 8192ull * 16 * 4, OFF_W = OFF_CBIAS + 4096, OFF_XB = OFF_W + 2 * LW_SIZE, OFF_BIG = OFF_XB + (size_t)T_ * D_ * 2,
                 OFF_QA = OFF_BIG + (size_t)T_ * PW * 2, OFF_KA = OFF_QA + (size_t)T_ * 384 * 2, OFF_VA = OFF_KA + (size_t)T_ * 384 * 2,
                 OFF_DILO = OFF_VA + (size_t)T_ * 256 * 2, OFF_DILL = OFF_DILO + 3ull * T_ * 384 * 2, OFF_CHID = OFF_DILL + 3ull * T_ * 6 * 4,
                 OFF_KCVC = OFF_CHID + 2ull * 2048 * 256 * 2, OFF_SEL = OFF_KCVC + 2ull * 2048 * 64 * 2, OFF_IMP = OFF_SEL + (size_t)T_ * 2 * 4 * 4,
                 OFF_END = OFF_IMP + (size_t)T_ * 2 * 128 * 4;

struct WDesc { const float* src; bf16_t* dst; const float* kscale; int K, Nsrc, Ndst, map, tile0, ntn; };
struct Params {
  const float* x; const float* ln_g; const float* ln_b; const float* cmp_pos; const float* cmp_w1;
  float* out; char* ws;
  WDesc wd[24];
  int n_wtiles; int pad0;
};
struct Ctx { const float* x; const float* ln_g; const float* ln_b; const float* cmp_pos; const float* cmp_w1; float* out; char* ws; int tid; };

DI bf16_t f2bf(float x) { unsigned u = __float_as_uint(x); u += 0x7fffu + ((u >> 16) & 1u); return (bf16_t)(u >> 16); }
DI float bf2f(bf16_t v) { return __uint_as_float(((unsigned)v) << 16); }
DI unsigned pk2(float a, float b) { return (unsigned)f2bf(a) | ((unsigned)f2bf(b) << 16); }
DI float fast_exp2(float x) { return __builtin_amdgcn_exp2f(x); }
DI float silu(float v) { return v * __builtin_amdgcn_rcpf(1.f + __expf(-v)); }
DI f32x4 mfma16(bf16x8 a, bf16x8 b, f32x4 c) { return __builtin_amdgcn_mfma_f32_16x16x32_bf16(a, b, c, 0, 0, 0); }

DI void sincos_rr(float ang, float& c, float& s) {
  const double rev = (double)ang * 0.15915494309189533577; const float fr = (float)(rev - rint(rev));
  c = __builtin_amdgcn_cosf(fr); s = __builtin_amdgcn_sinf(fr);
}

struct ALin { const bf16_t* A; int lda; int mmax; DI const bf16_t* ptr(int row, int k) const { row = row < mmax ? row : mmax - 1; return A + (size_t)row * lda + k; } };
struct ACmp {
  const bf16_t* proj; int colbase;
  DI const bf16_t* ptr(int m, int k) const { if (m > 2043) m = 2043; int b = m / 1022, rem = m - b * 1022, g = rem / 511, c = rem - g * 511;
    return proj + (size_t)(b * S_ + 16 * c + (k >> 6)) * PW + colbase + g * 64 + (k & 63); } };

template <class AL, class EPI>
DI void gemm_tile(const int tid, const AL al, const bf16_t* __restrict__ Bt, int ldb, int nvalid, int K, int m0, int n0, const EPI epi, char* smem) {
  const int lane = tid & 63, wave = tid >> 6, wr = wave >> 1, wc = wave & 1, g = lane >> 4;
  f32x4 acc[4][4];
#pragma unroll
  for (int i = 0; i < 4; ++i)
#pragma unroll
    for (int j = 0; j < 4; ++j) acc[i][j] = (f32x4){0.f, 0.f, 0.f, 0.f};
  const int srow = wave * 32 + (lane >> 3), sc8 = ((lane & 7) ^ (lane >> 3)) * 8;
  const bf16_t* bp[4];
#pragma unroll
  for (int i = 0; i < 4; ++i) { int r = n0 + srow + 8 * i; r = r < nvalid ? r : nvalid - 1; bp[i] = Bt + (size_t)r * ldb + sc8; }
  const int offA = (wr * 64 + (lane & 15)) * 128 + ((g ^ (lane & 7)) << 4);
  const int offB = (wc * 64 + (lane & 15)) * 128 + ((g ^ (lane & 7)) << 4);
  const int nk = K >> 6;
  auto stage = [&](int kt, int buf) {
    char* da = smem + buf * 32768 + wave * 4096; const int k0 = kt << 6;
#pragma unroll
    for (int i = 0; i < 4; ++i) {
      __builtin_amdgcn_global_load_lds((const unsigned*)al.ptr(m0 + srow + 8 * i, k0 + sc8), LDSP(unsigned, da + i * 1024), 16, 0, 0);
      __builtin_amdgcn_global_load_lds((const unsigned*)(bp[i] + k0), LDSP(unsigned, da + 16384 + i * 1024), 16, 0, 0);
    }
  };
  stage(0, 0);
  asm volatile("s_waitcnt vmcnt(0)" ::: "memory");
  __syncthreads();
  for (int kt = 0; kt < nk; ++kt) {
    if (kt + 1 < nk) stage(kt + 1, (kt + 1) & 1);
    const char* sa = smem + (kt & 1) * 32768; const char* sb = sa + 16384;
#pragma unroll
    for (int ks = 0; ks < 2; ++ks) {
      bf16x8 af[4], bfr[4];
#pragma unroll
      for (int i = 0; i < 4; ++i) { af[i] = *(const bf16x8*)(sa + ((offA + i * 2048) ^ (ks << 6))); bfr[i] = *(const bf16x8*)(sb + ((offB + i * 2048) ^ (ks << 6))); }
#pragma unroll
      for (int i = 0; i < 4; ++i)
#pragma unroll
        for (int j = 0; j < 4; ++j) acc[i][j] = mfma16(af[i], bfr[j], acc[i][j]);
    }
    asm volatile("s_waitcnt vmcnt(0)" ::: "memory");
    __syncthreads();
  }
  epi(acc, m0 + wr * 64, n0 + wc * 64, lane);
}

DI void store_plain(bf16_t* dst, int ld, const f32x4 (&acc)[4][4], int row0, int col0, int lane, float sc) {
#pragma unroll
  for (int mi = 0; mi < 4; ++mi)
#pragma unroll
    for (int r = 0; r < 4; ++r) { const int row = row0 + mi * 16 + (lane >> 4) * 4 + r;
#pragma unroll
      for (int ni = 0; ni < 4; ++ni) dst[(size_t)row * ld + col0 + ni * 16 + (lane & 15)] = f2bf(acc[mi][ni][r] * sc); }
}

struct EpiSwiGLU { bf16_t* H;
  DI void operator()(const f32x4 (&acc)[4][4], int row0, int col0, int lane) const {
#pragma unroll
    for (int mi = 0; mi < 4; ++mi)
#pragma unroll
      for (int r = 0; r < 4; ++r) { const int row = row0 + mi * 16 + (lane >> 4) * 4 + r;
#pragma unroll
        for (int pr = 0; pr < 2; ++pr) { const float gt = acc[mi][2 * pr][r], up = acc[mi][2 * pr + 1][r];
          H[(size_t)row * F_ + ((col0 >> 5) + pr) * 16 + (lane & 15)] = f2bf(silu(gt) * up); } }
  } };
struct EpiResid { const float* xin; float* y; float scale;
  DI void operator()(const f32x4 (&acc)[4][4], int row0, int col0, int lane) const {
#pragma unroll
    for (int mi = 0; mi < 4; ++mi)
#pragma unroll
      for (int r = 0; r < 4; ++r) { const int row = row0 + mi * 16 + (lane >> 4) * 4 + r;
#pragma unroll
        for (int ni = 0; ni < 4; ++ni) { const size_t ix = (size_t)row * D_ + col0 + ni * 16 + (lane & 15); y[ix] = ALPHA * xin[ix] + scale * acc[mi][ni][r]; } }
  } };
struct EpiProj { bf16_t* proj; bf16_t* ka; const float* c64; const float* s64; const float* c32; const float* s32;
  DI void operator()(const f32x4 (&acc)[4][4], int row0, int col0, int lane) const {
    const bool rope = (col0 >= C_DQ && col0 < C_DV) || (col0 >= C_NQR && col0 < C_KC) || (col0 >= C_KSL && col0 < C_VSL) || (col0 >= C_KW && col0 < C_VW);
    if (rope) {
#pragma unroll
      for (int mi = 0; mi < 4; ++mi)
#pragma unroll
        for (int r = 0; r < 4; ++r) { const int row = row0 + mi * 16 + (lane >> 4) * 4 + r, pos = row & (S_ - 1);
#pragma unroll
          for (int ni = 0; ni < 2; ++ni) { const int i = ni * 16 + (lane & 15); const float c = c64[pos * 32 + i], s = s64[pos * 32 + i];
            const float x1 = acc[mi][ni][r], x2 = acc[mi][ni + 2][r];
            proj[(size_t)row * PW + col0 + i] = f2bf(x1 * c - x2 * s); proj[(size_t)row * PW + col0 + 32 + i] = f2bf(x1 * s + x2 * c); } }
    } else if (col0 == C_KPE) {
#pragma unroll
      for (int mi = 0; mi < 4; ++mi)
#pragma unroll
        for (int r = 0; r < 4; ++r) { const int row = row0 + mi * 16 + (lane >> 4) * 4 + r, pos = row & (S_ - 1); const int i = lane & 15;
          const float c = c32[pos * 16 + i], s = s32[pos * 16 + i]; const float x1 = acc[mi][0][r], x2 = acc[mi][1][r];
          const bf16_t o1 = f2bf(x1 * c - x2 * s), o2 = f2bf(x1 * s + x2 * c);
#pragma unroll
          for (int h = 0; h < 4; ++h) { ka[(size_t)row * 384 + h * 96 + 64 + i] = o1; ka[(size_t)row * 384 + h * 96 + 80 + i] = o2; }
#pragma unroll
          for (int ni = 2; ni < 4; ++ni) { const float v = acc[mi][ni][r]; proj[(size_t)row * PW + col0 + ni * 16 + i] = f2bf(1.f / (1.f + __expf(-v))); } }
    } else store_plain(proj, PW, acc, row0, col0, lane, 1.f);
  } };
struct EpiMLAq { bf16_t* qa; const float* rs; int m0; const float* c32; const float* s32;
  DI void operator()(const f32x4 (&acc)[4][4], int row0, int col0, int lane) const {
#pragma unroll
    for (int mi = 0; mi < 4; ++mi)
#pragma unroll
      for (int r = 0; r < 4; ++r) { const int row = row0 + mi * 16 + (lane >> 4) * 4 + r, pos = row & (S_ - 1); const float sc = rs[row - m0]; const int i = lane & 15;
#pragma unroll
        for (int ch = 0; ch < 2; ++ch) { const int gc = col0 + 32 * ch; const float x1 = acc[mi][2 * ch][r] * sc, x2 = acc[mi][2 * ch + 1][r] * sc;
          if (((gc >> 5) % 3) == 2) { const float c = c32[pos * 16 + i], s = s32[pos * 16 + i];
            qa[(size_t)row * 384 + gc + i] = f2bf(x1 * c - x2 * s); qa[(size_t)row * 384 + gc + 16 + i] = f2bf(x1 * s + x2 * c); }
          else { qa[(size_t)row * 384 + gc + i] = f2bf(x1); qa[(size_t)row * 384 + gc + 16 + i] = f2bf(x2); } } }
  } };
struct EpiMLAkv { bf16_t* ka; bf16_t* va; const float* rs; int m0;
  DI void operator()(const f32x4 (&acc)[4][4], int row0, int col0, int lane) const {
    const int h = col0 >> 7, part = (col0 >> 6) & 1;
#pragma unroll
    for (int mi = 0; mi < 4; ++mi)
#pragma unroll
      for (int r = 0; r < 4; ++r) { const int row = row0 + mi * 16 + (lane >> 4) * 4 + r; const float sc = rs[row - m0];
#pragma unroll
        for (int ni = 0; ni < 4; ++ni) { const int j = ni * 16 + (lane & 15); const bf16_t v = f2bf(acc[mi][ni][r] * sc);
          if (part == 0) ka[(size_t)row * 384 + h * 96 + j] = v; else va[(size_t)row * 256 + h * 64 + j] = v; } }
  } };
struct EpiCmp1 { bf16_t* hid; const float* bias;
  DI void operator()(const f32x4 (&acc)[4][4], int row0, int col0, int lane) const {
#pragma unroll
    for (int mi = 0; mi < 4; ++mi)
#pragma unroll
      for (int r = 0; r < 4; ++r) { const int row = row0 + mi * 16 + (lane >> 4) * 4 + r;
#pragma unroll
        for (int ni = 0; ni < 4; ++ni) { const int col = col0 + ni * 16 + (lane & 15); hid[(size_t)row * 256 + col] = f2bf(silu(acc[mi][ni][r] + bias[col])); } }
  } };
struct EpiCmp2 { bf16_t* kc;
  DI void operator()(const f32x4 (&acc)[4][4], int row0, int col0, int lane) const {
    if (col0 >= 64) return;
#pragma unroll
    for (int mi = 0; mi < 4; ++mi)
#pragma unroll
      for (int r = 0; r < 4; ++r) { const int row = row0 + mi * 16 + (lane >> 4) * 4 + r;
        if (row < 2044) {
#pragma unroll
          for (int ni = 0; ni < 4; ++ni) kc[(size_t)row * 64 + col0 + ni * 16 + (lane & 15)] = f2bf(acc[mi][ni][r]); } }
  } };

template <int DQ, int MODE, class OUT>
DI void attn_core(const int tid, const bf16_t* __restrict__ Qb, long qs, const bf16_t* __restrict__ Kb, long kst, const bf16_t* __restrict__ Vb, long vst,
                  int q0, int k0, int kmax, int ntiles, const int* tlist, float sl2, int window,
                  const unsigned* selw, float* impg, bool first_head, float (&m_io)[2], float (&l_io)[2], const OUT out, char* smem) {
  constexpr int NKD = DQ / 32, CPR = DQ / 8, KST = (DQ == 64) ? 128 : 256;
  const int lane = tid & 63, wave = tid >> 6, g = lane >> 4, li = lane & 15;
  bf16x8 qf[2][NKD];
#pragma unroll
  for (int qt = 0; qt < 2; ++qt)
#pragma unroll
    for (int kd = 0; kd < NKD; ++kd) qf[qt][kd] = *(const bf16x8*)(Qb + (long)(q0 + wave * 32 + qt * 16 + li) * qs + kd * 32 + g * 8);
  int qidx[2]; qidx[0] = q0 + wave * 32 + li; qidx[1] = qidx[0] + 16;
  f32x4 o[4][2];
#pragma unroll
  for (int i = 0; i < 4; ++i) { o[i][0] = (f32x4){0.f, 0.f, 0.f, 0.f}; o[i][1] = (f32x4){0.f, 0.f, 0.f, 0.f}; }
  float mrun[2], lrun[2], invl[2], prev3[2];
#pragma unroll
  for (int qt = 0; qt < 2; ++qt) { prev3[qt] = 0.f;
    if (MODE == 3) { mrun[qt] = m_io[qt]; lrun[qt] = 0.f; invl[qt] = l_io[qt] > 0.f ? 1.f / l_io[qt] : 0.f; } else { mrun[qt] = -1e30f; lrun[qt] = 0.f; invl[qt] = 0.f; } }
  constexpr int RPP = 1024 / KST, NKP = 64 / RPP / 4;
  auto stage = [&](int jt, int buf) {
    const int kb = k0 + jt * 64; char* kbuf = smem + buf * 16384; char* vbuf = smem + 32768 + buf * 8192;
#pragma unroll
    for (int i = 0; i < NKP; ++i) { const int pc = wave * NKP + i; const int row = pc * RPP + (DQ == 64 ? (lane >> 3) : (lane >> 4));
      int c = (DQ == 64) ? ((lane & 7) ^ (row & 7)) : ((lane & 15) ^ (row & 7)); if (DQ != 64 && c >= CPR) c = 0;
      int ix = kb + row; ix = ix < 0 ? 0 : (ix > kmax ? kmax : ix);
      __builtin_amdgcn_global_load_lds((const unsigned*)(Kb + (long)ix * kst + c * 8), LDSP(unsigned, kbuf + pc * 1024), 16, 0, 0); }
    if (MODE != 2) {
#pragma unroll
      for (int i = 0; i < 2; ++i) { const int pc = wave * 2 + i; const int row = pc * 8 + (lane >> 3); const int pp = lane & 7;
        const int c = ((((pp >> 1) ^ ((row >> 1) & 3)) << 1) | (pp & 1));
        int ix = kb + row; ix = ix < 0 ? 0 : (ix > kmax ? kmax : ix);
        __builtin_amdgcn_global_load_lds((const unsigned*)(Vb + (long)ix * vst + c * 8), LDSP(unsigned, vbuf + pc * 1024), 16, 0, 0); }
    }
  };
  if (ntiles > 0) stage(tlist ? tlist[0] : 0, 0);
  asm volatile("s_waitcnt vmcnt(0)" ::: "memory");
  __syncthreads();
  for (int it = 0; it < ntiles; ++it) {
    const int jt = tlist ? tlist[it] : it;
    const bool more = it + 1 < ntiles;
    if (more) stage(tlist ? tlist[it + 1] : it + 1, (it + 1) & 1);
    const char* kbuf = smem + (it & 1) * 16384; const char* vbuf = smem + 32768 + (it & 1) * 8192;
    f32x4 st[4][2];
#pragma unroll
    for (int kt4 = 0; kt4 < 4; ++kt4) {
      bf16x8 kf[NKD]; const int row = kt4 * 16 + li;
#pragma unroll
      for (int kd = 0; kd < NKD; ++kd) kf[kd] = *(const bf16x8*)(kbuf + row * KST + (((kd * 4 + g) ^ (row & 7)) << 4));
#pragma unroll
      for (int qt = 0; qt < 2; ++qt) { f32x4 a = (f32x4){0.f, 0.f, 0.f, 0.f};
#pragma unroll
        for (int kd = 0; kd < NKD; ++kd) a = mfma16(kf[kd], qf[qt][kd], a);
        st[kt4][qt] = a; }
    }
    const int kbase = k0 + jt * 64;
    bool sb[2] = {true, true};
    if (MODE == 4) { sb[0] = (selw[(wave * 32 + li) * 4 + (jt >> 5)] >> (jt & 31)) & 1u; sb[1] = (selw[(wave * 32 + 16 + li) * 4 + (jt >> 5)] >> (jt & 31)) & 1u; }
    float alpha[2];
#pragma unroll
    for (int qt = 0; qt < 2; ++qt) {
      float mx = -1e30f;
#pragma unroll
      for (int kt4 = 0; kt4 < 4; ++kt4)
#pragma unroll
        for (int r = 0; r < 4; ++r) { const int kidx = kbase + kt4 * 16 + g * 4 + r; bool v;
          if (MODE == 0) v = kidx <= qidx[qt];
          else if (MODE == 1) v = (kidx >= 0) && (kidx <= qidx[qt]) && (qidx[qt] - kidx <= window);
          else if (MODE == 2 || MODE == 3) v = (kidx <= kmax) && (16 * kidx + 31 <= qidx[qt]);
          else v = (kidx <= qidx[qt]) && sb[qt];
          const float s = v ? st[kt4][qt][r] * sl2 : -1e30f; st[kt4][qt][r] = s; mx = fmaxf(mx, s); }
      if (MODE != 3) {
        mx = fmaxf(mx, __shfl_xor(mx, 16)); mx = fmaxf(mx, __shfl_xor(mx, 32));
        const float mn = fmaxf(mrun[qt], mx); alpha[qt] = fast_exp2(mrun[qt] - mn); mrun[qt] = mn;
      } else alpha[qt] = 1.f;
      float ls = 0.f;
#pragma unroll
      for (int kt4 = 0; kt4 < 4; ++kt4)
#pragma unroll
        for (int r = 0; r < 4; ++r) { const float s = st[kt4][qt][r]; float p = (s > -5e29f) ? fast_exp2(s - mrun[qt]) : 0.f; if (MODE == 3) p *= invl[qt]; st[kt4][qt][r] = p; ls += p; }
      lrun[qt] = lrun[qt] * alpha[qt] + ls;
    }
    if (MODE == 3) {
#pragma unroll
      for (int qt = 0; qt < 2; ++qt)
#pragma unroll
        for (int kt4 = 0; kt4 < 4; ++kt4) { const float p3 = st[kt4][qt][3]; const float a = (st[kt4][qt][0] + st[kt4][qt][1]) + (st[kt4][qt][2] + p3);
          const float give = (g == 3) ? prev3[qt] : p3; const float up = __shfl(give, (lane + 48) & 63); prev3[qt] = p3;
          float* ip = impg + (size_t)(wave * 32 + qt * 16 + li) * 128 + jt * 16 + kt4 * 4 + g; const float val = a + up;
          if (first_head) *ip = val; else *ip += val; }
    }
    if (MODE != 2) {
      if (MODE != 3) {
#pragma unroll
        for (int dt = 0; dt < 4; ++dt) { o[dt][0] *= alpha[0]; o[dt][1] *= alpha[1]; }
      }
#pragma unroll
      for (int ks2 = 0; ks2 < 2; ++ks2) {
        bf16x8 pf[2];
#pragma unroll
        for (int qt = 0; qt < 2; ++qt) { u32x4 w; w[0] = pk2(st[2 * ks2][qt][0], st[2 * ks2][qt][1]); w[1] = pk2(st[2 * ks2][qt][2], st[2 * ks2][qt][3]);
          w[2] = pk2(st[2 * ks2 + 1][qt][0], st[2 * ks2 + 1][qt][1]); w[3] = pk2(st[2 * ks2 + 1][qt][2], st[2 * ks2 + 1][qt][3]); pf[qt] = __builtin_bit_cast(bf16x8, w); }
        const int rowA = 32 * ks2 + 4 * g + (li >> 2), p_ = li & 3;
#pragma unroll
        for (int dt = 0; dt < 4; ++dt) {
          const int off = rowA * 128 + ((((dt ^ ((rowA >> 1) & 3)) << 1) | (p_ >> 1)) << 4) + 8 * (p_ & 1);
          const s16x4 lo = __builtin_amdgcn_ds_read_tr16_b64_v4i16(LDSP(s16x4, vbuf + off));
          const s16x4 hi = __builtin_amdgcn_ds_read_tr16_b64_v4i16(LDSP(s16x4, vbuf + off + 2048));
          const bf16x8 vf = __builtin_shufflevector(lo, hi, 0, 1, 2, 3, 4, 5, 6, 7);
          o[dt][0] = mfma16(vf, pf[0], o[dt][0]); o[dt][1] = mfma16(vf, pf[1], o[dt][1]);
        }
      }
    }
    asm volatile("s_waitcnt vmcnt(0)" ::: "memory");
    __syncthreads();
  }
#pragma unroll
  for (int qt = 0; qt < 2; ++qt) {
    float lt = lrun[qt]; lt += __shfl_xor(lt, 16); lt += __shfl_xor(lt, 32);
    if (MODE == 2) { m_io[qt] = mrun[qt]; l_io[qt] = lt; }
    else {
      const float inv = (MODE == 3) ? 1.f : (lt > 0.f ? 1.f / lt : 0.f);
#pragma unroll
      for (int dt = 0; dt < 4; ++dt) out(wave * 32 + qt * 16 + li, dt * 16 + g * 4, o[dt][qt] * inv, mrun[qt], lt);
    }
  }
}

struct OutSet { bf16_t* dst; long ld; const bf16_t* gate; long gld; float* lse; long lld;
  DI void operator()(int ql, int d0, f32x4 v, float m, float l) const {
    float gs = 1.f; if (gate) gs = bf2f(gate[ql * gld]);
    u32x2 w; w[0] = pk2(v[0] * gs, v[1] * gs); w[1] = pk2(v[2] * gs, v[3] * gs); *(u32x2*)(dst + ql * ld + d0) = w;
    if (lse && d0 == 0) lse[ql * lld] = (m + __log2f(l)) * 0.69314718056f;
  } };
struct OutAdd { bf16_t* dst; long ld; const bf16_t* gate; long gld;
  DI void operator()(int ql, int d0, f32x4 v, float m, float l) const {
    const float gs = bf2f(gate[ql * gld]); u32x2* p = (u32x2*)(dst + ql * ld + d0); const u32x2 old = *p;
    u32x2 w; w[0] = pk2(__uint_as_float(old[0] << 16) + v[0] * gs, __uint_as_float(old[0] & 0xffff0000u) + v[1] * gs);
    w[1] = pk2(__uint_as_float(old[1] << 16) + v[2] * gs, __uint_as_float(old[1] & 0xffff0000u) + v[3] * gs); *p = w;
  } };

DI bf16_t* lw(char* ws, int l, size_t off) { return (bf16_t*)(ws + OFF_W + (size_t)l * LW_SIZE + off); }

DI int colmap(int map, int n, int nsrc) {
  if (map == 0) return n < nsrc ? n : -1;
  if (map == 1) { const int t = n >> 5, i = n & 31; return i < 16 ? 16 * t + i : 2816 + 16 * t + (i - 16); }
  if (n < 384) return n;
  if (n < C_DV + 384) return 416 + (n - C_DQ);
  if (n < C_NQR) return 1568 + (n - C_NQ);
  if (n < C_KC) return 1568 + (n - C_NQR);
  if (n < C_KPE) return 1952 + (n - C_KC);
  if (n < C_GL) return 384 + (n - C_KPE);
  if (n < C_GL + 18) return 2720 + (n - C_GL);
  return -1;
}

DI void phase_prologue(const Params& P, const Ctx& p, char* smem) {
  const int tid = p.tid;
  const int n_w = P.n_wtiles, n_cb = 4, n_r64 = 256, n_r32 = 128, n_xb = 1024;
  const int total = n_w + n_cb + n_r64 + n_r32 + n_xb;
  for (int t = blockIdx.x; t < total; t += gridDim.x) {
    if (t < n_w) {
      int di = 0;
#pragma unroll 1
      for (int i = 1; i < 24; ++i) if (t >= P.wd[i].tile0) di = i;
      const WDesc d = P.wd[di]; const int lt = t - d.tile0, tn = lt % d.ntn, tk = lt / d.ntn, n0 = tn * 64, k0 = tk * 128;
      float* tile = (float*)smem;
      const int nn = tid & 63; const int sc = colmap(d.map, n0 + nn, d.Nsrc);
      float v[32];
#pragma unroll
      for (int i = 0; i < 32; ++i) { const int kk = (tid >> 6) + 4 * i; v[i] = (sc >= 0) ? d.src[(size_t)(k0 + kk) * d.Nsrc + sc] : 0.f; }
      if (d.kscale) {
#pragma unroll
        for (int i = 0; i < 32; ++i) v[i] *= d.kscale[k0 + (tid >> 6) + 4 * i];
      }
#pragma unroll
      for (int i = 0; i < 32; ++i) tile[((tid >> 6) + 4 * i) * 65 + nn] = v[i];
      __syncthreads();
      { const int on = tid >> 2, kq = tid & 3;
        bf16_t* dp = d.dst + (size_t)(n0 + on) * d.K + k0 + kq * 32;
#pragma unroll
        for (int c = 0; c < 4; ++c) { u32x4 w;
#pragma unroll
          for (int j = 0; j < 4; ++j) w[j] = pk2(tile[(kq * 32 + c * 8 + 2 * j) * 65 + on], tile[(kq * 32 + c * 8 + 2 * j + 1) * 65 + on]);
          *(u32x4*)(dp + c * 8) = w; } }
      __syncthreads();
    } else if (t < n_w + n_cb) {
      const int id = t - n_w; const float* pos = p.cmp_pos + (size_t)id * 2048; const float* w1 = p.cmp_w1 + (size_t)id * 2048 * 256; float a = 0.f;
      for (int k = 0; k < 2048; ++k) a += pos[k] * w1[(size_t)k * 256 + tid];
      ((float*)(p.ws + OFF_CBIAS))[id * 256 + tid] = a;
    } else if (t < n_w + n_cb + n_r64) {
      const int e0 = (t - n_w - n_cb) * 1024; float* C = (float*)(p.ws + OFF_C64); float* Sn = (float*)(p.ws + OFF_S64);
      for (int e = e0 + tid; e < e0 + 1024; e += 256) { const int pos = e >> 5, i = e & 31; const float inv = exp2f(-(float)(2 * i) / 64.f * 13.287712379549449f); const float ang = (float)pos * inv;
        sincos_rr(ang, C[e], Sn[e]); }
    } else if (t < n_w + n_cb + n_r64 + n_r32) {
      const int e0 = (t - n_w - n_cb - n_r64) * 1024; float* C = (float*)(p.ws + OFF_C32); float* Sn = (float*)(p.ws + OFF_S32);
      for (int e = e0 + tid; e < e0 + 1024; e += 256) { const int pos = e >> 4, i = e & 15; const float inv = exp2f(-(float)(2 * i) / 32.f * 13.287712379549449f); const float ang = (float)pos * inv;
        sincos_rr(ang, C[e], Sn[e]); }
    } else {
      const size_t e0 = (size_t)(t - n_w - n_cb - n_r64 - n_r32) * 16384 + tid * 8; bf16_t* xb = (bf16_t*)(p.ws + OFF_XB);
      f32x4 a[8], b[8];
#pragma unroll
      for (int i = 0; i < 8; ++i) { a[i] = *(const f32x4*)(p.x + e0 + i * 2048); b[i] = *(const f32x4*)(p.x + e0 + i * 2048 + 4); }
#pragma unroll
      for (int i = 0; i < 8; ++i) { u32x4 w; w[0] = pk2(a[i][0], a[i][1]); w[1] = pk2(a[i][2], a[i][3]); w[2] = pk2(b[i][0], b[i][1]); w[3] = pk2(b[i][2], b[i][3]);
        *(u32x4*)(xb + e0 + i * 2048) = w; }
    }
  }
}

DI bool tile_seq(int k, int NT, int total, int& mt, int& nt) {
  const int G = gridDim.x, b = blockIdx.x; const int s = k * G + (b & 7) * (G >> 3) + (b >> 3);
  if (s >= total) return false;
  const int band = s / (16 * NT), r = s - band * 16 * NT; nt = r >> 4; mt = band * 16 + (r & 15); return true;
}
DI void phase_ffn_up(const Ctx& p, int l, int j, char* smem) {
  const ALin al{(const bf16_t*)(p.ws + OFF_XB), D_, T_}; const bf16_t* Bt = lw(p.ws, l, LW_FIN + j * SZ_FIN); const EpiSwiGLU epi{(bf16_t*)(p.ws + OFF_BIG)};
  for (int k = 0;; ++k) { int mt, nt; if (!tile_seq(k, 44, 128 * 44, mt, nt)) break; gemm_tile(p.tid, al, Bt, D_, 5632, D_, mt * 128, nt * 128, epi, smem); }
}
DI void phase_ffn_down(const Ctx& p, int l, int j, char* smem) {
  const ALin al{(const bf16_t*)(p.ws + OFF_BIG), F_, T_}; const bf16_t* Bt = lw(p.ws, l, LW_FOUT + j * SZ_FOUT);
  const EpiResid epi{(l == 0 && j == 0) ? p.x : p.out, p.out, 0.5f};
  for (int k = 0;; ++k) { int mt, nt; if (!tile_seq(k, 8, 128 * 8, mt, nt)) break; gemm_tile(p.tid, al, Bt, F_, D_, F_, mt * 128, nt * 128, epi, smem); }
}
DI void phase_wout(const Ctx& p, int l, char* smem) {
  const ALin al{(const bf16_t*)(p.ws + OFF_XB), D_, T_}; const bf16_t* Bt = lw(p.ws, l, LW_WOUT); const EpiResid epi{p.out, p.out, 1.0f};
  for (int k = 0;; ++k) { int mt, nt; if (!tile_seq(k, 8, 128 * 8, mt, nt)) break; gemm_tile(p.tid, al, Bt, D_, D_, D_, mt * 128, nt * 128, epi, smem); }
}
DI void phase_ln(const Ctx& p, int l, int j, bool zero_o) {
  const int lane = p.tid & 63, wave = p.tid >> 6; const float* gp = p.ln_g + (size_t)(l * 3 + j) * D_; const float* bp = p.ln_b + (size_t)(l * 3 + j) * D_;
  bf16_t* xb = (bf16_t*)(p.ws + OFF_XB);
  for (int t = blockIdx.x; t < T_ / 4; t += gridDim.x) {
    const int row = t * 4 + wave; float* yr = p.out + (size_t)row * D_; f32x4 v[4]; float s = 0.f;
#pragma unroll
    for (int i = 0; i < 4; ++i) { v[i] = *(const f32x4*)(yr + i * 256 + lane * 4); s += (v[i][0] + v[i][1]) + (v[i][2] + v[i][3]); }
#pragma unroll
    for (int o = 1; o < 64; o <<= 1) s += __shfl_xor(s, o);
    const float mu = s * (1.f / D_); float q = 0.f;
#pragma unroll
    for (int i = 0; i < 4; ++i)
#pragma unroll
      for (int e = 0; e < 4; ++e) { const float d = v[i][e] - mu; q += d * d; }
#pragma unroll
    for (int o = 1; o < 64; o <<= 1) q += __shfl_xor(q, o);
    const float rstd = rsqrtf(q * (1.f / D_) + 1e-5f);
#pragma unroll
    for (int i = 0; i < 4; ++i) { const int c = i * 256 + lane * 4; const f32x4 gg = *(const f32x4*)(gp + c), bb = *(const f32x4*)(bp + c); f32x4 r;
#pragma unroll
      for (int e = 0; e < 4; ++e) r[e] = (v[i][e] - mu) * rstd * gg[e] + bb[e];
      *(f32x4*)(yr + c) = r; u32x2 w; w[0] = pk2(r[0], r[1]); w[1] = pk2(r[2], r[3]); *(u32x2*)(xb + (size_t)row * D_ + c) = w; }
  }
}
DI void phase_win(const Ctx& p, int l, char* smem) {
  const ALin al{(const bf16_t*)(p.ws + OFF_XB), D_, T_}; const bf16_t* Bt = lw(p.ws, l, LW_WIN);
  const EpiProj epi{(bf16_t*)(p.ws + OFF_BIG), (bf16_t*)(p.ws + OFF_KA), (const float*)(p.ws + OFF_C64), (const float*)(p.ws + OFF_S64), (const float*)(p.ws + OFF_C32), (const float*)(p.ws + OFF_S32)};
  for (int k = 0;; ++k) { int mt, nt; if (!tile_seq(k, 25, 128 * 25, mt, nt)) break; gemm_tile(p.tid, al, Bt, D_, PW, D_, mt * 128, nt * 128, epi, smem); }
}

DI int next_item(const int tid, unsigned* ctr, char* smem) {
  int* slot = (int*)(smem + 69632 - 16);
  __syncthreads();
  if (tid == 0) *slot = (int)atomicAdd(ctr, 1u);
  __syncthreads();
  return *slot;
}

DI void item_dilated(const Ctx& p, int id, char* smem) {
  const int pat = id / 768, r1 = id % 768, b = r1 / 384, r2 = r1 % 384, h = r2 >> 6, blk = r2 & 63;
  const int dil = pat == 0 ? 1 : (pat == 1 ? 4 : 16), nsub = 64 / dil, rho = blk / nsub, i = blk % nsub;
  const bf16_t* proj = (const bf16_t*)(p.ws + OFF_BIG); const bf16_t* base = proj + (size_t)(b * S_ + rho) * PW; const long rs = (long)dil * PW;
  bf16_t* dst = (bf16_t*)(p.ws + OFF_DILO) + ((size_t)pat * T_ + b * S_ + rho + (size_t)dil * 128 * i) * 384 + h * 64;
  float* lse = (float*)(p.ws + OFF_DILL) + ((size_t)pat * T_ + b * S_ + rho + (size_t)dil * 128 * i) * 6 + h;
  const OutSet out{dst, (long)dil * 384, nullptr, 0, lse, (long)dil * 6}; float mm[2], ll[2];
  attn_core<64, 1>(p.tid, base + C_DQ + h * 64, rs, base + C_DK + h * 64, rs, base + C_DV + h * 64, rs, 128 * i, 128 * i - 128, S_ / dil - 1, 4, nullptr,
                   0.125f * 1.44269504089f, 128, nullptr, nullptr, false, mm, ll, out, smem);
}
DI void item_nsawin(const Ctx& p, int id, char* smem) {
  const int b = id / 384, r = id % 384, h = r >> 6, i = r & 63, g = h / 3;
  const bf16_t* proj = (const bf16_t*)(p.ws + OFF_BIG); const bf16_t* base = proj + (size_t)(b * S_) * PW;
  bf16_t* o = (bf16_t*)(p.ws + OFF_XB) + (size_t)(b * S_ + 128 * i) * D_ + 640 + h * 64;
  const OutSet out{o, D_, base + (size_t)(128 * i) * PW + C_GL + h * 3 + 2, PW, nullptr, 0}; float mm[2], ll[2];
  attn_core<64, 1>(p.tid, base + C_NQR + h * 64, PW, base + C_KW + g * 64, PW, base + C_VW + g * 64, PW, 128 * i, 128 * i - 512, S_ - 1, 10, nullptr,
                   0.125f * 1.44269504089f, 512, nullptr, nullptr, false, mm, ll, out, smem);
}
DI void item_expand(const Ctx& p, int l, int id, char* smem) {
  const bf16_t* proj = (const bf16_t*)(p.ws + OFF_BIG); float* rs = (float*)(smem + 65536);
  const bool isq = id < 384; const int lid = isq ? id : id - 384; const int mt = isq ? lid / 3 : lid >> 2, nt = isq ? lid % 3 : lid & 3;
  const int K = isq ? 256 : 128, cb = isq ? C_CQ : C_CKV, tid = p.tid;
  { const int row = tid >> 1, half = tid & 1; const bf16_t* rp = proj + (size_t)(mt * 128 + row) * PW + cb + half * (K / 2); float ss = 0.f;
    for (int c = 0; c < K / 2; c += 8) { const u32x4 w = *(const u32x4*)(rp + c);
#pragma unroll
      for (int e = 0; e < 4; ++e) { const float a = __uint_as_float(w[e] << 16), b2 = __uint_as_float(w[e] & 0xffff0000u); ss += a * a + b2 * b2; } }
    ss += __shfl_xor(ss, 1); if (half == 0) rs[row] = rsqrtf(ss / (float)K + 1e-6f); }
  __syncthreads();
  const ALin al{proj + cb, PW, T_};
  if (isq) { const EpiMLAq epi{(bf16_t*)(p.ws + OFF_QA), rs, mt * 128, (const float*)(p.ws + OFF_C32), (const float*)(p.ws + OFF_S32)};
    gemm_tile(p.tid, al, lw(p.ws, l, LW_UQ), 256, 384, 256, mt * 128, nt * 128, epi, smem); }
  else { const EpiMLAkv epi{(bf16_t*)(p.ws + OFF_KA), (bf16_t*)(p.ws + OFF_VA), rs, mt * 128};
    gemm_tile(p.tid, al, lw(p.ws, l, LW_UKV), 128, 512, 128, mt * 128, nt * 128, epi, smem); }
}
DI void item_cmp1(const Ctx& p, int l, int id, char* smem) {
  const int kv = id >> 5, mt = (id >> 1) & 15, nt = id & 1; const ACmp al{(const bf16_t*)(p.ws + OFF_BIG), kv ? C_VC : C_KC};
  const EpiCmp1 epi{(bf16_t*)(p.ws + OFF_CHID) + (size_t)kv * 2048 * 256, (const float*)(p.ws + OFF_CBIAS) + (l * 2 + kv) * 256};
  gemm_tile(p.tid, al, lw(p.ws, l, LW_C1 + kv * SZ_C1), 2048, 256, 2048, mt * 128, nt * 128, epi, smem);
}
DI void item_cmp2(const Ctx& p, int l, int id, char* smem) {
  const int kv = id >> 4, mt = id & 15; const ALin al{(const bf16_t*)(p.ws + OFF_CHID) + (size_t)kv * 2048 * 256, 256, 2048};
  const EpiCmp2 epi{(bf16_t*)(p.ws + OFF_KCVC) + (size_t)kv * 2048 * 64};
  gemm_tile(p.tid, al, lw(p.ws, l, LW_C2 + kv * SZ_C2), 256, 64, 256, mt * 128, 0, epi, smem);
}
DI void item_mla(const Ctx& p, int id, char* smem) {
  const int i = 63 - (id >> 3), bh = id & 7, b = bh >> 2, h = bh & 3;
  const bf16_t* qa = (const bf16_t*)(p.ws + OFF_QA) + (size_t)(b * S_) * 384 + h * 96; const bf16_t* ka = (const bf16_t*)(p.ws + OFF_KA) + (size_t)(b * S_) * 384 + h * 96;
  const bf16_t* va = (const bf16_t*)(p.ws + OFF_VA) + (size_t)(b * S_) * 256 + h * 64;
  bf16_t* o = (bf16_t*)(p.ws + OFF_XB) + (size_t)(b * S_ + 128 * i) * D_ + h * 64; const OutSet out{o, D_, nullptr, 0, nullptr, 0}; float mm[2], ll[2];
  attn_core<96, 0>(p.tid, qa, 384, ka, 384, va, 256, 128 * i, 0, S_ - 1, 2 * (i + 1), nullptr, 0.10206207261f * 1.44269504089f, 0, nullptr, nullptr, false, mm, ll, out, smem);
}
DI void item_nsacmp(const Ctx& p, int id, char* smem) {
  const int i = 63 - (id >> 2), bg = id & 3, b = bg >> 1, g = bg & 1, tid = p.tid;
  const bf16_t* proj = (const bf16_t*)(p.ws + OFF_BIG); const bf16_t* base = proj + (size_t)(b * S_) * PW;
  const bf16_t* kc = (const bf16_t*)(p.ws + OFF_KCVC) + (size_t)((b * 2 + g) * NCMP) * 64; const bf16_t* vc = kc + (size_t)2048 * 64;
  float* imp = (float*)(p.ws + OFF_IMP) + ((size_t)((b * 2 + g) * S_) + 128 * i) * 128;
  const int nkt = (i + 8) >> 3;
#pragma unroll 1
  for (int hh = 0; hh < 3; ++hh) { const int h = g * 3 + hh; float mm[2], ll[2];
    bf16_t* o = (bf16_t*)(p.ws + OFF_XB) + (size_t)(b * S_ + 128 * i) * D_ + 640 + h * 64;
    const OutAdd out{o, D_, base + (size_t)(128 * i) * PW + C_GL + h * 3 + 0, PW};
    attn_core<64, 2>(p.tid, base + C_NQ + h * 64, PW, kc, 64, vc, 64, 128 * i, 0, NCMP - 1, nkt, nullptr, 0.125f * 1.44269504089f, 0, nullptr, nullptr, false, mm, ll, out, smem);
    attn_core<64, 3>(p.tid, base + C_NQ + h * 64, PW, kc, 64, vc, 64, 128 * i, 0, NCMP - 1, nkt, nullptr, 0.125f * 1.44269504089f, 0, nullptr, imp, hh == 0, mm, ll, out, smem);
  }
  __syncthreads();
  float* sc = (float*)smem;
  const int q = tid >> 1, half = tid & 1, qpos = 128 * i + q, cur = qpos >> 6;
#pragma unroll 2
  for (int j = half * 64; j < half * 64 + 64; ++j) { const float v = (j < nkt * 16) ? imp[(size_t)q * 128 + j] : 0.f; const bool forced = (j == 0) || (j == cur) || (j == cur - 1);
    sc[q * 129 + j] = forced ? 1e4f : (j <= cur ? v : -1e4f); }
  unsigned m0 = 0, m1 = 0, m2 = 0, m3 = 0;
#pragma unroll 1
  for (int rd = 0; rd < 16; ++rd) {
    float bv = -3e38f; int bj = half * 64;
#pragma unroll 4
    for (int j = half * 64; j < half * 64 + 64; ++j) { const float v = sc[q * 129 + j]; if (v > bv) { bv = v; bj = j; } }
    const float ov = __shfl_xor(bv, 1); const int oj = __shfl_xor(bj, 1);
    if (ov > bv || (ov == bv && oj < bj)) { bv = ov; bj = oj; }
    if ((bj >> 6) == half) sc[q * 129 + bj] = -3.2e38f;
    if (bj <= cur) { const unsigned bit = 1u << (bj & 31); const int w = bj >> 5; m0 |= (w == 0) ? bit : 0u; m1 |= (w == 1) ? bit : 0u; m2 |= (w == 2) ? bit : 0u; m3 |= (w == 3) ? bit : 0u; }
  }
  if (half == 0) { u32x4 w; w[0] = m0; w[1] = m1; w[2] = m2; w[3] = m3; *(u32x4*)((unsigned*)(p.ws + OFF_SEL) + ((size_t)(b * S_ + qpos) * 2 + g) * 4) = w; }
  __syncthreads();
}
DI void item_dilcombine(const Ctx& p, int id) {
  const size_t e = (size_t)id * 256 + p.tid; const int tok = (int)(e / 48), r = (int)(e % 48), h = r >> 3, d0 = (r & 7) * 8;
  const float* L = (const float*)(p.ws + OFF_DILL); const bf16_t* O = (const bf16_t*)(p.ws + OFF_DILO);
  const float l0 = L[(size_t)tok * 6 + h], l1 = L[((size_t)T_ + tok) * 6 + h], l2 = L[((size_t)2 * T_ + tok) * 6 + h]; const float mx = fmaxf(l0, fmaxf(l1, l2));
  float w0 = __expf(l0 - mx), w1 = __expf(l1 - mx), w2 = __expf(l2 - mx); const float inv = 1.f / (w0 + w1 + w2); w0 *= inv; w1 *= inv; w2 *= inv;
  const u32x4 a = *(const u32x4*)(O + (size_t)tok * 384 + h * 64 + d0), b = *(const u32x4*)(O + ((size_t)T_ + tok) * 384 + h * 64 + d0), c = *(const u32x4*)(O + ((size_t)2 * T_ + tok) * 384 + h * 64 + d0);
  u32x4 w;
#pragma unroll
  for (int k = 0; k < 4; ++k) { const float lo = w0 * __uint_as_float(a[k] << 16) + w1 * __uint_as_float(b[k] << 16) + w2 * __uint_as_float(c[k] << 16);
    const float hi = w0 * __uint_as_float(a[k] & 0xffff0000u) + w1 * __uint_as_float(b[k] & 0xffff0000u) + w2 * __uint_as_float(c[k] & 0xffff0000u); w[k] = pk2(lo, hi); }
  *(u32x4*)((bf16_t*)(p.ws + OFF_XB) + (size_t)tok * D_ + 256 + h * 64 + d0) = w;
}
DI void item_nsaslc(const Ctx& p, int id, char* smem) {
  const int i = 63 - id / 12, r = id % 12, b = r / 6, h = r % 6, g = h / 3, tid = p.tid;
  const bf16_t* proj = (const bf16_t*)(p.ws + OFF_BIG); const bf16_t* base = proj + (size_t)(b * S_) * PW;
  unsigned* selw = (unsigned*)(smem + 49152 + 2048); int* tlist = (int*)(smem + 49152); unsigned* un = (unsigned*)(smem + 49152 + 1024);
  __syncthreads();
  if (tid < 4) un[tid] = 0u;
  __syncthreads();
  if (tid < 128) { const u32x4 w = *(const u32x4*)((const unsigned*)(p.ws + OFF_SEL) + ((size_t)(b * S_ + 128 * i + tid) * 2 + g) * 4);
    selw[tid * 4 + 0] = w[0]; selw[tid * 4 + 1] = w[1]; selw[tid * 4 + 2] = w[2]; selw[tid * 4 + 3] = w[3];
    atomicOr(&un[0], w[0]); atomicOr(&un[1], w[1]); atomicOr(&un[2], w[2]); atomicOr(&un[3], w[3]); }
  __syncthreads();
  if (tid == 0) { int n = 0; for (int jt = 0; jt < 2 * (i + 1); ++jt) if ((un[jt >> 5] >> (jt & 31)) & 1u) tlist[n++] = jt; tlist[255] = n; }
  __syncthreads();
  const int nt = tlist[255];
  bf16_t* o = (bf16_t*)(p.ws + OFF_XB) + (size_t)(b * S_ + 128 * i) * D_ + 640 + h * 64;
  const OutAdd out{o, D_, base + (size_t)(128 * i) * PW + C_GL + h * 3 + 1, PW}; float mm[2], ll[2];
  attn_core<64, 4>(p.tid, base + C_NQR + h * 64, PW, base + C_KSL + g * 64, PW, base + C_VSL + g * 64, PW, 128 * i, 0, S_ - 1, nt, tlist, 0.125f * 1.44269504089f, 0, selw, nullptr, false, mm, ll, out, smem);
}

DI void phase_mix_a(const Ctx& p0, int l, char* smem, int ci) {
  unsigned* ctr = (unsigned*)(p0.ws + OFF_CTRL) + l * 8 + ci; const int total = 768 + 2304 + 896 + 64;
  for (;;) { Ctx q = p0; asm volatile("" : "+v"(q.tid)); const Ctx& p = q; const int t = next_item(p.tid, ctr, smem); if (t >= total) break;
    if (t < 768) item_nsawin(p, t, smem); else if (t < 768 + 2304) item_dilated(p, t - 768, smem);
    else if (t < 768 + 2304 + 896) item_expand(p, l, t - 768 - 2304, smem); else item_cmp1(p, l, t - 768 - 2304 - 896, smem); }
}
DI void phase_mix_b(const Ctx& p0, int l, char* smem, int ci) {
  unsigned* ctr = (unsigned*)(p0.ws + OFF_CTRL) + l * 8 + ci; const int total = 512 + 32;
  for (;;) { Ctx q = p0; asm volatile("" : "+v"(q.tid)); const Ctx& p = q; const int t = next_item(p.tid, ctr, smem); if (t >= total) break; if (t < 512) item_mla(p, t, smem); else item_cmp2(p, l, t - 512, smem); }
}
DI void phase_mix_c(const Ctx& p0, int l, char* smem) {
  unsigned* ctr = (unsigned*)(p0.ws + OFF_CTRL) + l * 8 + 2; const int total = 256 + 3072;
  for (;;) { Ctx q = p0; asm volatile("" : "+v"(q.tid)); const Ctx& p = q; const int t = next_item(p.tid, ctr, smem); if (t >= total) break; if (t < 256) item_nsacmp(p, t, smem); else item_dilcombine(p, t - 256); }
}
DI void phase_mix_d(const Ctx& p0, int l, char* smem) {
  unsigned* ctr = (unsigned*)(p0.ws + OFF_CTRL) + l * 8 + 3; const int total = 768;
  for (;;) { Ctx q = p0; asm volatile("" : "+v"(q.tid)); const Ctx& p = q; const int t = next_item(p.tid, ctr, smem); if (t >= total) break; item_nsaslc(p, t, smem); }
}
DI void phase_zero_o(const Ctx& p) {
  u32x4* o = (u32x4*)(p.ws + OFF_XB); const u32x4 z = (u32x4){0u, 0u, 0u, 0u};
  for (size_t e = (size_t)blockIdx.x * 256 + p.tid; e < (size_t)T_ * D_ / 8; e += (size_t)gridDim.x * 256) o[e] = z;
}

DI void run_phase(const Params& P, int ph, char* smem) {
  Ctx p; p.x = P.x; p.ln_g = P.ln_g; p.ln_b = P.ln_b; p.cmp_pos = P.cmp_pos; p.cmp_w1 = P.cmp_w1; p.out = P.out; p.ws = P.ws; p.tid = threadIdx.x;
  asm volatile("" : "+v"(p.tid));
  if (ph == 0) { phase_prologue(P, p, smem); return; }
  const int l = (ph - 1) / 13; int s = (ph - 1) % 13;
#ifdef ONLY_S
  if (s != ONLY_S) return;
  s = ONLY_S;
#endif
  switch (s) {
    case 0: phase_ffn_up(p, l, 0, smem);
#if PROBE_REP == 1
      __syncthreads(); phase_ffn_up(p, l, 0, smem);
#endif
      break;
    case 1: phase_ffn_down(p, l, 0, smem); break;
    case 2: phase_ln(p, l, 0, false); break;
#if ENABLE_MIX
    case 3: phase_win(p, l, smem); break;
    case 4: phase_mix_a(p, l, smem, 0);
#if PROBE_REP == 2
      phase_mix_a(p, l, smem, 4);
#endif
      break;
    case 5: phase_mix_b(p, l, smem, 1);
#if PROBE_REP == 3
      phase_mix_b(p, l, smem, 5);
#endif
      break;
    case 6: phase_mix_c(p, l, smem); break;
    case 7: phase_mix_d(p, l, smem); break;
#else
    case 3: phase_zero_o(p); break;
    case 4: case 5: case 6: case 7: break;
#endif
    case 8: phase_wout(p, l, smem); break;
    case 9: phase_ln(p, l, 1, false); break;
    case 10: phase_ffn_up(p, l, 1, smem);
#if PROBE_REP == 1
      __syncthreads(); phase_ffn_up(p, l, 1, smem);
#endif
      break;
    case 11: phase_ffn_down(p, l, 1, smem); break;
    case 12: phase_ln(p, l, 2, false); break;
  }
}
constexpr int NPHASE = 27;

#if ONE_LAUNCH
DI unsigned xb_ld(unsigned* p) { return __hip_atomic_load(p, __ATOMIC_RELAXED, __HIP_MEMORY_SCOPE_AGENT); }
DI unsigned xb_add(unsigned* p, unsigned v) { return __hip_atomic_fetch_add(p, v, __ATOMIC_RELAXED, __HIP_MEMORY_SCOPE_AGENT); }
DI void xb_st(unsigned* p, unsigned v) { __hip_atomic_store(p, v, __ATOMIC_RELAXED, __HIP_MEMORY_SCOPE_AGENT); }
constexpr int XB_CNT = 256, XB_SUB = 256 + 64 * 16, XB_GEN = 256 + 64 * 32, XB_TOP = 256 + 64 * 48, XB_TOPGEN = 256 + 64 * 49, XB_WORDS = 256 + 64 * 50;
DI void grid_bar(const Params& P, unsigned idx, char* smem) {
  asm volatile("s_waitcnt vmcnt(0)" ::: "memory");
  __syncthreads();
  int t = threadIdx.x; asm volatile("" : "+v"(t));
  if (t == 0) {
    unsigned* bar = (unsigned*)(P.ws + OFF_CTRL);
    volatile unsigned* st = (volatile unsigned*)(smem + 69632 - 16);
    const unsigned x = st[1], nloc = st[2], nx = st[3];
    const unsigned old = xb_add(&bar[XB_SUB + 64 * x], 1u);
    if (old + 1u == idx * nloc) {
      __builtin_amdgcn_fence(__ATOMIC_RELEASE, "agent");
      asm volatile("s_waitcnt vmcnt(0)" ::: "memory");
      const unsigned og = xb_add(&bar[XB_TOP], 1u);
      if (og + 1u == idx * nx) xb_st(&bar[XB_TOPGEN], idx);
      else { while (xb_ld(&bar[XB_TOPGEN]) < idx) __builtin_amdgcn_s_sleep(1); }
      xb_st(&bar[XB_GEN + 64 * x], idx);
    } else { while (xb_ld(&bar[XB_GEN + 64 * x]) < idx) __builtin_amdgcn_s_sleep(1); }
    __builtin_amdgcn_fence(__ATOMIC_ACQUIRE, "agent");
    asm volatile("s_waitcnt vmcnt(0)" ::: "memory");
  }
  __syncthreads();
}
template <int PH> DI void run_all(const Params& p, char* smem) {
  run_phase(p, PH, smem);
  if constexpr (PH + 1 < NPHASE) { grid_bar(p, PH + 1, smem); run_all<PH + 1>(p, smem); }
}
__global__ void __launch_bounds__(256, 2) mega_kernel(Params p) {
  __shared__ __attribute__((aligned(16))) char smem[69632];
  {
    unsigned* bar = (unsigned*)(p.ws + OFF_CTRL); volatile unsigned* st = (volatile unsigned*)(smem + 69632 - 16);
    const unsigned x = (unsigned)__builtin_amdgcn_s_getreg((3 << 11) | 20) & 0xFu;
    if (threadIdx.x == 0) xb_add(&bar[XB_CNT + 64 * x], 1u);
    cg::this_grid().sync();
    if (threadIdx.x == 0) { unsigned nx = 0, mine = 1;
      for (unsigned j = 0; j < 16; ++j) { const unsigned c = xb_ld(&bar[XB_CNT + 64 * j]); nx += (c > 0u) ? 1u : 0u; if (j == x) mine = c; }
      st[1] = x; st[2] = mine; st[3] = nx; }
    __syncthreads();
  }
  run_all<0>(p, smem);
}
#define MAIN_KERNEL mega_kernel
#else
#define MAIN_KERNEL phase_kernel
#endif
__global__ void __launch_bounds__(256, 2) phase_kernel(Params p, int ph) {
  __shared__ __attribute__((aligned(16))) char smem[69632];
  run_phase(p, ph, smem);
}

extern "C" void kernel_launch(void* const* d_in, const int* in_sizes, int n_in, void* d_out, int out_size, void* d_ws, size_t ws_size, hipStream_t stream) {
  static int grid_blocks = 0;
  if (!grid_blocks) { int dev = 0, cus = 0, per_cu = 0; hipGetDevice(&dev); hipDeviceGetAttribute(&cus, hipDeviceAttributeMultiprocessorCount, dev);
    hipOccupancyMaxActiveBlocksPerMultiprocessor(&per_cu, MAIN_KERNEL, 256, 0); if (per_cu > 2) per_cu = 2; if (per_cu < 1) per_cu = 1; grid_blocks = cus * per_cu; }
  if (ws_size < OFF_END) { fprintf(stderr, "workspace too small: %zu < %zu\n", ws_size, (size_t)OFF_END); return; }
  Params p; memset(&p, 0, sizeof(p));
  const float* x = (const float*)d_in[0]; const float* ffn_in = (const float*)d_in[1]; const float* ffn_out = (const float*)d_in[2];
  const float* w_in = (const float*)d_in[5]; const float* w_out = (const float*)d_in[6]; const float* qn = (const float*)d_in[7]; const float* kvn = (const float*)d_in[8];
  const float* wuq = (const float*)d_in[9]; const float* wukv = (const float*)d_in[10]; const float* cw1 = (const float*)d_in[12]; const float* cw2 = (const float*)d_in[13];
  p.x = x; p.ln_g = (const float*)d_in[3]; p.ln_b = (const float*)d_in[4]; p.cmp_pos = (const float*)d_in[11]; p.cmp_w1 = cw1; p.out = (float*)d_out; p.ws = (char*)d_ws;
  int tile0 = 0, di = 0;
  auto add = [&](const float* src, size_t dst_off, const float* ksc, int K, int Nsrc, int Ndst, int map) {
    WDesc& d = p.wd[di++]; d.src = src; d.dst = (bf16_t*)((char*)d_ws + dst_off); d.kscale = ksc; d.K = K; d.Nsrc = Nsrc; d.Ndst = Ndst; d.map = map; d.tile0 = tile0; d.ntn = Ndst / 64;
    tile0 += (Ndst / 64) * (K / 128); };
  for (int l = 0; l < 2; ++l) { const size_t wb = OFF_W + (size_t)l * LW_SIZE;
    for (int j = 0; j < 2; ++j) add(ffn_in + (size_t)(l * 2 + j) * 1024 * 5632, wb + LW_FIN + j * SZ_FIN, nullptr, 1024, 5632, 5632, 1);
    for (int j = 0; j < 2; ++j) add(ffn_out + (size_t)(l * 2 + j) * 2816 * 1024, wb + LW_FOUT + j * SZ_FOUT, nullptr, 2816, 1024, 1024, 0);
    add(w_in + (size_t)l * 1024 * 2738, wb + LW_WIN, nullptr, 1024, 2738, PW, 2);
    add(w_out + (size_t)l * 1024 * 1024, wb + LW_WOUT, nullptr, 1024, 1024, 1024, 0);
    add(wuq + (size_t)l * 256 * 384, wb + LW_UQ, qn + l * 256, 256, 384, 384, 0);
    add(wukv + (size_t)l * 128 * 512, wb + LW_UKV, kvn + l * 128, 128, 512, 512, 0);
    for (int kv = 0; kv < 2; ++kv) add(cw1 + (size_t)(l * 2 + kv) * 2048 * 256, wb + LW_C1 + kv * SZ_C1, nullptr, 2048, 256, 256, 0);
    for (int kv = 0; kv < 2; ++kv) add(cw2 + (size_t)(l * 2 + kv) * 256 * 64, wb + LW_C2 + kv * SZ_C2, nullptr, 256, 64, 64, 0);
  }
  p.n_wtiles = tile0;
  hipMemsetAsync((char*)d_ws + OFF_CTRL, 0, 16384, stream);
#if ONE_LAUNCH
  void* args[] = {&p};
  hipError_t e = hipLaunchCooperativeKernel((void*)mega_kernel, dim3(grid_blocks), dim3(256), args, 0, stream);
  if (e != hipSuccess) fprintf(stderr, "cooperative launch failed: %s (grid %d)\n", hipGetErrorString(e), grid_blocks);
#else
  for (int ph = 0; ph < NPHASE; ++ph) phase_kernel<<<dim3(grid_blocks), dim3(256), 0, stream>>>(p, ph);
#endif
}
```

```cpp
#include <hip/hip_runtime.h>
#include <hip/hip_cooperative_groups.h>
#include <cstdio>
#include <cstdint>
#include <cstring>
namespace cg = cooperative_groups;

typedef unsigned short bf16_t;
typedef short bf16x8 __attribute__((ext_vector_type(8)));
typedef short s16x4 __attribute__((ext_vector_type(4)));
typedef float f32x4 __attribute__((ext_vector_type(4)));
typedef unsigned u32x4 __attribute__((ext_vector_type(4)));
typedef unsigned u32x2 __attribute__((ext_vector_type(2)));
#define DI __device__ __forceinline__
#define LDSP(T, p) ((__attribute__((address_space(3))) T*)(p))

#ifndef ENABLE_MIX
#define ENABLE_MIX 1
#endif
#ifndef PROBE_REP
#define PROBE_REP 0
#endif
#ifndef ONE_LAUNCH
#define ONE_LAUNCH 1
#endif

constexpr int T_ = 16384, S_ = 8192, D_ = 1024, F_ = 2816, PW = 3200;
constexpr float ALPHA = 1.41421356237f;
constexpr int C_CQ = 0, C_CKV = 256, C_DQ = 384, C_DK = 768, C_DV = 1152, C_NQ = 1536, C_NQR = 1920, C_KC = 2304, C_VC = 2432,
              C_KSL = 2560, C_VSL = 2688, C_KW = 2816, C_VW = 2944, C_KPE = 3072, C_GL = 3104;
constexpr int NCMP = 511;

constexpr size_t SZ_FIN = 5632ull * 1024 * 2, SZ_FOUT = 1024ull * 2816 * 2, SZ_WIN = (size_t)PW * 1024 * 2, SZ_WOUT = 1024ull * 1024 * 2,
                 SZ_UQ = 384ull * 256 * 2, SZ_UKV = 512ull * 128 * 2, SZ_C1 = 256ull * 2048 * 2, SZ_C2 = 64ull * 256 * 2;
constexpr size_t LW_FIN = 0, LW_FOUT = LW_FIN + 2 * SZ_FIN, LW_WIN = LW_FOUT + 2 * SZ_FOUT, LW_WOUT = LW_WIN + SZ_WIN, LW_UQ = LW_WOUT + SZ_WOUT,
                 LW_UKV = LW_UQ + SZ_UQ, LW_C1 = LW_UKV + SZ_UKV, LW_C2 = LW_C1 + 2 * SZ_C1, LW_SIZE = LW_C2 + 2 * SZ_C2;
constexpr size_t OFF_CTRL = 0, OFF_C64 = 16384, OFF_S64 = OFF_C64 + 8192ull * 32 * 4, OFF_C32 = OFF_S64 + 8192ull * 32 * 4, OFF_S32 = OFF_C32 + 8192ull * 16 * 4,
                 OFF_CBIAS = OFF_S32 + 8192ull * 16 * 4, OFF_W = OFF_CBIAS + 4096, OFF_XB = OFF_W + 2 * LW_SIZE, OFF_BIG = OFF_XB + (size_t)T_ * D_ * 2,
                 OFF_QA = OFF_BIG + (size_t)T_ * PW * 2, OFF_KA = OFF_QA + (size_t)T_ * 384 * 2, OFF_VA = OFF_KA + (size_t)T_ * 384 * 2,
                 OFF_DILO = OFF_VA + (size_t)T_ * 256 * 2, OFF_DILL = OFF_DILO + 3ull * T_ * 384 * 2, OFF_CHID = OFF_DILL + 3ull * T_ * 6 * 4,
                 OFF_KCVC = OFF_CHID + 2ull * 2048 * 256 * 2, OFF_SEL = OFF_KCVC + 2ull * 2048 * 64 * 2, OFF_IMP = OFF_SEL + (size_t)T_ * 2 * 4 * 4,
                 OFF_END = OFF_IMP + (size_t)T_ * 2 * 128 * 4;

struct WDesc { const float* src; bf16_t* dst; const float* kscale; int K, Nsrc, Ndst, map, tile0, ntn; };
struct Params {
  const float* x; const float* ln_g; const float* ln_b; const float* cmp_pos; const float* cmp_w1;
  float* out; char* ws;
  WDesc wd[24];
  int n_wtiles; int pad0;
};
struct Ctx { const float* x; const float* ln_g; const float* ln_b; const float* cmp_pos; const float* cmp_w1; float* out; char* ws; int tid; };

DI bf16_t f2bf(float x) { unsigned u = __float_as_uint(x); u += 0x7fffu + ((u >> 16) & 1u); return (bf16_t)(u >> 16); }
DI float bf2f(bf16_t v) { return __uint_as_float(((unsigned)v) << 16); }
DI unsigned pk2(float a, float b) { return (unsigned)f2bf(a) | ((unsigned)f2bf(b) << 16); }
DI float fast_exp2(float x) { return __builtin_amdgcn_exp2f(x); }
DI float silu(float v) { return v * __builtin_amdgcn_rcpf(1.f + __expf(-v)); }
DI f32x4 mfma16(bf16x8 a, bf16x8 b, f32x4 c) { return __builtin_amdgcn_mfma_f32_16x16x32_bf16(a, b, c, 0, 0, 0); }

DI void sincos_rr(float ang, float& c, float& s) {
  const double rev = (double)ang * 0.15915494309189533577; const float fr = (float)(rev - rint(rev));
  c = __builtin_amdgcn_cosf(fr); s = __builtin_amdgcn_sinf(fr);
}

struct ALin { const bf16_t* A; int lda; int mmax; DI const bf16_t* ptr(int row, int k) const { row = row < mmax ? row : mmax - 1; return A + (size_t)row * lda + k; } };
struct ACmp {
  const bf16_t* proj; int colbase;
  DI const bf16_t* ptr(int m, int k) const { if (m > 2043) m = 2043; int b = m / 1022, rem = m - b * 1022, g = rem / 511, c = rem - g * 511;
    return proj + (size_t)(b * S_ + 16 * c + (k >> 6)) * PW + colbase + g * 64 + (k & 63); } };

template <class AL, class EPI>
DI void gemm_tile(const int tid, const AL al, const bf16_t* __restrict__ Bt, int ldb, int nvalid, int K, int m0, int n0, const EPI epi, char* smem) {
  const int lane = tid & 63, wave = tid >> 6, wr = wave >> 1, wc = wave & 1, g = lane >> 4;
  f32x4 acc[4][4];
#pragma unroll
  for (int i = 0; i < 4; ++i)
#pragma unroll
    for (int j = 0; j < 4; ++j) acc[i][j] = (f32x4){0.f, 0.f, 0.f, 0.f};
  const int srow = wave * 32 + (lane >> 3), sc8 = ((lane & 7) ^ (lane >> 3)) * 8;
  const bf16_t* bp[4];
#pragma unroll
  for (int i = 0; i < 4; ++i) { int r = n0 + srow + 8 * i; r = r < nvalid ? r : nvalid - 1; bp[i] = Bt + (size_t)r * ldb + sc8; }
  const int offA = (wr * 64 + (lane & 15)) * 128 + ((g ^ (lane & 7)) << 4);
  const int offB = (wc * 64 + (lane & 15)) * 128 + ((g ^ (lane & 7)) << 4);
  const int nk = K >> 6;
  auto stage = [&](int kt, int buf) {
    char* da = smem + buf * 32768 + wave * 4096; const int k0 = kt << 6;
#pragma unroll
    for (int i = 0; i < 4; ++i) {
      __builtin_amdgcn_global_load_lds((const unsigned*)al.ptr(m0 + srow + 8 * i, k0 + sc8), LDSP(unsigned, da + i * 1024), 16, 0, 0);
      __builtin_amdgcn_global_load_lds((const unsigned*)(bp[i] + k0), LDSP(unsigned, da + 16384 + i * 1024), 16, 0, 0);
    }
  };
  bf16x8 a0[4], b0[4], a1[4], b1[4];
  auto rd = [&](bf16x8 (&a)[4], bf16x8 (&b)[4], const char* sa, int ks) {
#pragma unroll
    for (int i = 0; i < 4; ++i) { a[i] = *(const bf16x8*)(sa + ((offA + i * 2048) ^ (ks << 6))); b[i] = *(const bf16x8*)(sa + 16384 + ((offB + i * 2048) ^ (ks << 6))); }
  };
  auto mm = [&](const bf16x8 (&a)[4], const bf16x8 (&b)[4]) {
#pragma unroll
    for (int i = 0; i < 4; ++i)
#pragma unroll
      for (int j = 0; j < 4; ++j) acc[i][j] = mfma16(a[i], b[j], acc[i][j]);
  };
  stage(0, 0);
  asm volatile("s_waitcnt vmcnt(0)" ::: "memory");
  __syncthreads();
  if (nk > 1) stage(1, 1);
  rd(a0, b0, smem, 0);
  for (int kt = 0; kt < nk; ++kt) {
    const char* sa = smem + (kt & 1) * 32768;
    rd(a1, b1, sa, 1);
    __builtin_amdgcn_sched_barrier(0);
    mm(a0, b0);
    __builtin_amdgcn_sched_barrier(0);
    asm volatile("s_waitcnt vmcnt(0)" ::: "memory");
    __syncthreads();
    if (kt + 2 < nk) stage(kt + 2, kt & 1);
    if (kt + 1 < nk) rd(a0, b0, smem + ((kt + 1) & 1) * 32768, 0);
    __builtin_amdgcn_sched_barrier(0);
    mm(a1, b1);
    __builtin_amdgcn_sched_barrier(0);
  }
  epi(acc, m0 + wr * 64, n0 + wc * 64, lane);
}

DI void store_plain(bf16_t* dst, int ld, const f32x4 (&acc)[4][4], int row0, int col0, int lane, float sc) {
#pragma unroll
  for (int mi = 0; mi < 4; ++mi)
#pragma unroll
    for (int r = 0; r < 4; ++r) { const int row = row0 + mi * 16 + (lane >> 4) * 4 + r;
#pragma unroll
      for (int ni = 0; ni < 4; ++ni) dst[(size_t)row * ld + col0 + ni * 16 + (lane & 15)] = f2bf(acc[mi][ni][r] * sc); }
}

struct EpiSwiGLU { bf16_t* H;
  DI void operator()(const f32x4 (&acc)[4][4], int row0, int col0, int lane) const {
#pragma unroll
    for (int mi = 0; mi < 4; ++mi)
#pragma unroll
      for (int r = 0; r < 4; ++r) { const int row = row0 + mi * 16 + (lane >> 4) * 4 + r;
#pragma unroll
        for (int pr = 0; pr < 2; ++pr) { const float gt = acc[mi][2 * pr][r], up = acc[mi][2 * pr + 1][r];
          H[(size_t)row * F_ + ((col0 >> 5) + pr) * 16 + (lane & 15)] = f2bf(silu(gt) * up); } }
  } };
struct EpiResid { const float* xin; float* y; float scale;
  DI void operator()(const f32x4 (&acc)[4][4], int row0, int col0, int lane) const {
#pragma unroll
    for (int mi = 0; mi < 4; ++mi)
#pragma unroll
      for (int r = 0; r < 4; ++r) { const int row = row0 + mi * 16 + (lane >> 4) * 4 + r;
#pragma unroll
        for (int ni = 0; ni < 4; ++ni) { const size_t ix = (size_t)row * D_ + col0 + ni * 16 + (lane & 15); y[ix] = ALPHA * xin[ix] + scale * acc[mi][ni][r]; } }
  } };
struct EpiProj { bf16_t* proj; bf16_t* ka; const float* c64; const float* s64; const float* c32; const float* s32;
  DI void operator()(const f32x4 (&acc)[4][4], int row0, int col0, int lane) const {
    const bool rope = (col0 >= C_DQ && col0 < C_DV) || (col0 >= C_NQR && col0 < C_KC) || (col0 >= C_KSL && col0 < C_VSL) || (col0 >= C_KW && col0 < C_VW);
    if (rope) {
#pragma unroll
      for (int mi = 0; mi < 4; ++mi)
#pragma unroll
        for (int r = 0; r < 4; ++r) { const int row = row0 + mi * 16 + (lane >> 4) * 4 + r, pos = row & (S_ - 1);
#pragma unroll
          for (int ni = 0; ni < 2; ++ni) { const int i = ni * 16 + (lane & 15); const float c = c64[pos * 32 + i], s = s64[pos * 32 + i];
            const float x1 = acc[mi][ni][r], x2 = acc[mi][ni + 2][r];
            proj[(size_t)row * PW + col0 + i] = f2bf(x1 * c - x2 * s); proj[(size_t)row * PW + col0 + 32 + i] = f2bf(x1 * s + x2 * c); } }
    } else if (col0 == C_KPE) {
#pragma unroll
      for (int mi = 0; mi < 4; ++mi)
#pragma unroll
        for (int r = 0; r < 4; ++r) { const int row = row0 + mi * 16 + (lane >> 4) * 4 + r, pos = row & (S_ - 1); const int i = lane & 15;
          const float c = c32[pos * 16 + i], s = s32[pos * 16 + i]; const float x1 = acc[mi][0][r], x2 = acc[mi][1][r];
          const bf16_t o1 = f2bf(x1 * c - x2 * s), o2 = f2bf(x1 * s + x2 * c);
#pragma unroll
          for (int h = 0; h < 4; ++h) { ka[(size_t)row * 384 + h * 96 + 64 + i] = o1; ka[(size_t)row * 384 + h * 96 + 80 + i] = o2; }
#pragma unroll
          for (int ni = 2; ni < 4; ++ni) { const float v = acc[mi][ni][r]; proj[(size_t)row * PW + col0 + ni * 16 + i] = f2bf(1.f / (1.f + __expf(-v))); } }
    } else store_plain(proj, PW, acc, row0, col0, lane, 1.f);
  } };
struct EpiMLAq { bf16_t* qa; const float* rs; int m0; const float* c32; const float* s32;
  DI void operator()(const f32x4 (&acc)[4][4], int row0, int col0, int lane) const {
#pragma unroll
    for (int mi = 0; mi < 4; ++mi)
#pragma unroll
      for (int r = 0; r < 4; ++r) { const int row = row0 + mi * 16 + (lane >> 4) * 4 + r, pos = row & (S_ - 1); const float sc = rs[row - m0]; const int i = lane & 15;
#pragma unroll
        for (int ch = 0; ch < 2; ++ch) { const int gc = col0 + 32 * ch; const float x1 = acc[mi][2 * ch][r] * sc, x2 = acc[mi][2 * ch + 1][r] * sc;
          if (((gc >> 5) % 3) == 2) { const float c = c32[pos * 16 + i], s = s32[pos * 16 + i];
            qa[(size_t)row * 384 + gc + i] = f2bf(x1 * c - x2 * s); qa[(size_t)row * 384 + gc + 16 + i] = f2bf(x1 * s + x2 * c); }
          else { qa[(size_t)row * 384 + gc + i] = f2bf(x1); qa[(size_t)row * 384 + gc + 16 + i] = f2bf(x2); } } }
  } };
struct EpiMLAkv { bf16_t* ka; bf16_t* va; const float* rs; int m0;
  DI void operator()(const f32x4 (&acc)[4][4], int row0, int col0, int lane) const {
    const int h = col0 >> 7, part = (col0 >> 6) & 1;
#pragma unroll
    for (int mi = 0; mi < 4; ++mi)
#pragma unroll
      for (int r = 0; r < 4; ++r) { const int row = row0 + mi * 16 + (lane >> 4) * 4 + r; const float sc = rs[row - m0];
#pragma unroll
        for (int ni = 0; ni < 4; ++ni) { const int j = ni * 16 + (lane & 15); const bf16_t v = f2bf(acc[mi][ni][r] * sc);
          if (part == 0) ka[(size_t)row * 384 + h * 96 + j] = v; else va[(size_t)row * 256 + h * 64 + j] = v; } }
  } };
struct EpiCmp1 { bf16_t* hid; const float* bias;
  DI void operator()(const f32x4 (&acc)[4][4], int row0, int col0, int lane) const {
#pragma unroll
    for (int mi = 0; mi < 4; ++mi)
#pragma unroll
      for (int r = 0; r < 4; ++r) { const int row = row0 + mi * 16 + (lane >> 4) * 4 + r;
#pragma unroll
        for (int ni = 0; ni < 4; ++ni) { const int col = col0 + ni * 16 + (lane & 15); hid[(size_t)row * 256 + col] = f2bf(silu(acc[mi][ni][r] + bias[col])); } }
  } };
struct EpiCmp2 { bf16_t* kc;
  DI void operator()(const f32x4 (&acc)[4][4], int row0, int col0, int lane) const {
    if (col0 >= 64) return;
#pragma unroll
    for (int mi = 0; mi < 4; ++mi)
#pragma unroll
      for (int r = 0; r < 4; ++r) { const int row = row0 + mi * 16 + (lane >> 4) * 4 + r;
        if (row < 2044) {
#pragma unroll
          for (int ni = 0; ni < 4; ++ni) kc[(size_t)row * 64 + col0 + ni * 16 + (lane & 15)] = f2bf(acc[mi][ni][r]); } }
  } };

template <int DQ, int MODE, class OUT>
DI void attn_core(const int tid, const bf16_t* __restrict__ Qb, long qs, const bf16_t* __restrict__ Kb, long kst, const bf16_t* __restrict__ Vb, long vst,
                  int q0, int k0, int kmax, int ntiles, const int* tlist, float sl2, int window,
                  const unsigned* selw, float* impg, bool first_head, float (&m_io)[2], float (&l_io)[2], const OUT out, char* smem) {
  constexpr int NKD = DQ / 32, CPR = DQ / 8, KST = (DQ == 64) ? 128 : 256;
  const int lane = tid & 63, wave = tid >> 6, g = lane >> 4, li = lane & 15;
  bf16x8 qf[2][NKD];
#pragma unroll
  for (int qt = 0; qt < 2; ++qt)
#pragma unroll
    for (int kd = 0; kd < NKD; ++kd) qf[qt][kd] = *(const bf16x8*)(Qb + (long)(q0 + wave * 32 + qt * 16 + li) * qs + kd * 32 + g * 8);
  int qidx[2]; qidx[0] = q0 + wave * 32 + li; qidx[1] = qidx[0] + 16;
  f32x4 o[4][2];
#pragma unroll
  for (int i = 0; i < 4; ++i) { o[i][0] = (f32x4){0.f, 0.f, 0.f, 0.f}; o[i][1] = (f32x4){0.f, 0.f, 0.f, 0.f}; }
  float mrun[2], lrun[2], invl[2], prev3[2];
#pragma unroll
  for (int qt = 0; qt < 2; ++qt) { prev3[qt] = 0.f;
    if (MODE == 3) { mrun[qt] = m_io[qt]; lrun[qt] = 0.f; invl[qt] = l_io[qt] > 0.f ? 1.f / l_io[qt] : 0.f; } else { mrun[qt] = -1e30f; lrun[qt] = 0.f; invl[qt] = 0.f; } }
  constexpr int RPP = 1024 / KST, NKP = 64 / RPP / 4;
  auto stage = [&](int jt, int buf) {
    const int kb = k0 + jt * 64; char* kbuf = smem + buf * 16384; char* vbuf = smem + 32768 + buf * 8192;
#pragma unroll
    for (int i = 0; i < NKP; ++i) { const int pc = wave * NKP + i; const int row = pc * RPP + (DQ == 64 ? (lane >> 3) : (lane >> 4));
      int c = (DQ == 64) ? ((lane & 7) ^ (row & 7)) : ((lane & 15) ^ (row & 7)); if (DQ != 64 && c >= CPR) c = 0;
      int ix = kb + row; ix = ix < 0 ? 0 : (ix > kmax ? kmax : ix);
      __builtin_amdgcn_global_load_lds((const unsigned*)(Kb + (long)ix * kst + c * 8), LDSP(unsigned, kbuf + pc * 1024), 16, 0, 0); }
    if (MODE != 2) {
#pragma unroll
      for (int i = 0; i < 2; ++i) { const int pc = wave * 2 + i; const int row = pc * 8 + (lane >> 3); const int pp = lane & 7;
        const int c = ((((pp >> 1) ^ ((row >> 1) & 3)) << 1) | (pp & 1));
        int ix = kb + row; ix = ix < 0 ? 0 : (ix > kmax ? kmax : ix);
        __builtin_amdgcn_global_load_lds((const unsigned*)(Vb + (long)ix * vst + c * 8), LDSP(unsigned, vbuf + pc * 1024), 16, 0, 0); }
    }
  };
  if (ntiles > 0) stage(tlist ? tlist[0] : 0, 0);
  asm volatile("s_waitcnt vmcnt(0)" ::: "memory");
  __syncthreads();
  for (int it = 0; it < ntiles; ++it) {
    const int jt = tlist ? tlist[it] : it;
    const bool more = it + 1 < ntiles;
    if (more) stage(tlist ? tlist[it + 1] : it + 1, (it + 1) & 1);
    const char* kbuf = smem + (it & 1) * 16384; const char* vbuf = smem + 32768 + (it & 1) * 8192;
    f32x4 st[4][2];
#pragma unroll
    for (int kt4 = 0; kt4 < 4; ++kt4) {
      bf16x8 kf[NKD]; const int row = kt4 * 16 + li;
#pragma unroll
      for (int kd = 0; kd < NKD; ++kd) kf[kd] = *(const bf16x8*)(kbuf + row * KST + (((kd * 4 + g) ^ (row & 7)) << 4));
#pragma unroll
      for (int qt = 0; qt < 2; ++qt) { f32x4 a = (f32x4){0.f, 0.f, 0.f, 0.f};
#pragma unroll
        for (int kd = 0; kd < NKD; ++kd) a = mfma16(kf[kd], qf[qt][kd], a);
        st[kt4][qt] = a; }
    }
    const int kbase = k0 + jt * 64;
    bool sb[2] = {true, true};
    if (MODE == 4) { sb[0] = (selw[(wave * 32 + li) * 4 + (jt >> 5)] >> (jt & 31)) & 1u; sb[1] = (selw[(wave * 32 + 16 + li) * 4 + (jt >> 5)] >> (jt & 31)) & 1u; }
    float alpha[2];
#pragma unroll
    for (int qt = 0; qt < 2; ++qt) {
      float mx = -1e30f;
#pragma unroll
      for (int kt4 = 0; kt4 < 4; ++kt4)
#pragma unroll
        for (int r = 0; r < 4; ++r) { const int kidx = kbase + kt4 * 16 + g * 4 + r; bool v;
          if (MODE == 0) v = kidx <= qidx[qt];
          else if (MODE == 1) v = (kidx >= 0) && (kidx <= qidx[qt]) && (qidx[qt] - kidx <= window);
          else if (MODE == 2 || MODE == 3) v = (kidx <= kmax) && (16 * kidx + 31 <= qidx[qt]);
          else v = (kidx <= qidx[qt]) && sb[qt];
          const float s = v ? st[kt4][qt][r] * sl2 : -1e30f; st[kt4][qt][r] = s; mx = fmaxf(mx, s); }
      if (MODE != 3) {
        mx = fmaxf(mx, __shfl_xor(mx, 16)); mx = fmaxf(mx, __shfl_xor(mx, 32));
        const float mn = fmaxf(mrun[qt], mx); alpha[qt] = fast_exp2(mrun[qt] - mn); mrun[qt] = mn;
      } else alpha[qt] = 1.f;
      float ls = 0.f;
#pragma unroll
      for (int kt4 = 0; kt4 < 4; ++kt4)
#pragma unroll
        for (int r = 0; r < 4; ++r) { const float s = st[kt4][qt][r]; float p = (s > -5e29f) ? fast_exp2(s - mrun[qt]) : 0.f; if (MODE == 3) p *= invl[qt]; st[kt4][qt][r] = p; ls += p; }
      lrun[qt] = lrun[qt] * alpha[qt] + ls;
    }
    if (MODE == 3) {
#pragma unroll
      for (int qt = 0; qt < 2; ++qt)
#pragma unroll
        for (int kt4 = 0; kt4 < 4; ++kt4) { const float p3 = st[kt4][qt][3]; const float a = (st[kt4][qt][0] + st[kt4][qt][1]) + (st[kt4][qt][2] + p3);
          const float give = (g == 3) ? prev3[qt] : p3; const float up = __shfl(give, (lane + 48) & 63); prev3[qt] = p3;
          float* ip = impg + (size_t)(wave * 32 + qt * 16 + li) * 128 + jt * 16 + kt4 * 4 + g; const float val = a + up;
          if (first_head) *ip = val; else *ip += val; }
    }
    if (MODE != 2) {
      if (MODE != 3) {
#pragma unroll
        for (int dt = 0; dt < 4; ++dt) { o[dt][0] *= alpha[0]; o[dt][1] *= alpha[1]; }
      }
#pragma unroll
      for (int ks2 = 0; ks2 < 2; ++ks2) {
        bf16x8 pf[2];
#pragma unroll
        for (int qt = 0; qt < 2; ++qt) { u32x4 w; w[0] = pk2(st[2 * ks2][qt][0], st[2 * ks2][qt][1]); w[1] = pk2(st[2 * ks2][qt][2], st[2 * ks2][qt][3]);
          w[2] = pk2(st[2 * ks2 + 1][qt][0], st[2 * ks2 + 1][qt][1]); w[3] = pk2(st[2 * ks2 + 1][qt][2], st[2 * ks2 + 1][qt][3]); pf[qt] = __builtin_bit_cast(bf16x8, w); }
        const int rowA = 32 * ks2 + 4 * g + (li >> 2), p_ = li & 3;
#pragma unroll
        for (int dt = 0; dt < 4; ++dt) {
          const int off = rowA * 128 + ((((dt ^ ((rowA >> 1) & 3)) << 1) | (p_ >> 1)) << 4) + 8 * (p_ & 1);
          const s16x4 lo = __builtin_amdgcn_ds_read_tr16_b64_v4i16(LDSP(s16x4, vbuf + off));
          const s16x4 hi = __builtin_amdgcn_ds_read_tr16_b64_v4i16(LDSP(s16x4, vbuf + off + 2048));
          const bf16x8 vf = __builtin_shufflevector(lo, hi, 0, 1, 2, 3, 4, 5, 6, 7);
          o[dt][0] = mfma16(vf, pf[0], o[dt][0]); o[dt][1] = mfma16(vf, pf[1], o[dt][1]);
        }
      }
    }
    asm volatile("s_waitcnt vmcnt(0)" ::: "memory");
    __syncthreads();
  }
#pragma unroll
  for (int qt = 0; qt < 2; ++qt) {
    float lt = lrun[qt]; lt += __shfl_xor(lt, 16); lt += __shfl_xor(lt, 32);
    if (MODE == 2) { m_io[qt] = mrun[qt]; l_io[qt] = lt; }
    else {
      const float inv = (MODE == 3) ? 1.f : (lt > 0.f ? 1.f / lt : 0.f);
#pragma unroll
      for (int dt = 0; dt < 4; ++dt) out(wave * 32 + qt * 16 + li, dt * 16 + g * 4, o[dt][qt] * inv, mrun[qt], lt);
    }
  }
}

struct OutSet { bf16_t* dst; long ld; const bf16_t* gate; long gld; float* lse; long lld;
  DI void operator()(int ql, int d0, f32x4 v, float m, float l) const {
    float gs = 1.f; if (gate) gs = bf2f(gate[ql * gld]);
    u32x2 w; w[0] = pk2(v[0] * gs, v[1] * gs); w[1] = pk2(v[2] * gs, v[3] * gs); *(u32x2*)(dst + ql * ld + d0) = w;
    if (lse && d0 == 0) lse[ql * lld] = (m + __log2f(l)) * 0.69314718056f;
  } };
struct OutAdd { bf16_t* dst; long ld; const bf16_t* gate; long gld;
  DI void operator()(int ql, int d0, f32x4 v, float m, float l) const {
    const float gs = bf2f(gate[ql * gld]); u32x2* p = (u32x2*)(dst + ql * ld + d0); const u32x2 old = *p;
    u32x2 w; w[0] = pk2(__uint_as_float(old[0] << 16) + v[0] * gs, __uint_as_float(old[0] & 0xffff0000u) + v[1] * gs);
    w[1] = pk2(__uint_as_float(old[1] << 16) + v[2] * gs, __uint_as_float(old[1] & 0xffff0000u) + v[3] * gs); *p = w;
  } };

DI bf16_t* lw(char* ws, int l, size_t off) { return (bf16_t*)(ws + OFF_W + (size_t)l * LW_SIZE + off); }

DI int colmap(int map, int n, int nsrc) {
  if (map == 0) return n < nsrc ? n : -1;
  if (map == 1) { const int t = n >> 5, i = n & 31; return i < 16 ? 16 * t + i : 2816 + 16 * t + (i - 16); }
  if (n < 384) return n;
  if (n < C_DV + 384) return 416 + (n - C_DQ);
  if (n < C_NQR) return 1568 + (n - C_NQ);
  if (n < C_KC) return 1568 + (n - C_NQR);
  if (n < C_KPE) return 1952 + (n - C_KC);
  if (n < C_GL) return 384 + (n - C_KPE);
  if (n < C_GL + 18) return 2720 + (n - C_GL);
  return -1;
}

DI void phase_prologue(const Params& P, const Ctx& p, char* smem) {
  const int tid = p.tid;
  const int n_w = P.n_wtiles, n_cb = 4, n_r64 = 256, n_r32 = 128, n_xb = 1024;
  const int total = n_w + n_cb + n_r64 + n_r32 + n_xb;
  for (int t = blockIdx.x; t < total; t += gridDim.x) {
    if (t < n_w) {
      int di = 0;
#pragma unroll 1
      for (int i = 1; i < 24; ++i) if (t >= P.wd[i].tile0) di = i;
      const WDesc d = P.wd[di]; const int lt = t - d.tile0, tn = lt % d.ntn, tk = lt / d.ntn, n0 = tn * 64, k0 = tk * 128;
      float* tile = (float*)smem;
      const int nn = tid & 63; const int sc = colmap(d.map, n0 + nn, d.Nsrc);
      float v[32];
#pragma unroll
      for (int i = 0; i < 32; ++i) { const int kk = (tid >> 6) + 4 * i; v[i] = (sc >= 0) ? d.src[(size_t)(k0 + kk) * d.Nsrc + sc] : 0.f; }
      if (d.kscale) {
#pragma unroll
        for (int i = 0; i < 32; ++i) v[i] *= d.kscale[k0 + (tid >> 6) + 4 * i];
      }
#pragma unroll
      for (int i = 0; i < 32; ++i) tile[((tid >> 6) + 4 * i) * 65 + nn] = v[i];
      __syncthreads();
      { const int on = tid >> 2, kq = tid & 3;
        bf16_t* dp = d.dst + (size_t)(n0 + on) * d.K + k0 + kq * 32;
#pragma unroll
        for (int c = 0; c < 4; ++c) { u32x4 w;
#pragma unroll
          for (int j = 0; j < 4; ++j) w[j] = pk2(tile[(kq * 32 + c * 8 + 2 * j) * 65 + on], tile[(kq * 32 + c * 8 + 2 * j + 1) * 65 + on]);
          *(u32x4*)(dp + c * 8) = w; } }
      __syncthreads();
    } else if (t < n_w + n_cb) {
      const int id = t - n_w; const float* pos = p.cmp_pos + (size_t)id * 2048; const float* w1 = p.cmp_w1 + (size_t)id * 2048 * 256; float a = 0.f;
      for (int k = 0; k < 2048; ++k) a += pos[k] * w1[(size_t)k * 256 + tid];
      ((float*)(p.ws + OFF_CBIAS))[id * 256 + tid] = a;
    } else if (t < n_w + n_cb + n_r64) {
      const int e0 = (t - n_w - n_cb) * 1024; float* C = (float*)(p.ws + OFF_C64); float* Sn = (float*)(p.ws + OFF_S64);
      for (int e = e0 + tid; e < e0 + 1024; e += 256) { const int pos = e >> 5, i = e & 31; const float inv = exp2f(-(float)(2 * i) / 64.f * 13.287712379549449f); const float ang = (float)pos * inv;
        sincos_rr(ang, C[e], Sn[e]); }
    } else if (t < n_w + n_cb + n_r64 + n_r32) {
      const int e0 = (t - n_w - n_cb - n_r64) * 1024; float* C = (float*)(p.ws + OFF_C32); float* Sn = (float*)(p.ws + OFF_S32);
      for (int e = e0 + tid; e < e0 + 1024; e += 256) { const int pos = e >> 4, i = e & 15; const float inv = exp2f(-(float)(2 * i) / 32.f * 13.287712379549449f); const float ang = (float)pos * inv;
        sincos_rr(ang, C[e], Sn[e]); }
    } else {
      const size_t e0 = (size_t)(t - n_w - n_cb - n_r64 - n_r32) * 16384 + tid * 8; bf16_t* xb = (bf16_t*)(p.ws + OFF_XB);
      f32x4 a[8], b[8];
#pragma unroll
      for (int i = 0; i < 8; ++i) { a[i] = *(const f32x4*)(p.x + e0 + i * 2048); b[i] = *(const f32x4*)(p.x + e0 + i * 2048 + 4); }
#pragma unroll
      for (int i = 0; i < 8; ++i) { u32x4 w; w[0] = pk2(a[i][0], a[i][1]); w[1] = pk2(a[i][2], a[i][3]); w[2] = pk2(b[i][0], b[i][1]); w[3] = pk2(b[i][2], b[i][3]);
        *(u32x4*)(xb + e0 + i * 2048) = w; }
    }
  }
}

DI bool tile_seq(int k, int NT, int total, int& mt, int& nt) {
  const int G = gridDim.x, b = blockIdx.x; const int s = k * G + (b & 7) * (G >> 3) + (b >> 3);
  if (s >= total) return false;
  const int band = s / (16 * NT), r = s - band * 16 * NT; nt = r >> 4; mt = band * 16 + (r & 15); return true;
}
DI void phase_ffn_up(const Ctx& p, int l, int j, char* smem) {
  const ALin al{(const bf16_t*)(p.ws + OFF_XB), D_, T_}; const bf16_t* Bt = lw(p.ws, l, LW_FIN + j * SZ_FIN); const EpiSwiGLU epi{(bf16_t*)(p.ws + OFF_BIG)};
  for (int k = 0;; ++k) { int mt, nt; if (!tile_seq(k, 44, 128 * 44, mt, nt)) break; gemm_tile(p.tid, al, Bt, D_, 5632, D_, mt * 128, nt * 128, epi, smem); }
}
DI void phase_ffn_down(const Ctx& p, int l, int j, char* smem) {
  const ALin al{(const bf16_t*)(p.ws + OFF_BIG), F_, T_}; const bf16_t* Bt = lw(p.ws, l, LW_FOUT + j * SZ_FOUT);
  const EpiResid epi{(l == 0 && j == 0) ? p.x : p.out, p.out, 0.5f};
  for (int k = 0;; ++k) { int mt, nt; if (!tile_seq(k, 8, 128 * 8, mt, nt)) break; gemm_tile(p.tid, al, Bt, F_, D_, F_, mt * 128, nt * 128, epi, smem); }
}
DI void phase_wout(const Ctx& p, int l, char* smem) {
  const ALin al{(const bf16_t*)(p.ws + OFF_XB), D_, T_}; const bf16_t* Bt = lw(p.ws, l, LW_WOUT); const EpiResid epi{p.out, p.out, 1.0f};
  for (int k = 0;; ++k) { int mt, nt; if (!tile_seq(k, 8, 128 * 8, mt, nt)) break; gemm_tile(p.tid, al, Bt, D_, D_, D_, mt * 128, nt * 128, epi, smem); }
}
DI void phase_ln(const Ctx& p, int l, int j, bool zero_o) {
  const int lane = p.tid & 63, wave = p.tid >> 6; const float* gp = p.ln_g + (size_t)(l * 3 + j) * D_; const float* bp = p.ln_b + (size_t)(l * 3 + j) * D_;
  bf16_t* xb = (bf16_t*)(p.ws + OFF_XB);
  for (int t = blockIdx.x; t < T_ / 4; t += gridDim.x) {
    const int row = t * 4 + wave; float* yr = p.out + (size_t)row * D_; f32x4 v[4]; float s = 0.f;
#pragma unroll
    for (int i = 0; i < 4; ++i) { v[i] = *(const f32x4*)(yr + i * 256 + lane * 4); s += (v[i][0] + v[i][1]) + (v[i][2] + v[i][3]); }
#pragma unroll
    for (int o = 1; o < 64; o <<= 1) s += __shfl_xor(s, o);
    const float mu = s * (1.f / D_); float q = 0.f;
#pragma unroll
    for (int i = 0; i < 4; ++i)
#pragma unroll
      for (int e = 0; e < 4; ++e) { const float d = v[i][e] - mu; q += d * d; }
#pragma unroll
    for (int o = 1; o < 64; o <<= 1) q += __shfl_xor(q, o);
    const float rstd = rsqrtf(q * (1.f / D_) + 1e-5f);
#pragma unroll
    for (int i = 0; i < 4; ++i) { const int c = i * 256 + lane * 4; const f32x4 gg = *(const f32x4*)(gp + c), bb = *(const f32x4*)(bp + c); f32x4 r;
#pragma unroll
      for (int e = 0; e < 4; ++e) r[e] = (v[i][e] - mu) * rstd * gg[e] + bb[e];
      *(f32x4*)(yr + c) = r; u32x2 w; w[0] = pk2(r[0], r[1]); w[1] = pk2(r[2], r[3]); *(u32x2*)(xb + (size_t)row * D_ + c) = w; }
  }
}
DI void phase_win(const Ctx& p, int l, char* smem) {
  const ALin al{(const bf16_t*)(p.ws + OFF_XB), D_, T_}; const bf16_t* Bt = lw(p.ws, l, LW_WIN);
  const EpiProj epi{(bf16_t*)(p.ws + OFF_BIG), (bf16_t*)(p.ws + OFF_KA), (const float*)(p.ws + OFF_C64), (const float*)(p.ws + OFF_S64), (const float*)(p.ws + OFF_C32), (const float*)(p.ws + OFF_S32)};
  for (int k = 0;; ++k) { int mt, nt; if (!tile_seq(k, 25, 128 * 25, mt, nt)) break; gemm_tile(p.tid, al, Bt, D_, PW, D_, mt * 128, nt * 128, epi, smem); }
}

DI int next_item(const int tid, unsigned* ctr, char* smem) {
  int* slot = (int*)(smem + 69632 - 16);
  __syncthreads();
  if (tid == 0) *slot = (int)atomicAdd(ctr, 1u);
  __syncthreads();
  return *slot;
}

DI void item_dilated(const Ctx& p, int id, char* smem) {
  const int pat = id / 768, r1 = id % 768, b = r1 / 384, r2 = r1 % 384, h = r2 >> 6, blk = r2 & 63;
  const int dil = pat == 0 ? 1 : (pat == 1 ? 4 : 16), nsub = 64 / dil, rho = blk / nsub, i = blk % nsub;
  const bf16_t* proj = (const bf16_t*)(p.ws + OFF_BIG); const bf16_t* base = proj + (size_t)(b * S_ + rho) * PW; const long rs = (long)dil * PW;
  bf16_t* dst = (bf16_t*)(p.ws + OFF_DILO) + ((size_t)pat * T_ + b * S_ + rho + (size_t)dil * 128 * i) * 384 + h * 64;
  float* lse = (float*)(p.ws + OFF_DILL) + ((size_t)pat * T_ + b * S_ + rho + (size_t)dil * 128 * i) * 6 + h;
  const OutSet out{dst, (long)dil * 384, nullptr, 0, lse, (long)dil * 6}; float mm[2], ll[2];
  attn_core<64, 1>(p.tid, base + C_DQ + h * 64, rs, base + C_DK + h * 64, rs, base + C_DV + h * 64, rs, 128 * i, 128 * i - 128, S_ / dil - 1, 4, nullptr,
                   0.125f * 1.44269504089f, 128, nullptr, nullptr, false, mm, ll, out, smem);
}
DI void item_nsawin(const Ctx& p, int id, char* smem) {
  const int b = id / 384, r = id % 384, h = r >> 6, i = r & 63, g = h / 3;
  const bf16_t* proj = (const bf16_t*)(p.ws + OFF_BIG); const bf16_t* base = proj + (size_t)(b * S_) * PW;
  bf16_t* o = (bf16_t*)(p.ws + OFF_XB) + (size_t)(b * S_ + 128 * i) * D_ + 640 + h * 64;
  const OutSet out{o, D_, base + (size_t)(128 * i) * PW + C_GL + h * 3 + 2, PW, nullptr, 0}; float mm[2], ll[2];
  attn_core<64, 1>(p.tid, base + C_NQR + h * 64, PW, base + C_KW + g * 64, PW, base + C_VW + g * 64, PW, 128 * i, 128 * i - 512, S_ - 1, 10, nullptr,
                   0.125f * 1.44269504089f, 512, nullptr, nullptr, false, mm, ll, out, smem);
}
DI void item_expand(const Ctx& p, int l, int id, char* smem) {
  const bf16_t* proj = (const bf16_t*)(p.ws + OFF_BIG); float* rs = (float*)(smem + 65536);
  const bool isq = id < 384; const int lid = isq ? id : id - 384; const int mt = isq ? lid / 3 : lid >> 2, nt = isq ? lid % 3 : lid & 3;
  const int K = isq ? 256 : 128, cb = isq ? C_CQ : C_CKV, tid = p.tid;
  { const int row = tid >> 1, half = tid & 1; const bf16_t* rp = proj + (size_t)(mt * 128 + row) * PW + cb + half * (K / 2); float ss = 0.f;
    for (int c = 0; c < K / 2; c += 8) { const u32x4 w = *(const u32x4*)(rp + c);
#pragma unroll
      for (int e = 0; e < 4; ++e) { const float a = __uint_as_float(w[e] << 16), b2 = __uint_as_float(w[e] & 0xffff0000u); ss += a * a + b2 * b2; } }
    ss += __shfl_xor(ss, 1); if (half == 0) rs[row] = rsqrtf(ss / (float)K + 1e-6f); }
  __syncthreads();
  const ALin al{proj + cb, PW, T_};
  if (isq) { const EpiMLAq epi{(bf16_t*)(p.ws + OFF_QA), rs, mt * 128, (const float*)(p.ws + OFF_C32), (const float*)(p.ws + OFF_S32)};
    gemm_tile(p.tid, al, lw(p.ws, l, LW_UQ), 256, 384, 256, mt * 128, nt * 128, epi, smem); }
  else { const EpiMLAkv epi{(bf16_t*)(p.ws + OFF_KA), (bf16_t*)(p.ws + OFF_VA), rs, mt * 128};
    gemm_tile(p.tid, al, lw(p.ws, l, LW_UKV), 128, 512, 128, mt * 128, nt * 128, epi, smem); }
}
DI void item_cmp(const Ctx& p, int l, int id, char* smem) {
  const int kv = id >> 4, mt = id & 15; const ACmp al1{(const bf16_t*)(p.ws + OFF_BIG), kv ? C_VC : C_KC};
  bf16_t* hid = (bf16_t*)(p.ws + OFF_CHID) + (size_t)kv * 2048 * 256;
  const EpiCmp1 epi1{hid, (const float*)(p.ws + OFF_CBIAS) + (l * 2 + kv) * 256};
#pragma unroll 1
  for (int nt = 0; nt < 2; ++nt) gemm_tile(p.tid, al1, lw(p.ws, l, LW_C1 + kv * SZ_C1), 2048, 256, 2048, mt * 128, nt * 128, epi1, smem);
  asm volatile("s_waitcnt vmcnt(0)" ::: "memory");
  __syncthreads();
  const ALin al2{hid, 256, 2048}; const EpiCmp2 epi2{(bf16_t*)(p.ws + OFF_KCVC) + (size_t)kv * 2048 * 64};
  int t2 = p.tid; asm volatile("" : "+v"(t2));
  gemm_tile(t2, al2, lw(p.ws, l, LW_C2 + kv * SZ_C2), 256, 64, 256, mt * 128, 0, epi2, smem);
}
DI void item_mla(const Ctx& p, int id, char* smem) {
  const int i = 63 - (id >> 3), bh = id & 7, b = bh >> 2, h = bh & 3;
  const bf16_t* qa = (const bf16_t*)(p.ws + OFF_QA) + (size_t)(b * S_) * 384 + h * 96; const bf16_t* ka = (const bf16_t*)(p.ws + OFF_KA) + (size_t)(b * S_) * 384 + h * 96;
  const bf16_t* va = (const bf16_t*)(p.ws + OFF_VA) + (size_t)(b * S_) * 256 + h * 64;
  bf16_t* o = (bf16_t*)(p.ws + OFF_XB) + (size_t)(b * S_ + 128 * i) * D_ + h * 64; const OutSet out{o, D_, nullptr, 0, nullptr, 0}; float mm[2], ll[2];
  attn_core<96, 0>(p.tid, qa, 384, ka, 384, va, 256, 128 * i, 0, S_ - 1, 2 * (i + 1), nullptr, 0.10206207261f * 1.44269504089f, 0, nullptr, nullptr, false, mm, ll, out, smem);
}
DI void item_nsacmp(const Ctx& p, int id, char* smem) {
  const int i = 63 - (id >> 2), bg = id & 3, b = bg >> 1, g = bg & 1, tid = p.tid;
  const bf16_t* proj = (const bf16_t*)(p.ws + OFF_BIG); const bf16_t* base = proj + (size_t)(b * S_) * PW;
  const bf16_t* kc = (const bf16_t*)(p.ws + OFF_KCVC) + (size_t)((b * 2 + g) * NCMP) * 64; const bf16_t* vc = kc + (size_t)2048 * 64;
  float* imp = (float*)(p.ws + OFF_IMP) + ((size_t)((b * 2 + g) * S_) + 128 * i) * 128;
  const int nkt = (i + 8) >> 3;
#pragma unroll 1
  for (int hh = 0; hh < 3; ++hh) { const int h = g * 3 + hh; float mm[2], ll[2];
    bf16_t* o = (bf16_t*)(p.ws + OFF_XB) + (size_t)(b * S_ + 128 * i) * D_ + 640 + h * 64;
    const OutAdd out{o, D_, base + (size_t)(128 * i) * PW + C_GL + h * 3 + 0, PW};
    attn_core<64, 2>(p.tid, base + C_NQ + h * 64, PW, kc, 64, vc, 64, 128 * i, 0, NCMP - 1, nkt, nullptr, 0.125f * 1.44269504089f, 0, nullptr, nullptr, false, mm, ll, out, smem);
    attn_core<64, 3>(p.tid, base + C_NQ + h * 64, PW, kc, 64, vc, 64, 128 * i, 0, NCMP - 1, nkt, nullptr, 0.125f * 1.44269504089f, 0, nullptr, imp, hh == 0, mm, ll, out, smem);
  }
  __syncthreads();
  float* sc = (float*)smem;
  const int q = tid >> 1, half = tid & 1, qpos = 128 * i + q, cur = qpos >> 6;
#pragma unroll 2
  for (int j = half * 64; j < half * 64 + 64; ++j) { const float v = (j < nkt * 16) ? imp[(size_t)q * 128 + j] : 0.f; const bool forced = (j == 0) || (j == cur) || (j == cur - 1);
    sc[q * 129 + j] = forced ? 1e4f : (j <= cur ? v : -1e4f); }
  unsigned m0 = 0, m1 = 0, m2 = 0, m3 = 0;
#pragma unroll 1
  for (int rd = 0; rd < 16; ++rd) {
    float bv = -3e38f; int bj = half * 64;
#pragma unroll 4
    for (int j = half * 64; j < half * 64 + 64; ++j) { const float v = sc[q * 129 + j]; if (v > bv) { bv = v; bj = j; } }
    const float ov = __shfl_xor(bv, 1); const int oj = __shfl_xor(bj, 1);
    if (ov > bv || (ov == bv && oj < bj)) { bv = ov; bj = oj; }
    if ((bj >> 6) == half) sc[q * 129 + bj] = -3.2e38f;
    if (bj <= cur) { const unsigned bit = 1u << (bj & 31); const int w = bj >> 5; m0 |= (w == 0) ? bit : 0u; m1 |= (w == 1) ? bit : 0u; m2 |= (w == 2) ? bit : 0u; m3 |= (w == 3) ? bit : 0u; }
  }
  if (half == 0) { u32x4 w; w[0] = m0; w[1] = m1; w[2] = m2; w[3] = m3; *(u32x4*)((unsigned*)(p.ws + OFF_SEL) + ((size_t)(b * S_ + qpos) * 2 + g) * 4) = w; }
  __syncthreads();
}
DI void item_dilcombine(const Ctx& p, int id) {
  const size_t e = (size_t)id * 256 + p.tid; const int tok = (int)(e / 48), r = (int)(e % 48), h = r >> 3, d0 = (r & 7) * 8;
  const float* L = (const float*)(p.ws + OFF_DILL); const bf16_t* O = (const bf16_t*)(p.ws + OFF_DILO);
  const float l0 = L[(size_t)tok * 6 + h], l1 = L[((size_t)T_ + tok) * 6 + h], l2 = L[((size_t)2 * T_ + tok) * 6 + h]; const float mx = fmaxf(l0, fmaxf(l1, l2));
  float w0 = __expf(l0 - mx), w1 = __expf(l1 - mx), w2 = __expf(l2 - mx); const float inv = 1.f / (w0 + w1 + w2); w0 *= inv; w1 *= inv; w2 *= inv;
  const u32x4 a = *(const u32x4*)(O + (size_t)tok * 384 + h * 64 + d0), b = *(const u32x4*)(O + ((size_t)T_ + tok) * 384 + h * 64 + d0), c = *(const u32x4*)(O + ((size_t)2 * T_ + tok) * 384 + h * 64 + d0);
  u32x4 w;
#pragma unroll
  for (int k = 0; k < 4; ++k) { const float lo = w0 * __uint_as_float(a[k] << 16) + w1 * __uint_as_float(b[k] << 16) + w2 * __uint_as_float(c[k] << 16);
    const float hi = w0 * __uint_as_float(a[k] & 0xffff0000u) + w1 * __uint_as_float(b[k] & 0xffff0000u) + w2 * __uint_as_float(c[k] & 0xffff0000u); w[k] = pk2(lo, hi); }
  *(u32x4*)((bf16_t*)(p.ws + OFF_XB) + (size_t)tok * D_ + 256 + h * 64 + d0) = w;
}
DI void item_nsaslc(const Ctx& p, int id, char* smem) {
  const int i = 63 - id / 12, r = id % 12, b = r / 6, h = r % 6, g = h / 3, tid = p.tid;
  const bf16_t* proj = (const bf16_t*)(p.ws + OFF_BIG); const bf16_t* base = proj + (size_t)(b * S_) * PW;
  unsigned* selw = (unsigned*)(smem + 49152 + 2048); int* tlist = (int*)(smem + 49152); unsigned* un = (unsigned*)(smem + 49152 + 1024);
  __syncthreads();
  if (tid < 4) un[tid] = 0u;
  __syncthreads();
  if (tid < 128) { const u32x4 w = *(const u32x4*)((const unsigned*)(p.ws + OFF_SEL) + ((size_t)(b * S_ + 128 * i + tid) * 2 + g) * 4);
    selw[tid * 4 + 0] = w[0]; selw[tid * 4 + 1] = w[1]; selw[tid * 4 + 2] = w[2]; selw[tid * 4 + 3] = w[3];
    atomicOr(&un[0], w[0]); atomicOr(&un[1], w[1]); atomicOr(&un[2], w[2]); atomicOr(&un[3], w[3]); }
  __syncthreads();
  if (tid == 0) { int n = 0; for (int jt = 0; jt < 2 * (i + 1); ++jt) if ((un[jt >> 5] >> (jt & 31)) & 1u) tlist[n++] = jt; tlist[255] = n; }
  __syncthreads();
  const int nt = tlist[255];
  bf16_t* o = (bf16_t*)(p.ws + OFF_XB) + (size_t)(b * S_ + 128 * i) * D_ + 640 + h * 64;
  const OutAdd out{o, D_, base + (size_t)(128 * i) * PW + C_GL + h * 3 + 1, PW}; float mm[2], ll[2];
  attn_core<64, 4>(p.tid, base + C_NQR + h * 64, PW, base + C_KSL + g * 64, PW, base + C_VSL + g * 64, PW, 128 * i, 0, S_ - 1, nt, tlist, 0.125f * 1.44269504089f, 0, selw, nullptr, false, mm, ll, out, smem);
}

DI void phase_mix_a(const Ctx& p0, int l, char* smem, int ci) {
  unsigned* ctr = (unsigned*)(p0.ws + OFF_CTRL) + l * 8 + ci; const int total = 32 + 768 + 2304 + 896;
  for (;;) { Ctx q = p0; asm volatile("" : "+v"(q.tid)); asm volatile("" : "+v"(q.ws)); const Ctx& p = q; const int t = next_item(p.tid, ctr, smem); if (t >= total) break;
    if (t < 32) item_cmp(p, l, t, smem); else if (t < 32 + 768) item_nsawin(p, t - 32, smem); else if (t < 32 + 768 + 2304) item_dilated(p, t - 32 - 768, smem);
    else item_expand(p, l, t - 32 - 768 - 2304, smem); }
}
DI void phase_mix_b(const Ctx& p0, int l, char* smem, int ci) {
  unsigned* ctr = (unsigned*)(p0.ws + OFF_CTRL) + l * 8 + ci; const int total = 512 + 256 + 3072;
  for (;;) { Ctx q = p0; asm volatile("" : "+v"(q.tid)); asm volatile("" : "+v"(q.ws)); const Ctx& p = q; const int t = next_item(p.tid, ctr, smem); if (t >= total) break;
    if (t < 512) item_mla(p, t, smem);
    else if (t < 512 + 256) item_nsacmp(p, t - 512, smem); else item_dilcombine(p, t - 512 - 256); }
}
DI void phase_mix_d(const Ctx& p0, int l, char* smem) {
  unsigned* ctr = (unsigned*)(p0.ws + OFF_CTRL) + l * 8 + 3; const int total = 768;
  for (;;) { Ctx q = p0; asm volatile("" : "+v"(q.tid)); asm volatile("" : "+v"(q.ws)); const Ctx& p = q; const int t = next_item(p.tid, ctr, smem); if (t >= total) break; item_nsaslc(p, t, smem); }
}
DI void phase_zero_o(const Ctx& p) {
  u32x4* o = (u32x4*)(p.ws + OFF_XB); const u32x4 z = (u32x4){0u, 0u, 0u, 0u};
  for (size_t e = (size_t)blockIdx.x * 256 + p.tid; e < (size_t)T_ * D_ / 8; e += (size_t)gridDim.x * 256) o[e] = z;
}

DI void run_phase(const Params& P, int ph, char* smem) {
  Ctx p; p.x = P.x; p.ln_g = P.ln_g; p.ln_b = P.ln_b; p.cmp_pos = P.cmp_pos; p.cmp_w1 = P.cmp_w1; p.out = P.out; p.ws = P.ws; p.tid = threadIdx.x;
  asm volatile("" : "+v"(p.tid));
  if (ph == 0) { phase_prologue(P, p, smem); return; }
  const int l = (ph - 1) / 12; int s = (ph - 1) % 12;
#ifdef ONLY_S
  if (s != ONLY_S) return;
  s = ONLY_S;
#endif
  switch (s) {
    case 0: phase_ffn_up(p, l, 0, smem); break;
    case 1: phase_ffn_down(p, l, 0, smem); break;
    case 2: phase_ln(p, l, 0, false); break;
#if ENABLE_MIX
    case 3: phase_win(p, l, smem); break;
    case 4: phase_mix_a(p, l, smem, 0); break;
    case 5: phase_mix_b(p, l, smem, 1); break;
    case 6: phase_mix_d(p, l, smem); break;
#else
    case 3: phase_zero_o(p); break;
    case 4: case 5: case 6: break;
#endif
    case 7: phase_wout(p, l, smem); break;
    case 8: phase_ln(p, l, 1, false); break;
    case 9: phase_ffn_up(p, l, 1, smem); break;
    case 10: phase_ffn_down(p, l, 1, smem); break;
    case 11: phase_ln(p, l, 2, false); break;
  }
}
constexpr int NPHASE = 25;

#if ONE_LAUNCH
DI unsigned xb_ld(unsigned* p) { return __hip_atomic_load(p, __ATOMIC_RELAXED, __HIP_MEMORY_SCOPE_AGENT); }
DI unsigned xb_add(unsigned* p, unsigned v) { return __hip_atomic_fetch_add(p, v, __ATOMIC_RELAXED, __HIP_MEMORY_SCOPE_AGENT); }
DI void xb_st(unsigned* p, unsigned v) { __hip_atomic_store(p, v, __ATOMIC_RELAXED, __HIP_MEMORY_SCOPE_AGENT); }
constexpr int XB_CNT = 256, XB_SUB = 256 + 64 * 16, XB_GEN = 256 + 64 * 32, XB_TOP = 256 + 64 * 48, XB_TOPGEN = 256 + 64 * 49, XB_WORDS = 256 + 64 * 50;
DI void grid_bar(const Params& P, unsigned idx, char* smem) {
  asm volatile("s_waitcnt vmcnt(0)" ::: "memory");
  __syncthreads();
  int t = threadIdx.x; asm volatile("" : "+v"(t));
  if (t == 0) {
    unsigned* bar = (unsigned*)(P.ws + OFF_CTRL);
    volatile unsigned* st = (volatile unsigned*)(smem + 69632 - 16);
    const unsigned x = st[1], nloc = st[2], nx = st[3];
    const unsigned old = xb_add(&bar[XB_SUB + 64 * x], 1u);
    if (old + 1u == idx * nloc) {
      __builtin_amdgcn_fence(__ATOMIC_RELEASE, "agent");
      asm volatile("s_waitcnt vmcnt(0)" ::: "memory");
      const unsigned og = xb_add(&bar[XB_TOP], 1u);
      if (og + 1u == idx * nx) xb_st(&bar[XB_TOPGEN], idx);
      else { while (xb_ld(&bar[XB_TOPGEN]) < idx) __builtin_amdgcn_s_sleep(1); }
      xb_st(&bar[XB_GEN + 64 * x], idx);
    } else { while (xb_ld(&bar[XB_GEN + 64 * x]) < idx) __builtin_amdgcn_s_sleep(1); }
    __builtin_amdgcn_fence(__ATOMIC_ACQUIRE, "agent");
    asm volatile("s_waitcnt vmcnt(0)" ::: "memory");
  }
  __syncthreads();
}
template <int PH> DI void run_all(const Params& p, char* smem) {
  run_phase(p, PH, smem);
  if constexpr (PH + 1 < NPHASE) { grid_bar(p, PH + 1, smem); run_all<PH + 1>(p, smem); }
}
__global__ void __launch_bounds__(256, 2) mega_kernel(Params p) {
  __shared__ __attribute__((aligned(16))) char smem[69632];
  {
    unsigned* bar = (unsigned*)(p.ws + OFF_CTRL); volatile unsigned* st = (volatile unsigned*)(smem + 69632 - 16);
    const unsigned x = (unsigned)__builtin_amdgcn_s_getreg((3 << 11) | 20) & 0xFu;
    if (threadIdx.x == 0) xb_add(&bar[XB_CNT + 64 * x], 1u);
    cg::this_grid().sync();
    if (threadIdx.x == 0) { unsigned nx = 0, mine = 1;
      for (unsigned j = 0; j < 16; ++j) { const unsigned c = xb_ld(&bar[XB_CNT + 64 * j]); nx += (c > 0u) ? 1u : 0u; if (j == x) mine = c; }
      st[1] = x; st[2] = mine; st[3] = nx; }
    __syncthreads();
  }
  run_all<0>(p, smem);
}
#define MAIN_KERNEL mega_kernel
#else
#define MAIN_KERNEL phase_kernel
#endif
__global__ void __launch_bounds__(256, 2) phase_kernel(Params p, int ph) {
  __shared__ __attribute__((aligned(16))) char smem[69632];
  run_phase(p, ph, smem);
}

extern "C" void kernel_launch(void* const* d_in, const int* in_sizes, int n_in, void* d_out, int out_size, void* d_ws, size_t ws_size, hipStream_t stream) {
  static int grid_blocks = 0;
  if (!grid_blocks) { int dev = 0, cus = 0, per_cu = 0; hipGetDevice(&dev); hipDeviceGetAttribute(&cus, hipDeviceAttributeMultiprocessorCount, dev);
    hipOccupancyMaxActiveBlocksPerMultiprocessor(&per_cu, MAIN_KERNEL, 256, 0); if (per_cu > 2) per_cu = 2; if (per_cu < 1) per_cu = 1; grid_blocks = cus * per_cu; }
  if (ws_size < OFF_END) { fprintf(stderr, "workspace too small: %zu < %zu\n", ws_size, (size_t)OFF_END); return; }
  Params p; memset(&p, 0, sizeof(p));
  const float* x = (const float*)d_in[0]; const float* ffn_in = (const float*)d_in[1]; const float* ffn_out = (const float*)d_in[2];
  const float* w_in = (const float*)d_in[5]; const float* w_out = (const float*)d_in[6]; const float* qn = (const float*)d_in[7]; const float* kvn = (const float*)d_in[8];
  const float* wuq = (const float*)d_in[9]; const float* wukv = (const float*)d_in[10]; const float* cw1 = (const float*)d_in[12]; const float* cw2 = (const float*)d_in[13];
  p.x = x; p.ln_g = (const float*)d_in[3]; p.ln_b = (const float*)d_in[4]; p.cmp_pos = (const float*)d_in[11]; p.cmp_w1 = cw1; p.out = (float*)d_out; p.ws = (char*)d_ws;
  int tile0 = 0, di = 0;
  auto add = [&](const float* src, size_t dst_off, const float* ksc, int K, int Nsrc, int Ndst, int map) {
    WDesc& d = p.wd[di++]; d.src = src; d.dst = (bf16_t*)((char*)d_ws + dst_off); d.kscale = ksc; d.K = K; d.Nsrc = Nsrc; d.Ndst = Ndst; d.map = map; d.tile0 = tile0; d.ntn = Ndst / 64;
    tile0 += (Ndst / 64) * (K / 128); };
  for (int l = 0; l < 2; ++l) { const size_t wb = OFF_W + (size_t)l * LW_SIZE;
    for (int j = 0; j < 2; ++j) add(ffn_in + (size_t)(l * 2 + j) * 1024 * 5632, wb + LW_FIN + j * SZ_FIN, nullptr, 1024, 5632, 5632, 1);
    for (int j = 0; j < 2; ++j) add(ffn_out + (size_t)(l * 2 + j) * 2816 * 1024, wb + LW_FOUT + j * SZ_FOUT, nullptr, 2816, 1024, 1024, 0);
    add(w_in + (size_t)l * 1024 * 2738, wb + LW_WIN, nullptr, 1024, 2738, PW, 2);
    add(w_out + (size_t)l * 1024 * 1024, wb + LW_WOUT, nullptr, 1024, 1024, 1024, 0);
    add(wuq + (size_t)l * 256 * 384, wb + LW_UQ, qn + l * 256, 256, 384, 384, 0);
    add(wukv + (size_t)l * 128 * 512, wb + LW_UKV, kvn + l * 128, 128, 512, 512, 0);
    for (int kv = 0; kv < 2; ++kv) add(cw1 + (size_t)(l * 2 + kv) * 2048 * 256, wb + LW_C1 + kv * SZ_C1, nullptr, 2048, 256, 256, 0);
    for (int kv = 0; kv < 2; ++kv) add(cw2 + (size_t)(l * 2 + kv) * 256 * 64, wb + LW_C2 + kv * SZ_C2, nullptr, 256, 64, 64, 0);
  }
  p.n_wtiles = tile0;
  hipMemsetAsync((char*)d_ws + OFF_CTRL, 0, 16384, stream);
#if ONE_LAUNCH
  void* args[] = {&p};
  hipError_t e = hipLaunchCooperativeKernel((void*)mega_kernel, dim3(grid_blocks), dim3(256), args, 0, stream);
  if (e != hipSuccess) fprintf(stderr, "cooperative launch failed: %s (grid %d)\n", hipGetErrorString(e), grid_blocks);
#else
  for (int ph = 0; ph < NPHASE; ++ph) phase_kernel<<<dim3(grid_blocks), dim3(256), 0, stream>>>(p, ph);
#endif
}
```

```cpp
#include <hip/hip_runtime.h>
#include <hip/hip_cooperative_groups.h>
#include <cstdio>
#include <cstdint>
#include <cstring>
namespace cg = cooperative_groups;

typedef unsigned short bf16_t;
typedef short bf16x8 __attribute__((ext_vector_type(8)));
typedef short s16x4 __attribute__((ext_vector_type(4)));
typedef float f32x4 __attribute__((ext_vector_type(4)));
typedef unsigned u32x4 __attribute__((ext_vector_type(4)));
typedef unsigned u32x2 __attribute__((ext_vector_type(2)));
#define DI __device__ __forceinline__
#define LDSP(T, p) ((__attribute__((address_space(3))) T*)(p))

#ifndef ENABLE_MIX
#define ENABLE_MIX 1
#endif
#ifndef PROBE_REP
#define PROBE_REP 0
#endif
#ifndef ONE_LAUNCH
#define ONE_LAUNCH 1
#endif

constexpr int T_ = 16384, S_ = 8192, D_ = 1024, F_ = 2816, PW = 3200;
constexpr float ALPHA = 1.41421356237f;
constexpr int C_CQ = 0, C_CKV = 256, C_DQ = 384, C_DK = 768, C_DV = 1152, C_NQ = 1536, C_NQR = 1920, C_KC = 2304, C_VC = 2432,
              C_KSL = 2560, C_VSL = 2688, C_KW = 2816, C_VW = 2944, C_KPE = 3072, C_GL = 3104;
constexpr int NCMP = 511;

constexpr size_t SZ_FIN = 5632ull * 1024 * 2, SZ_FOUT = 1024ull * 2816 * 2, SZ_WIN = (size_t)PW * 1024 * 2, SZ_WOUT = 1024ull * 1024 * 2,
                 SZ_UQ = 384ull * 256 * 2, SZ_UKV = 512ull * 128 * 2, SZ_C1 = 256ull * 2048 * 2, SZ_C2 = 64ull * 256 * 2;
constexpr size_t LW_FIN = 0, LW_FOUT = LW_FIN + 2 * SZ_FIN, LW_WIN = LW_FOUT + 2 * SZ_FOUT, LW_WOUT = LW_WIN + SZ_WIN, LW_UQ = LW_WOUT + SZ_WOUT,
                 LW_UKV = LW_UQ + SZ_UQ, LW_C1 = LW_UKV + SZ_UKV, LW_C2 = LW_C1 + 2 * SZ_C1, LW_SIZE = LW_C2 + 2 * SZ_C2;
constexpr size_t OFF_CTRL = 0, OFF_C64 = 16384, OFF_S64 = OFF_C64 + 8192ull * 32 * 4, OFF_C32 = OFF_S64 + 8192ull * 32 * 4, OFF_S32 = OFF_C32 + 8192ull * 16 * 4,
                 OFF_CBIAS = OFF_S32 + 8192ull * 16 * 4, OFF_W = OFF_CBIAS + 4096, OFF_XB = OFF_W + 2 * LW_SIZE, OFF_BIG = OFF_XB + (size_t)T_ * D_ * 2,
                 OFF_QA = OFF_BIG + (size_t)T_ * PW * 2, OFF_KA = OFF_QA + (size_t)T_ * 384 * 2, OFF_VA = OFF_KA + (size_t)T_ * 384 * 2,
                 OFF_DILO = OFF_VA + (size_t)T_ * 256 * 2, OFF_DILL = OFF_DILO + 3ull * T_ * 384 * 2, OFF_CHID = OFF_DILL + 3ull * T_ * 6 * 4,
                 OFF_KCVC = OFF_CHID + 2ull * 2048 * 256 * 2, OFF_SEL = OFF_KCVC + 2ull * 2048 * 64 * 2, OFF_IMP = OFF_SEL + (size_t)T_ * 2 * 4 * 4,
                 OFF_END = OFF_IMP + (size_t)T_ * 2 * 128 * 4;

struct WDesc { const float* src; bf16_t* dst; const float* kscale; int K, Nsrc, Ndst, map, tile0, ntn; };
struct Params {
  const float* x; const float* ln_g; const float* ln_b; const float* cmp_pos; const float* cmp_w1;
  float* out; char* ws;
  WDesc wd[24];
  int n_wtiles; int n_early;
};
struct Ctx { const float* x; const float* ln_g; const float* ln_b; const float* cmp_pos; const float* cmp_w1; float* out; char* ws; int tid; };

DI bf16_t f2bf(float x) { unsigned u = __float_as_uint(x); u += 0x7fffu + ((u >> 16) & 1u); return (bf16_t)(u >> 16); }
DI float bf2f(bf16_t v) { return __uint_as_float(((unsigned)v) << 16); }
DI unsigned pk2(float a, float b) { return (unsigned)f2bf(a) | ((unsigned)f2bf(b) << 16); }
DI float fast_exp2(float x) { return __builtin_amdgcn_exp2f(x); }
DI float silu(float v) { return v * __builtin_amdgcn_rcpf(1.f + __expf(-v)); }
DI f32x4 mfma16(bf16x8 a, bf16x8 b, f32x4 c) { return __builtin_amdgcn_mfma_f32_16x16x32_bf16(a, b, c, 0, 0, 0); }

DI void sincos_rr(float ang, float& c, float& s) {
  const double rev = (double)ang * 0.15915494309189533577; const float fr = (float)(rev - rint(rev));
  c = __builtin_amdgcn_cosf(fr); s = __builtin_amdgcn_sinf(fr);
}

struct ALin { const bf16_t* A; int lda; int mmax; DI const bf16_t* ptr(int row, int k) const { row = row < mmax ? row : mmax - 1; return A + (size_t)row * lda + k; } };
struct ACmp {
  const bf16_t* proj; int colbase;
  DI const bf16_t* ptr(int m, int k) const { if (m > 2043) m = 2043; int b = m / 1022, rem = m - b * 1022, g = rem / 511, c = rem - g * 511;
    return proj + (size_t)(b * S_ + 16 * c + (k >> 6)) * PW + colbase + g * 64 + (k & 63); } };

template <class AL, class EPI>
DI void gemm_tile(const int tid, const AL al, const bf16_t* __restrict__ Bt, int ldb, int nvalid, int K, int m0, int n0, const EPI epi, char* smem) {
  const int lane = tid & 63, wave = tid >> 6, wr = wave >> 1, wc = wave & 1, g = lane >> 4;
  f32x4 acc[4][4];
#pragma unroll
  for (int i = 0; i < 4; ++i)
#pragma unroll
    for (int j = 0; j < 4; ++j) acc[i][j] = (f32x4){0.f, 0.f, 0.f, 0.f};
  const int srow = wave * 32 + (lane >> 3), sc8 = ((lane & 7) ^ (lane >> 3)) * 8;
  const bf16_t* bp[4];
#pragma unroll
  for (int i = 0; i < 4; ++i) { int r = n0 + srow + 8 * i; r = r < nvalid ? r : nvalid - 1; bp[i] = Bt + (size_t)r * ldb + sc8; }
  const int offA = (wr * 64 + (lane & 15)) * 128 + ((g ^ (lane & 7)) << 4);
  const int offB = (wc * 64 + (lane & 15)) * 128 + ((g ^ (lane & 7)) << 4);
  const int nk = K >> 6;
  auto stage = [&](int kt, int buf) {
    char* da = smem + buf * 32768 + wave * 4096; const int k0 = kt << 6;
#pragma unroll
    for (int i = 0; i < 4; ++i) {
      __builtin_amdgcn_global_load_lds((const unsigned*)al.ptr(m0 + srow + 8 * i, k0 + sc8), LDSP(unsigned, da + i * 1024), 16, 0, 0);
      __builtin_amdgcn_global_load_lds((const unsigned*)(bp[i] + k0), LDSP(unsigned, da + 16384 + i * 1024), 16, 0, 0);
    }
  };
  bf16x8 a0[4], b0[4], a1[4], b1[4];
  auto rd = [&](bf16x8 (&a)[4], bf16x8 (&b)[4], const char* sa, int ks) {
#pragma unroll
    for (int i = 0; i < 4; ++i) { a[i] = *(const bf16x8*)(sa + ((offA + i * 2048) ^ (ks << 6))); b[i] = *(const bf16x8*)(sa + 16384 + ((offB + i * 2048) ^ (ks << 6))); }
  };
  auto mm = [&](const bf16x8 (&a)[4], const bf16x8 (&b)[4]) {
#pragma unroll
    for (int i = 0; i < 4; ++i)
#pragma unroll
      for (int j = 0; j < 4; ++j) acc[i][j] = mfma16(a[i], b[j], acc[i][j]);
  };
  stage(0, 0);
  asm volatile("s_waitcnt vmcnt(0)" ::: "memory");
  __syncthreads();
  if (nk > 1) stage(1, 1);
  rd(a0, b0, smem, 0);
  for (int kt = 0; kt < nk; ++kt) {
    const char* sa = smem + (kt & 1) * 32768;
    rd(a1, b1, sa, 1);
    __builtin_amdgcn_sched_barrier(0);
    mm(a0, b0);
    __builtin_amdgcn_sched_barrier(0);
    asm volatile("s_waitcnt vmcnt(0)" ::: "memory");
    __syncthreads();
    if (kt + 2 < nk) stage(kt + 2, kt & 1);
    if (kt + 1 < nk) rd(a0, b0, smem + ((kt + 1) & 1) * 32768, 0);
    __builtin_amdgcn_sched_barrier(0);
    mm(a1, b1);
    __builtin_amdgcn_sched_barrier(0);
  }
  epi(acc, m0 + wr * 64, n0 + wc * 64, lane);
}

DI void store_plain(bf16_t* dst, int ld, const f32x4 (&acc)[4][4], int row0, int col0, int lane, float sc) {
#pragma unroll
  for (int mi = 0; mi < 4; ++mi)
#pragma unroll
    for (int r = 0; r < 4; ++r) { const int row = row0 + mi * 16 + (lane >> 4) * 4 + r;
#pragma unroll
      for (int ni = 0; ni < 4; ++ni) dst[(size_t)row * ld + col0 + ni * 16 + (lane & 15)] = f2bf(acc[mi][ni][r] * sc); }
}

struct EpiSwiGLU { bf16_t* H;
  DI void operator()(const f32x4 (&acc)[4][4], int row0, int col0, int lane) const {
#pragma unroll
    for (int mi = 0; mi < 4; ++mi)
#pragma unroll
      for (int r = 0; r < 4; ++r) { const int row = row0 + mi * 16 + (lane >> 4) * 4 + r;
#pragma unroll
        for (int pr = 0; pr < 2; ++pr) { const float gt = acc[mi][2 * pr][r], up = acc[mi][2 * pr + 1][r];
          H[(size_t)row * F_ + ((col0 >> 5) + pr) * 16 + (lane & 15)] = f2bf(silu(gt) * up); } }
  } };
struct EpiResid { const float* xin; float* y; float scale;
  DI void operator()(const f32x4 (&acc)[4][4], int row0, int col0, int lane) const {
#pragma unroll
    for (int mi = 0; mi < 4; ++mi)
#pragma unroll
      for (int r = 0; r < 4; ++r) { const int row = row0 + mi * 16 + (lane >> 4) * 4 + r;
#pragma unroll
        for (int ni = 0; ni < 4; ++ni) { const size_t ix = (size_t)row * D_ + col0 + ni * 16 + (lane & 15); y[ix] = ALPHA * xin[ix] + scale * acc[mi][ni][r]; } }
  } };
struct EpiProj { bf16_t* proj; bf16_t* ka; const float* c64; const float* s64; const float* c32; const float* s32;
  DI void operator()(const f32x4 (&acc)[4][4], int row0, int col0, int lane) const {
    const bool rope = (col0 >= C_DQ && col0 < C_DV) || (col0 >= C_NQR && col0 < C_KC) || (col0 >= C_KSL && col0 < C_VSL) || (col0 >= C_KW && col0 < C_VW);
    if (rope) {
#pragma unroll
      for (int mi = 0; mi < 4; ++mi)
#pragma unroll
        for (int r = 0; r < 4; ++r) { const int row = row0 + mi * 16 + (lane >> 4) * 4 + r, pos = row & (S_ - 1);
#pragma unroll
          for (int ni = 0; ni < 2; ++ni) { const int i = ni * 16 + (lane & 15); const float c = c64[pos * 32 + i], s = s64[pos * 32 + i];
            const float x1 = acc[mi][ni][r], x2 = acc[mi][ni + 2][r];
            proj[(size_t)row * PW + col0 + i] = f2bf(x1 * c - x2 * s); proj[(size_t)row * PW + col0 + 32 + i] = f2bf(x1 * s + x2 * c); } }
    } else if (col0 == C_KPE) {
#pragma unroll
      for (int mi = 0; mi < 4; ++mi)
#pragma unroll
        for (int r = 0; r < 4; ++r) { const int row = row0 + mi * 16 + (lane >> 4) * 4 + r, pos = row & (S_ - 1); const int i = lane & 15;
          const float c = c32[pos * 16 + i], s = s32[pos * 16 + i]; const float x1 = acc[mi][0][r], x2 = acc[mi][1][r];
          const bf16_t o1 = f2bf(x1 * c - x2 * s), o2 = f2bf(x1 * s + x2 * c);
#pragma unroll
          for (int h = 0; h < 4; ++h) { ka[(size_t)row * 384 + h * 96 + 64 + i] = o1; ka[(size_t)row * 384 + h * 96 + 80 + i] = o2; }
#pragma unroll
          for (int ni = 2; ni < 4; ++ni) { const float v = acc[mi][ni][r]; proj[(size_t)row * PW + col0 + ni * 16 + i] = f2bf(1.f / (1.f + __expf(-v))); } }
    } else store_plain(proj, PW, acc, row0, col0, lane, 1.f);
  } };
struct EpiMLAq { bf16_t* qa; const float* rs; int m0; const float* c32; const float* s32;
  DI void operator()(const f32x4 (&acc)[4][4], int row0, int col0, int lane) const {
#pragma unroll
    for (int mi = 0; mi < 4; ++mi)
#pragma unroll
      for (int r = 0; r < 4; ++r) { const int row = row0 + mi * 16 + (lane >> 4) * 4 + r, pos = row & (S_ - 1); const float sc = rs[row - m0]; const int i = lane & 15;
#pragma unroll
        for (int ch = 0; ch < 2; ++ch) { const int gc = col0 + 32 * ch; const float x1 = acc[mi][2 * ch][r] * sc, x2 = acc[mi][2 * ch + 1][r] * sc;
          if (((gc >> 5) % 3) == 2) { const float c = c32[pos * 16 + i], s = s32[pos * 16 + i];
            qa[(size_t)row * 384 + gc + i] = f2bf(x1 * c - x2 * s); qa[(size_t)row * 384 + gc + 16 + i] = f2bf(x1 * s + x2 * c); }
          else { qa[(size_t)row * 384 + gc + i] = f2bf(x1); qa[(size_t)row * 384 + gc + 16 + i] = f2bf(x2); } } }
  } };
struct EpiMLAkv { bf16_t* ka; bf16_t* va; const float* rs; int m0;
  DI void operator()(const f32x4 (&acc)[4][4], int row0, int col0, int lane) const {
    const int h = col0 >> 7, part = (col0 >> 6) & 1;
#pragma unroll
    for (int mi = 0; mi < 4; ++mi)
#pragma unroll
      for (int r = 0; r < 4; ++r) { const int row = row0 + mi * 16 + (lane >> 4) * 4 + r; const float sc = rs[row - m0];
#pragma unroll
        for (int ni = 0; ni < 4; ++ni) { const int j = ni * 16 + (lane & 15); const bf16_t v = f2bf(acc[mi][ni][r] * sc);
          if (part == 0) ka[(size_t)row * 384 + h * 96 + j] = v; else va[(size_t)row * 256 + h * 64 + j] = v; } }
  } };
struct EpiCmp1 { bf16_t* hid; const float* bias;
  DI void operator()(const f32x4 (&acc)[4][4], int row0, int col0, int lane) const {
#pragma unroll
    for (int mi = 0; mi < 4; ++mi)
#pragma unroll
      for (int r = 0; r < 4; ++r) { const int row = row0 + mi * 16 + (lane >> 4) * 4 + r;
#pragma unroll
        for (int ni = 0; ni < 4; ++ni) { const int col = col0 + ni * 16 + (lane & 15); hid[(size_t)row * 256 + col] = f2bf(silu(acc[mi][ni][r] + bias[col])); } }
  } };
struct EpiCmp2 { bf16_t* kc;
  DI void operator()(const f32x4 (&acc)[4][4], int row0, int col0, int lane) const {
    if (col0 >= 64) return;
#pragma unroll
    for (int mi = 0; mi < 4; ++mi)
#pragma unroll
      for (int r = 0; r < 4; ++r) { const int row = row0 + mi * 16 + (lane >> 4) * 4 + r;
        if (row < 2044) {
#pragma unroll
          for (int ni = 0; ni < 4; ++ni) kc[(size_t)row * 64 + col0 + ni * 16 + (lane & 15)] = f2bf(acc[mi][ni][r]); } }
  } };

template <int DQ, int MODE, class OUT>
DI void attn_core(const int tid, const bf16_t* __restrict__ Qb, long qs, const bf16_t* __restrict__ Kb, long kst, const bf16_t* __restrict__ Vb, long vst,
                  int q0, int k0, int kmax, int ntiles, const int* tlist, float sl2, int window,
                  const unsigned* selw, float* impg, bool first_head, float (&m_io)[2], float (&l_io)[2], const OUT out, char* smem) {
  constexpr int NKD = DQ / 32, CPR = DQ / 8, KST = (DQ == 64) ? 128 : 256;
  const int lane = tid & 63, wave = tid >> 6, g = lane >> 4, li = lane & 15;
  bf16x8 qf[2][NKD];
#pragma unroll
  for (int qt = 0; qt < 2; ++qt)
#pragma unroll
    for (int kd = 0; kd < NKD; ++kd) qf[qt][kd] = *(const bf16x8*)(Qb + (long)(q0 + wave * 32 + qt * 16 + li) * qs + kd * 32 + g * 8);
  int qidx[2]; qidx[0] = q0 + wave * 32 + li; qidx[1] = qidx[0] + 16;
  f32x4 o[4][2];
#pragma unroll
  for (int i = 0; i < 4; ++i) { o[i][0] = (f32x4){0.f, 0.f, 0.f, 0.f}; o[i][1] = (f32x4){0.f, 0.f, 0.f, 0.f}; }
  float mrun[2], lrun[2], invl[2], prev3[2];
#pragma unroll
  for (int qt = 0; qt < 2; ++qt) { prev3[qt] = 0.f;
    if (MODE == 3) { mrun[qt] = m_io[qt]; lrun[qt] = 0.f; invl[qt] = l_io[qt] > 0.f ? 1.f / l_io[qt] : 0.f; } else { mrun[qt] = -1e30f; lrun[qt] = 0.f; invl[qt] = 0.f; } }
  constexpr int RPP = 1024 / KST, NKP = 64 / RPP / 4;
  auto stage = [&](int jt, int buf) {
    const int kb = k0 + jt * 64; char* kbuf = smem + buf * 16384; char* vbuf = smem + 32768 + buf * 8192;
#pragma unroll
    for (int i = 0; i < NKP; ++i) { const int pc = wave * NKP + i; const int row = pc * RPP + (DQ == 64 ? (lane >> 3) : (lane >> 4));
      int c = (DQ == 64) ? ((lane & 7) ^ (row & 7)) : ((lane & 15) ^ (row & 7)); if (DQ != 64 && c >= CPR) c = 0;
      int ix = kb + row; ix = ix < 0 ? 0 : (ix > kmax ? kmax : ix);
      __builtin_amdgcn_global_load_lds((const unsigned*)(Kb + (long)ix * kst + c * 8), LDSP(unsigned, kbuf + pc * 1024), 16, 0, 0); }
    if (MODE != 2) {
#pragma unroll
      for (int i = 0; i < 2; ++i) { const int pc = wave * 2 + i; const int row = pc * 8 + (lane >> 3); const int pp = lane & 7;
        const int c = ((((pp >> 1) ^ ((row >> 1) & 3)) << 1) | (pp & 1));
        int ix = kb + row; ix = ix < 0 ? 0 : (ix > kmax ? kmax : ix);
        __builtin_amdgcn_global_load_lds((const unsigned*)(Vb + (long)ix * vst + c * 8), LDSP(unsigned, vbuf + pc * 1024), 16, 0, 0); }
    }
  };
  if (ntiles > 0) stage(tlist ? tlist[0] : 0, 0);
  asm volatile("s_waitcnt vmcnt(0)" ::: "memory");
  __syncthreads();
  for (int it = 0; it < ntiles; ++it) {
    const int jt = tlist ? tlist[it] : it;
    const bool more = it + 1 < ntiles;
    if (more) stage(tlist ? tlist[it + 1] : it + 1, (it + 1) & 1);
    const char* kbuf = smem + (it & 1) * 16384; const char* vbuf = smem + 32768 + (it & 1) * 8192;
    f32x4 st[4][2];
#pragma unroll
    for (int kt4 = 0; kt4 < 4; ++kt4) {
      bf16x8 kf[NKD]; const int row = kt4 * 16 + li;
#pragma unroll
      for (int kd = 0; kd < NKD; ++kd) kf[kd] = *(const bf16x8*)(kbuf + row * KST + (((kd * 4 + g) ^ (row & 7)) << 4));
#pragma unroll
      for (int qt = 0; qt < 2; ++qt) { f32x4 a = (f32x4){0.f, 0.f, 0.f, 0.f};
#pragma unroll
        for (int kd = 0; kd < NKD; ++kd) a = mfma16(kf[kd], qf[qt][kd], a);
        st[kt4][qt] = a; }
    }
    const int kbase = k0 + jt * 64;
    bool sb[2] = {true, true};
    if (MODE == 4) { sb[0] = (selw[(wave * 32 + li) * 4 + (jt >> 5)] >> (jt & 31)) & 1u; sb[1] = (selw[(wave * 32 + 16 + li) * 4 + (jt >> 5)] >> (jt & 31)) & 1u; }
    float alpha[2];
#pragma unroll
    for (int qt = 0; qt < 2; ++qt) {
      float mx = -1e30f;
#pragma unroll
      for (int kt4 = 0; kt4 < 4; ++kt4)
#pragma unroll
        for (int r = 0; r < 4; ++r) { const int kidx = kbase + kt4 * 16 + g * 4 + r; bool v;
          if (MODE == 0) v = kidx <= qidx[qt];
          else if (MODE == 1) v = (kidx >= 0) && (kidx <= qidx[qt]) && (qidx[qt] - kidx <= window);
          else if (MODE == 2 || MODE == 3) v = (kidx <= kmax) && (16 * kidx + 31 <= qidx[qt]);
          else v = (kidx <= qidx[qt]) && sb[qt];
          const float s = v ? st[kt4][qt][r] * sl2 : -1e30f; st[kt4][qt][r] = s; mx = fmaxf(mx, s); }
      if (MODE != 3) {
        mx = fmaxf(mx, __shfl_xor(mx, 16)); mx = fmaxf(mx, __shfl_xor(mx, 32));
        const float mn = fmaxf(mrun[qt], mx); alpha[qt] = fast_exp2(mrun[qt] - mn); mrun[qt] = mn;
      } else alpha[qt] = 1.f;
      float ls = 0.f;
#pragma unroll
      for (int kt4 = 0; kt4 < 4; ++kt4)
#pragma unroll
        for (int r = 0; r < 4; ++r) { const float s = st[kt4][qt][r]; float p = (s > -5e29f) ? fast_exp2(s - mrun[qt]) : 0.f; if (MODE == 3) p *= invl[qt]; st[kt4][qt][r] = p; ls += p; }
      lrun[qt] = lrun[qt] * alpha[qt] + ls;
    }
    if (MODE == 3) {
#pragma unroll
      for (int qt = 0; qt < 2; ++qt)
#pragma unroll
        for (int kt4 = 0; kt4 < 4; ++kt4) { const float p3 = st[kt4][qt][3]; const float a = (st[kt4][qt][0] + st[kt4][qt][1]) + (st[kt4][qt][2] + p3);
          const float give = (g == 3) ? prev3[qt] : p3; const float up = __shfl(give, (lane + 48) & 63); prev3[qt] = p3;
          float* ip = impg + (size_t)(wave * 32 + qt * 16 + li) * 128 + jt * 16 + kt4 * 4 + g; const float val = a + up;
          if (first_head) *ip = val; else *ip += val; }
    }
    if (MODE != 2) {
      if (MODE != 3) {
#pragma unroll
        for (int dt = 0; dt < 4; ++dt) { o[dt][0] *= alpha[0]; o[dt][1] *= alpha[1]; }
      }
#pragma unroll
      for (int ks2 = 0; ks2 < 2; ++ks2) {
        bf16x8 pf[2];
#pragma unroll
        for (int qt = 0; qt < 2; ++qt) { u32x4 w; w[0] = pk2(st[2 * ks2][qt][0], st[2 * ks2][qt][1]); w[1] = pk2(st[2 * ks2][qt][2], st[2 * ks2][qt][3]);
          w[2] = pk2(st[2 * ks2 + 1][qt][0], st[2 * ks2 + 1][qt][1]); w[3] = pk2(st[2 * ks2 + 1][qt][2], st[2 * ks2 + 1][qt][3]); pf[qt] = __builtin_bit_cast(bf16x8, w); }
        const int rowA = 32 * ks2 + 4 * g + (li >> 2), p_ = li & 3;
#pragma unroll
        for (int dt = 0; dt < 4; ++dt) {
          const int off = rowA * 128 + ((((dt ^ ((rowA >> 1) & 3)) << 1) | (p_ >> 1)) << 4) + 8 * (p_ & 1);
          const s16x4 lo = __builtin_amdgcn_ds_read_tr16_b64_v4i16(LDSP(s16x4, vbuf + off));
          const s16x4 hi = __builtin_amdgcn_ds_read_tr16_b64_v4i16(LDSP(s16x4, vbuf + off + 2048));
          const bf16x8 vf = __builtin_shufflevector(lo, hi, 0, 1, 2, 3, 4, 5, 6, 7);
          o[dt][0] = mfma16(vf, pf[0], o[dt][0]); o[dt][1] = mfma16(vf, pf[1], o[dt][1]);
        }
      }
    }
    asm volatile("s_waitcnt vmcnt(0)" ::: "memory");
    __syncthreads();
  }
#pragma unroll
  for (int qt = 0; qt < 2; ++qt) {
    float lt = lrun[qt]; lt += __shfl_xor(lt, 16); lt += __shfl_xor(lt, 32);
    if (MODE == 2) { m_io[qt] = mrun[qt]; l_io[qt] = lt; }
    else {
      const float inv = (MODE == 3) ? 1.f : (lt > 0.f ? 1.f / lt : 0.f);
#pragma unroll
      for (int dt = 0; dt < 4; ++dt) out(wave * 32 + qt * 16 + li, dt * 16 + g * 4, o[dt][qt] * inv, mrun[qt], lt);
    }
  }
}

struct OutSet { bf16_t* dst; long ld; const bf16_t* gate; long gld; float* lse; long lld;
  DI void operator()(int ql, int d0, f32x4 v, float m, float l) const {
    float gs = 1.f; if (gate) gs = bf2f(gate[ql * gld]);
    u32x2 w; w[0] = pk2(v[0] * gs, v[1] * gs); w[1] = pk2(v[2] * gs, v[3] * gs); *(u32x2*)(dst + ql * ld + d0) = w;
    if (lse && d0 == 0) lse[ql * lld] = (m + __log2f(l)) * 0.69314718056f;
  } };
struct OutAdd { bf16_t* dst; long ld; const bf16_t* gate; long gld;
  DI void operator()(int ql, int d0, f32x4 v, float m, float l) const {
    const float gs = bf2f(gate[ql * gld]); u32x2* p = (u32x2*)(dst + ql * ld + d0); const u32x2 old = *p;
    u32x2 w; w[0] = pk2(__uint_as_float(old[0] << 16) + v[0] * gs, __uint_as_float(old[0] & 0xffff0000u) + v[1] * gs);
    w[1] = pk2(__uint_as_float(old[1] << 16) + v[2] * gs, __uint_as_float(old[1] & 0xffff0000u) + v[3] * gs); *p = w;
  } };

DI bf16_t* lw(char* ws, int l, size_t off) { return (bf16_t*)(ws + OFF_W + (size_t)l * LW_SIZE + off); }

DI int colmap(int map, int n, int nsrc) {
  if (map == 0) return n < nsrc ? n : -1;
  if (map == 1) { const int t = n >> 5, i = n & 31; return i < 16 ? 16 * t + i : 2816 + 16 * t + (i - 16); }
  if (n < 384) return n;
  if (n < C_DV + 384) return 416 + (n - C_DQ);
  if (n < C_NQR) return 1568 + (n - C_NQ);
  if (n < C_KC) return 1568 + (n - C_NQR);
  if (n < C_KPE) return 1952 + (n - C_KC);
  if (n < C_GL) return 384 + (n - C_KPE);
  if (n < C_GL + 18) return 2720 + (n - C_GL);
  return -1;
}

DI void convert_wtile(const Params& P, const int tid, int t, char* smem) {
      int di = 0;
#pragma unroll 1
      for (int i = 1; i < 24; ++i) if (t >= P.wd[i].tile0) di = i;
      const WDesc d = P.wd[di]; const int lt = t - d.tile0, tn = lt % d.ntn, tk = lt / d.ntn, n0 = tn * 64, k0 = tk * 128;
      float* tile = (float*)smem;
      const int nn = tid & 63; const int sc = colmap(d.map, n0 + nn, d.Nsrc);
      float v[32];
#pragma unroll
      for (int i = 0; i < 32; ++i) { const int kk = (tid >> 6) + 4 * i; v[i] = (sc >= 0) ? d.src[(size_t)(k0 + kk) * d.Nsrc + sc] : 0.f; }
      if (d.kscale) {
#pragma unroll
        for (int i = 0; i < 32; ++i) v[i] *= d.kscale[k0 + (tid >> 6) + 4 * i];
      }
#pragma unroll
      for (int i = 0; i < 32; ++i) tile[((tid >> 6) + 4 * i) * 65 + nn] = v[i];
      __syncthreads();
      { const int on = tid >> 2, kq = tid & 3;
        bf16_t* dp = d.dst + (size_t)(n0 + on) * d.K + k0 + kq * 32;
#pragma unroll
        for (int c = 0; c < 4; ++c) { u32x4 w;
#pragma unroll
          for (int j = 0; j < 4; ++j) w[j] = pk2(tile[(kq * 32 + c * 8 + 2 * j) * 65 + on], tile[(kq * 32 + c * 8 + 2 * j + 1) * 65 + on]);
          *(u32x4*)(dp + c * 8) = w; } }
      __syncthreads();
}

DI void phase_prologue(const Params& P, const Ctx& p, char* smem) {
  const int tid = p.tid;
  const int n_w = P.n_early, n_cb = 4, n_r64 = 256, n_r32 = 128, n_xb = 1024;
  const int total = n_w + n_cb + n_r64 + n_r32 + n_xb;
  for (int t = blockIdx.x; t < total; t += gridDim.x) {
    if (t < n_w) { convert_wtile(P, tid, t, smem);
    } else if (t < n_w + n_cb) {
      const int id = t - n_w; const float* pos = p.cmp_pos + (size_t)id * 2048; const float* w1 = p.cmp_w1 + (size_t)id * 2048 * 256; float a = 0.f;
      for (int k = 0; k < 2048; ++k) a += pos[k] * w1[(size_t)k * 256 + tid];
      ((float*)(p.ws + OFF_CBIAS))[id * 256 + tid] = a;
    } else if (t < n_w + n_cb + n_r64) {
      const int e0 = (t - n_w - n_cb) * 1024; float* C = (float*)(p.ws + OFF_C64); float* Sn = (float*)(p.ws + OFF_S64);
      for (int e = e0 + tid; e < e0 + 1024; e += 256) { const int pos = e >> 5, i = e & 31; const float inv = exp2f(-(float)(2 * i) / 64.f * 13.287712379549449f); const float ang = (float)pos * inv;
        sincos_rr(ang, C[e], Sn[e]); }
    } else if (t < n_w + n_cb + n_r64 + n_r32) {
      const int e0 = (t - n_w - n_cb - n_r64) * 1024; float* C = (float*)(p.ws + OFF_C32); float* Sn = (float*)(p.ws + OFF_S32);
      for (int e = e0 + tid; e < e0 + 1024; e += 256) { const int pos = e >> 4, i = e & 15; const float inv = exp2f(-(float)(2 * i) / 32.f * 13.287712379549449f); const float ang = (float)pos * inv;
        sincos_rr(ang, C[e], Sn[e]); }
    } else {
      const size_t e0 = (size_t)(t - n_w - n_cb - n_r64 - n_r32) * 16384 + tid * 8; bf16_t* xb = (bf16_t*)(p.ws + OFF_XB);
      f32x4 a[8], b[8];
#pragma unroll
      for (int i = 0; i < 8; ++i) { a[i] = *(const f32x4*)(p.x + e0 + i * 2048); b[i] = *(const f32x4*)(p.x + e0 + i * 2048 + 4); }
#pragma unroll
      for (int i = 0; i < 8; ++i) { u32x4 w; w[0] = pk2(a[i][0], a[i][1]); w[1] = pk2(a[i][2], a[i][3]); w[2] = pk2(b[i][0], b[i][1]); w[3] = pk2(b[i][2], b[i][3]);
        *(u32x4*)(xb + e0 + i * 2048) = w; }
    }
  }
}

DI bool tile_seq(int k, int NT, int total, int& mt, int& nt) {
  const int G = gridDim.x, b = blockIdx.x; const int s = k * G + (b & 7) * (G >> 3) + (b >> 3);
  if (s >= total) return false;
  const int band = s / (16 * NT), r = s - band * 16 * NT; nt = r >> 4; mt = band * 16 + (r & 15); return true;
}
DI void phase_ffn_up(const Ctx& p, int l, int j, char* smem) {
  const ALin al{(const bf16_t*)(p.ws + OFF_XB), D_, T_}; const bf16_t* Bt = lw(p.ws, l, LW_FIN + j * SZ_FIN); const EpiSwiGLU epi{(bf16_t*)(p.ws + OFF_BIG)};
  for (int k = 0;; ++k) { int mt, nt; if (!tile_seq(k, 44, 128 * 44, mt, nt)) break; gemm_tile(p.tid, al, Bt, D_, 5632, D_, mt * 128, nt * 128, epi, smem); }
}
DI void phase_ffn_down(const Ctx& p, int l, int j, char* smem) {
  const ALin al{(const bf16_t*)(p.ws + OFF_BIG), F_, T_}; const bf16_t* Bt = lw(p.ws, l, LW_FOUT + j * SZ_FOUT);
  const EpiResid epi{(l == 0 && j == 0) ? p.x : p.out, p.out, 0.5f};
  for (int k = 0;; ++k) { int mt, nt; if (!tile_seq(k, 8, 128 * 8, mt, nt)) break; gemm_tile(p.tid, al, Bt, F_, D_, F_, mt * 128, nt * 128, epi, smem); }
}
DI void phase_wout(const Ctx& p, int l, char* smem) {
  const ALin al{(const bf16_t*)(p.ws + OFF_XB), D_, T_}; const bf16_t* Bt = lw(p.ws, l, LW_WOUT); const EpiResid epi{p.out, p.out, 1.0f};
  for (int k = 0;; ++k) { int mt, nt; if (!tile_seq(k, 8, 128 * 8, mt, nt)) break; gemm_tile(p.tid, al, Bt, D_, D_, D_, mt * 128, nt * 128, epi, smem); }
}
DI void phase_ln(const Ctx& p, int l, int j, bool zero_o) {
  const int lane = p.tid & 63, wave = p.tid >> 6; const float* gp = p.ln_g + (size_t)(l * 3 + j) * D_; const float* bp = p.ln_b + (size_t)(l * 3 + j) * D_;
  bf16_t* xb = (bf16_t*)(p.ws + OFF_XB);
  for (int t = blockIdx.x; t < T_ / 8; t += gridDim.x) {
    const int row = t * 8 + wave * 2; float* yr = p.out + (size_t)row * D_; f32x4 v[2][4]; float s[2] = {0.f, 0.f};
#pragma unroll
    for (int r = 0; r < 2; ++r)
#pragma unroll
      for (int i = 0; i < 4; ++i) v[r][i] = *(const f32x4*)(yr + r * D_ + i * 256 + lane * 4);
#pragma unroll
    for (int r = 0; r < 2; ++r) {
#pragma unroll
      for (int i = 0; i < 4; ++i) s[r] += (v[r][i][0] + v[r][i][1]) + (v[r][i][2] + v[r][i][3]);
#pragma unroll
      for (int o = 1; o < 64; o <<= 1) s[r] += __shfl_xor(s[r], o);
    }
#pragma unroll
    for (int r = 0; r < 2; ++r) {
      const float mu = s[r] * (1.f / D_); float q = 0.f;
#pragma unroll
      for (int i = 0; i < 4; ++i)
#pragma unroll
        for (int e = 0; e < 4; ++e) { const float d = v[r][i][e] - mu; q += d * d; }
#pragma unroll
      for (int o = 1; o < 64; o <<= 1) q += __shfl_xor(q, o);
      const float rstd = rsqrtf(q * (1.f / D_) + 1e-5f);
#pragma unroll
      for (int i = 0; i < 4; ++i) { const int c = i * 256 + lane * 4; const f32x4 gg = *(const f32x4*)(gp + c), bb = *(const f32x4*)(bp + c); f32x4 o4;
#pragma unroll
        for (int e = 0; e < 4; ++e) o4[e] = (v[r][i][e] - mu) * rstd * gg[e] + bb[e];
        *(f32x4*)(yr + r * D_ + c) = o4; u32x2 w; w[0] = pk2(o4[0], o4[1]); w[1] = pk2(o4[2], o4[3]); *(u32x2*)(xb + (size_t)(row + r) * D_ + c) = w; }
    }
  }
}
DI void phase_win(const Ctx& p, int l, char* smem) {
  const ALin al{(const bf16_t*)(p.ws + OFF_XB), D_, T_}; const bf16_t* Bt = lw(p.ws, l, LW_WIN);
  const EpiProj epi{(bf16_t*)(p.ws + OFF_BIG), (bf16_t*)(p.ws + OFF_KA), (const float*)(p.ws + OFF_C64), (const float*)(p.ws + OFF_S64), (const float*)(p.ws + OFF_C32), (const float*)(p.ws + OFF_S32)};
  for (int k = 0;; ++k) { int mt, nt; if (!tile_seq(k, 25, 128 * 25, mt, nt)) break; gemm_tile(p.tid, al, Bt, D_, PW, D_, mt * 128, nt * 128, epi, smem); }
}

DI int next_item(const int tid, unsigned* ctr, char* smem) {
  int* slot = (int*)(smem + 69632 - 16);
  __syncthreads();
  if (tid == 0) *slot = (int)atomicAdd(ctr, 1u);
  __syncthreads();
  return *slot;
}

DI void item_dilated(const Ctx& p, int id, char* smem) {
  const int pat = id / 768, r1 = id % 768, b = r1 / 384, r2 = r1 % 384, h = r2 >> 6, blk = r2 & 63;
  const int dil = pat == 0 ? 1 : (pat == 1 ? 4 : 16), nsub = 64 / dil, rho = blk / nsub, i = blk % nsub;
  const bf16_t* proj = (const bf16_t*)(p.ws + OFF_BIG); const bf16_t* base = proj + (size_t)(b * S_ + rho) * PW; const long rs = (long)dil * PW;
  bf16_t* dst = (bf16_t*)(p.ws + OFF_DILO) + ((size_t)pat * T_ + b * S_ + rho + (size_t)dil * 128 * i) * 384 + h * 64;
  float* lse = (float*)(p.ws + OFF_DILL) + ((size_t)pat * T_ + b * S_ + rho + (size_t)dil * 128 * i) * 6 + h;
  const OutSet out{dst, (long)dil * 384, nullptr, 0, lse, (long)dil * 6}; float mm[2], ll[2];
  attn_core<64, 1>(p.tid, base + C_DQ + h * 64, rs, base + C_DK + h * 64, rs, base + C_DV + h * 64, rs, 128 * i, 128 * i - 128, S_ / dil - 1, 4, nullptr,
                   0.125f * 1.44269504089f, 128, nullptr, nullptr, false, mm, ll, out, smem);
}
DI void item_nsawin(const Ctx& p, int id, char* smem) {
  const int b = id / 384, r = id % 384, h = r >> 6, i = r & 63, g = h / 3;
  const bf16_t* proj = (const bf16_t*)(p.ws + OFF_BIG); const bf16_t* base = proj + (size_t)(b * S_) * PW;
  bf16_t* o = (bf16_t*)(p.ws + OFF_XB) + (size_t)(b * S_ + 128 * i) * D_ + 640 + h * 64;
  const OutSet out{o, D_, base + (size_t)(128 * i) * PW + C_GL + h * 3 + 2, PW, nullptr, 0}; float mm[2], ll[2];
  attn_core<64, 1>(p.tid, base + C_NQR + h * 64, PW, base + C_KW + g * 64, PW, base + C_VW + g * 64, PW, 128 * i, 128 * i - 512, S_ - 1, 10, nullptr,
                   0.125f * 1.44269504089f, 512, nullptr, nullptr, false, mm, ll, out, smem);
}
DI void item_expand(const Ctx& p, int l, int id, char* smem) {
  const bf16_t* proj = (const bf16_t*)(p.ws + OFF_BIG); float* rs = (float*)(smem + 65536);
  const bool isq = id < 384; const int lid = isq ? id : id - 384; const int mt = isq ? lid / 3 : lid >> 2, nt = isq ? lid % 3 : lid & 3;
  const int K = isq ? 256 : 128, cb = isq ? C_CQ : C_CKV, tid = p.tid;
  { const int row = tid >> 1, half = tid & 1; const bf16_t* rp = proj + (size_t)(mt * 128 + row) * PW + cb + half * (K / 2); float ss = 0.f;
    for (int c = 0; c < K / 2; c += 8) { const u32x4 w = *(const u32x4*)(rp + c);
#pragma unroll
      for (int e = 0; e < 4; ++e) { const float a = __uint_as_float(w[e] << 16), b2 = __uint_as_float(w[e] & 0xffff0000u); ss += a * a + b2 * b2; } }
    ss += __shfl_xor(ss, 1); if (half == 0) rs[row] = rsqrtf(ss / (float)K + 1e-6f); }
  __syncthreads();
  const ALin al{proj + cb, PW, T_};
  if (isq) { const EpiMLAq epi{(bf16_t*)(p.ws + OFF_QA), rs, mt * 128, (const float*)(p.ws + OFF_C32), (const float*)(p.ws + OFF_S32)};
    gemm_tile(p.tid, al, lw(p.ws, l, LW_UQ), 256, 384, 256, mt * 128, nt * 128, epi, smem); }
  else { const EpiMLAkv epi{(bf16_t*)(p.ws + OFF_KA), (bf16_t*)(p.ws + OFF_VA), rs, mt * 128};
    gemm_tile(p.tid, al, lw(p.ws, l, LW_UKV), 128, 512, 128, mt * 128, nt * 128, epi, smem); }
}
DI void item_cmp(const Ctx& p, int l, int id, char* smem) {
  const int kv = id >> 4, mt = id & 15; const ACmp al1{(const bf16_t*)(p.ws + OFF_BIG), kv ? C_VC : C_KC};
  bf16_t* hid = (bf16_t*)(p.ws + OFF_CHID) + (size_t)kv * 2048 * 256;
  const EpiCmp1 epi1{hid, (const float*)(p.ws + OFF_CBIAS) + (l * 2 + kv) * 256};
#pragma unroll 1
  for (int nt = 0; nt < 2; ++nt) gemm_tile(p.tid, al1, lw(p.ws, l, LW_C1 + kv * SZ_C1), 2048, 256, 2048, mt * 128, nt * 128, epi1, smem);
  asm volatile("s_waitcnt vmcnt(0)" ::: "memory");
  __syncthreads();
  const ALin al2{hid, 256, 2048}; const EpiCmp2 epi2{(bf16_t*)(p.ws + OFF_KCVC) + (size_t)kv * 2048 * 64};
  int t2 = p.tid; asm volatile("" : "+v"(t2));
  gemm_tile(t2, al2, lw(p.ws, l, LW_C2 + kv * SZ_C2), 256, 64, 256, mt * 128, 0, epi2, smem);
}
DI void item_mla(const Ctx& p, int id, char* smem) {
  const int i = 63 - (id >> 3), bh = id & 7, b = bh >> 2, h = bh & 3;
  const bf16_t* qa = (const bf16_t*)(p.ws + OFF_QA) + (size_t)(b * S_) * 384 + h * 96; const bf16_t* ka = (const bf16_t*)(p.ws + OFF_KA) + (size_t)(b * S_) * 384 + h * 96;
  const bf16_t* va = (const bf16_t*)(p.ws + OFF_VA) + (size_t)(b * S_) * 256 + h * 64;
  bf16_t* o = (bf16_t*)(p.ws + OFF_XB) + (size_t)(b * S_ + 128 * i) * D_ + h * 64; const OutSet out{o, D_, nullptr, 0, nullptr, 0}; float mm[2], ll[2];
  attn_core<96, 0>(p.tid, qa, 384, ka, 384, va, 256, 128 * i, 0, S_ - 1, 2 * (i + 1), nullptr, 0.10206207261f * 1.44269504089f, 0, nullptr, nullptr, false, mm, ll, out, smem);
}
DI void item_nsacmp(const Ctx& p, int id, char* smem) {
  const int i = 63 - (id >> 2), bg = id & 3, b = bg >> 1, g = bg & 1, tid = p.tid;
  const bf16_t* proj = (const bf16_t*)(p.ws + OFF_BIG); const bf16_t* base = proj + (size_t)(b * S_) * PW;
  const bf16_t* kc = (const bf16_t*)(p.ws + OFF_KCVC) + (size_t)((b * 2 + g) * NCMP) * 64; const bf16_t* vc = kc + (size_t)2048 * 64;
  float* imp = (float*)(p.ws + OFF_IMP) + ((size_t)((b * 2 + g) * S_) + 128 * i) * 128;
  const int nkt = (i + 8) >> 3;
#pragma unroll 1
  for (int hh = 0; hh < 3; ++hh) { const int h = g * 3 + hh; float mm[2], ll[2];
    bf16_t* o = (bf16_t*)(p.ws + OFF_XB) + (size_t)(b * S_ + 128 * i) * D_ + 640 + h * 64;
    const OutAdd out{o, D_, base + (size_t)(128 * i) * PW + C_GL + h * 3 + 0, PW};
    attn_core<64, 2>(p.tid, base + C_NQ + h * 64, PW, kc, 64, vc, 64, 128 * i, 0, NCMP - 1, nkt, nullptr, 0.125f * 1.44269504089f, 0, nullptr, nullptr, false, mm, ll, out, smem);
    attn_core<64, 3>(p.tid, base + C_NQ + h * 64, PW, kc, 64, vc, 64, 128 * i, 0, NCMP - 1, nkt, nullptr, 0.125f * 1.44269504089f, 0, nullptr, imp, hh == 0, mm, ll, out, smem);
  }
  __syncthreads();
  float* sc = (float*)smem;
  const int q = tid >> 1, half = tid & 1, qpos = 128 * i + q, cur = qpos >> 6;
#pragma unroll 2
  for (int j = half * 64; j < half * 64 + 64; ++j) { const float v = (j < nkt * 16) ? imp[(size_t)q * 128 + j] : 0.f; const bool forced = (j == 0) || (j == cur) || (j == cur - 1);
    sc[q * 129 + j] = forced ? 1e4f : (j <= cur ? v : -1e4f); }
  unsigned m0 = 0, m1 = 0, m2 = 0, m3 = 0;
#pragma unroll 1
  for (int rd = 0; rd < 16; ++rd) {
    float bv = -3e38f; int bj = half * 64;
#pragma unroll 4
    for (int j = half * 64; j < half * 64 + 64; ++j) { const float v = sc[q * 129 + j]; if (v > bv) { bv = v; bj = j; } }
    const float ov = __shfl_xor(bv, 1); const int oj = __shfl_xor(bj, 1);
    if (ov > bv || (ov == bv && oj < bj)) { bv = ov; bj = oj; }
    if ((bj >> 6) == half) sc[q * 129 + bj] = -3.2e38f;
    if (bj <= cur) { const unsigned bit = 1u << (bj & 31); const int w = bj >> 5; m0 |= (w == 0) ? bit : 0u; m1 |= (w == 1) ? bit : 0u; m2 |= (w == 2) ? bit : 0u; m3 |= (w == 3) ? bit : 0u; }
  }
  if (half == 0) { u32x4 w; w[0] = m0; w[1] = m1; w[2] = m2; w[3] = m3; *(u32x4*)((unsigned*)(p.ws + OFF_SEL) + ((size_t)(b * S_ + qpos) * 2 + g) * 4) = w; }
  __syncthreads();
}
DI void item_dilcombine(const Ctx& p, int id) {
  const size_t e = (size_t)id * 256 + p.tid; const int tok = (int)(e / 48), r = (int)(e % 48), h = r >> 3, d0 = (r & 7) * 8;
  const float* L = (const float*)(p.ws + OFF_DILL); const bf16_t* O = (const bf16_t*)(p.ws + OFF_DILO);
  const float l0 = L[(size_t)tok * 6 + h], l1 = L[((size_t)T_ + tok) * 6 + h], l2 = L[((size_t)2 * T_ + tok) * 6 + h]; const float mx = fmaxf(l0, fmaxf(l1, l2));
  float w0 = __expf(l0 - mx), w1 = __expf(l1 - mx), w2 = __expf(l2 - mx); const float inv = 1.f / (w0 + w1 + w2); w0 *= inv; w1 *= inv; w2 *= inv;
  const u32x4 a = *(const u32x4*)(O + (size_t)tok * 384 + h * 64 + d0), b = *(const u32x4*)(O + ((size_t)T_ + tok) * 384 + h * 64 + d0), c = *(const u32x4*)(O + ((size_t)2 * T_ + tok) * 384 + h * 64 + d0);
  u32x4 w;
#pragma unroll
  for (int k = 0; k < 4; ++k) { const float lo = w0 * __uint_as_float(a[k] << 16) + w1 * __uint_as_float(b[k] << 16) + w2 * __uint_as_float(c[k] << 16);
    const float hi = w0 * __uint_as_float(a[k] & 0xffff0000u) + w1 * __uint_as_float(b[k] & 0xffff0000u) + w2 * __uint_as_float(c[k] & 0xffff0000u); w[k] = pk2(lo, hi); }
  *(u32x4*)((bf16_t*)(p.ws + OFF_XB) + (size_t)tok * D_ + 256 + h * 64 + d0) = w;
}
DI void item_nsaslc(const Ctx& p, int id, char* smem) {
  const int i = 63 - id / 12, r = id % 12, b = r / 6, h = r % 6, g = h / 3, tid = p.tid;
  const bf16_t* proj = (const bf16_t*)(p.ws + OFF_BIG); const bf16_t* base = proj + (size_t)(b * S_) * PW;
  unsigned* selw = (unsigned*)(smem + 49152 + 2048); int* tlist = (int*)(smem + 49152); unsigned* un = (unsigned*)(smem + 49152 + 1024);
  __syncthreads();
  if (tid < 4) un[tid] = 0u;
  __syncthreads();
  if (tid < 128) { const u32x4 w = *(const u32x4*)((const unsigned*)(p.ws + OFF_SEL) + ((size_t)(b * S_ + 128 * i + tid) * 2 + g) * 4);
    selw[tid * 4 + 0] = w[0]; selw[tid * 4 + 1] = w[1]; selw[tid * 4 + 2] = w[2]; selw[tid * 4 + 3] = w[3];
    atomicOr(&un[0], w[0]); atomicOr(&un[1], w[1]); atomicOr(&un[2], w[2]); atomicOr(&un[3], w[3]); }
  __syncthreads();
  if (tid == 0) { int n = 0; for (int jt = 0; jt < 2 * (i + 1); ++jt) if ((un[jt >> 5] >> (jt & 31)) & 1u) tlist[n++] = jt; tlist[255] = n; }
  __syncthreads();
  const int nt = tlist[255];
  bf16_t* o = (bf16_t*)(p.ws + OFF_XB) + (size_t)(b * S_ + 128 * i) * D_ + 640 + h * 64;
  const OutAdd out{o, D_, base + (size_t)(128 * i) * PW + C_GL + h * 3 + 1, PW}; float mm[2], ll[2];
  attn_core<64, 4>(p.tid, base + C_NQR + h * 64, PW, base + C_KSL + g * 64, PW, base + C_VSL + g * 64, PW, 128 * i, 0, S_ - 1, nt, tlist, 0.125f * 1.44269504089f, 0, selw, nullptr, false, mm, ll, out, smem);
}

DI void phase_mix_a(const Params& P, const Ctx& p0, int l, char* smem, int ci, int f0, int f1) {
  unsigned* ctr = (unsigned*)(p0.ws + OFF_CTRL) + l * 8 + ci; const int total = 32 + 768 + 2304 + 896;
  for (;;) { Ctx q = p0; asm volatile("" : "+v"(q.tid)); asm volatile("" : "+v"(q.ws)); const Ctx& p = q; const int t = next_item(p.tid, ctr, smem);
    if (t >= total) { if (t - total < f1 - f0) { convert_wtile(P, p.tid, f0 + t - total, smem); continue; } break; }
    if (t < 32) item_cmp(p, l, t, smem); else if (t < 32 + 768) item_nsawin(p, t - 32, smem); else if (t < 32 + 768 + 2304) item_dilated(p, t - 32 - 768, smem);
    else item_expand(p, l, t - 32 - 768 - 2304, smem); }
}
DI void phase_mix_b(const Params& P, const Ctx& p0, int l, char* smem, int ci, int f0, int f1) {
  unsigned* ctr = (unsigned*)(p0.ws + OFF_CTRL) + l * 8 + ci; const int total = 512 + 256 + 3072;
  for (;;) { Ctx q = p0; asm volatile("" : "+v"(q.tid)); asm volatile("" : "+v"(q.ws)); const Ctx& p = q; const int t = next_item(p.tid, ctr, smem);
    if (t >= total) { if (t - total < f1 - f0) { convert_wtile(P, p.tid, f0 + t - total, smem); continue; } break; }
    if (t < 512) item_mla(p, t, smem);
    else if (t < 512 + 256) item_nsacmp(p, t - 512, smem); else item_dilcombine(p, t - 512 - 256); }
}
DI void phase_mix_d(const Params& P, const Ctx& p0, int l, char* smem, int f0, int f1) {
  unsigned* ctr = (unsigned*)(p0.ws + OFF_CTRL) + l * 8 + 3; const int total = 768;
  for (;;) { Ctx q = p0; asm volatile("" : "+v"(q.tid)); asm volatile("" : "+v"(q.ws)); const Ctx& p = q; const int t = next_item(p.tid, ctr, smem);
    if (t >= total) { if (t - total < f1 - f0) { convert_wtile(P, p.tid, f0 + t - total, smem); continue; } break; }
    item_nsaslc(p, t, smem); }
}
DI void phase_zero_o(const Ctx& p) {
  u32x4* o = (u32x4*)(p.ws + OFF_XB); const u32x4 z = (u32x4){0u, 0u, 0u, 0u};
  for (size_t e = (size_t)blockIdx.x * 256 + p.tid; e < (size_t)T_ * D_ / 8; e += (size_t)gridDim.x * 256) o[e] = z;
}

DI void run_phase(const Params& P, int ph, char* smem) {
  Ctx p; p.x = P.x; p.ln_g = P.ln_g; p.ln_b = P.ln_b; p.cmp_pos = P.cmp_pos; p.cmp_w1 = P.cmp_w1; p.out = P.out; p.ws = P.ws; p.tid = threadIdx.x;
  asm volatile("" : "+v"(p.tid));
  if (ph == 0) { phase_prologue(P, p, smem); return; }
  const int l = (ph - 1) / 12; int s = (ph - 1) % 12;
#ifdef ONLY_S
  if (s != ONLY_S) return;
  s = ONLY_S;
#endif
  switch (s) {
    case 0: phase_ffn_up(p, l, 0, smem); break;
    case 1: phase_ffn_down(p, l, 0, smem); break;
    case 2: phase_ln(p, l, 0, false); break;
#if ENABLE_MIX
    case 3: phase_win(p, l, smem); break;
    case 4: { const int nl = P.n_wtiles - P.n_early, a = P.n_early, b = a + (l == 0 ? nl / 3 : 0); phase_mix_a(P, p, l, smem, 0, a, b); } break;
    case 5: { const int nl = P.n_wtiles - P.n_early, a = P.n_early + nl / 3, b = a + (l == 0 ? nl / 3 : 0); phase_mix_b(P, p, l, smem, 1, a, b); } break;
    case 6: { const int nl = P.n_wtiles - P.n_early, a = P.n_early + 2 * (nl / 3), b = (l == 0 ? P.n_wtiles : a); phase_mix_d(P, p, l, smem, a, b); } break;
#else
    case 3: phase_zero_o(p); break;
    case 4: case 5: case 6: break;
#endif
    case 7: phase_wout(p, l, smem); break;
    case 8: phase_ln(p, l, 1, false); break;
    case 9: phase_ffn_up(p, l, 1, smem); break;
    case 10: phase_ffn_down(p, l, 1, smem); break;
    case 11: phase_ln(p, l, 2, false); break;
  }
}
constexpr int NPHASE = 25;

#if ONE_LAUNCH
DI unsigned xb_ld(unsigned* p) { return __hip_atomic_load(p, __ATOMIC_RELAXED, __HIP_MEMORY_SCOPE_AGENT); }
DI unsigned xb_add(unsigned* p, unsigned v) { return __hip_atomic_fetch_add(p, v, __ATOMIC_RELAXED, __HIP_MEMORY_SCOPE_AGENT); }
DI void xb_st(unsigned* p, unsigned v) { __hip_atomic_store(p, v, __ATOMIC_RELAXED, __HIP_MEMORY_SCOPE_AGENT); }
constexpr int XB_CNT = 256, XB_SUB = 256 + 64 * 16, XB_GEN = 256 + 64 * 32, XB_TOP = 256 + 64 * 48, XB_TOPGEN = 256 + 64 * 49, XB_WORDS = 256 + 64 * 50;
DI void grid_bar(const Params& P, unsigned idx, char* smem) {
  asm volatile("s_waitcnt vmcnt(0)" ::: "memory");
  __syncthreads();
  int t = threadIdx.x; asm volatile("" : "+v"(t));
  if (t == 0) {
    unsigned* bar = (unsigned*)(P.ws + OFF_CTRL);
    volatile unsigned* st = (volatile unsigned*)(smem + 69632 - 16);
    const unsigned x = st[1], nloc = st[2], nx = st[3];
    const unsigned old = xb_add(&bar[XB_SUB + 64 * x], 1u);
    if (old + 1u == idx * nloc) {
      __builtin_amdgcn_fence(__ATOMIC_RELEASE, "agent");
      asm volatile("s_waitcnt vmcnt(0)" ::: "memory");
      const unsigned og = xb_add(&bar[XB_TOP], 1u);
      if (og + 1u == idx * nx) xb_st(&bar[XB_TOPGEN], idx);
      else { while (xb_ld(&bar[XB_TOPGEN]) < idx) __builtin_amdgcn_s_sleep(1); }
      xb_st(&bar[XB_GEN + 64 * x], idx);
    } else { while (xb_ld(&bar[XB_GEN + 64 * x]) < idx) __builtin_amdgcn_s_sleep(1); }
    __builtin_amdgcn_fence(__ATOMIC_ACQUIRE, "agent");
    asm volatile("s_waitcnt vmcnt(0)" ::: "memory");
  }
  __syncthreads();
}
template <int PH> DI void run_all(const Params& p, char* smem) {
  run_phase(p, PH, smem);
  if constexpr (PH + 1 < NPHASE) { grid_bar(p, PH + 1, smem); run_all<PH + 1>(p, smem); }
}
__global__ void __launch_bounds__(256, 2) mega_kernel(Params p) {
  __shared__ __attribute__((aligned(16))) char smem[69632];
  {
    unsigned* bar = (unsigned*)(p.ws + OFF_CTRL); volatile unsigned* st = (volatile unsigned*)(smem + 69632 - 16);
    const unsigned x = (unsigned)__builtin_amdgcn_s_getreg((3 << 11) | 20) & 0xFu;
    if (threadIdx.x == 0) xb_add(&bar[XB_CNT + 64 * x], 1u);
    cg::this_grid().sync();
    if (threadIdx.x == 0) { unsigned nx = 0, mine = 1;
      for (unsigned j = 0; j < 16; ++j) { const unsigned c = xb_ld(&bar[XB_CNT + 64 * j]); nx += (c > 0u) ? 1u : 0u; if (j == x) mine = c; }
      st[1] = x; st[2] = mine; st[3] = nx; }
    __syncthreads();
  }
  run_all<0>(p, smem);
}
#define MAIN_KERNEL mega_kernel
#else
#define MAIN_KERNEL phase_kernel
#endif
__global__ void __launch_bounds__(256, 2) phase_kernel(Params p, int ph) {
  __shared__ __attribute__((aligned(16))) char smem[69632];
  run_phase(p, ph, smem);
}

extern "C" void kernel_launch(void* const* d_in, const int* in_sizes, int n_in, void* d_out, int out_size, void* d_ws, size_t ws_size, hipStream_t stream) {
  static int grid_blocks = 0;
  if (!grid_blocks) { int dev = 0, cus = 0, per_cu = 0; hipGetDevice(&dev); hipDeviceGetAttribute(&cus, hipDeviceAttributeMultiprocessorCount, dev);
    hipOccupancyMaxActiveBlocksPerMultiprocessor(&per_cu, MAIN_KERNEL, 256, 0); if (per_cu > 2) per_cu = 2; if (per_cu < 1) per_cu = 1; grid_blocks = cus * per_cu; }
  if (ws_size < OFF_END) { fprintf(stderr, "workspace too small: %zu < %zu\n", ws_size, (size_t)OFF_END); return; }
  Params p; memset(&p, 0, sizeof(p));
  const float* x = (const float*)d_in[0]; const float* ffn_in = (const float*)d_in[1]; const float* ffn_out = (const float*)d_in[2];
  const float* w_in = (const float*)d_in[5]; const float* w_out = (const float*)d_in[6]; const float* qn = (const float*)d_in[7]; const float* kvn = (const float*)d_in[8];
  const float* wuq = (const float*)d_in[9]; const float* wukv = (const float*)d_in[10]; const float* cw1 = (const float*)d_in[12]; const float* cw2 = (const float*)d_in[13];
  p.x = x; p.ln_g = (const float*)d_in[3]; p.ln_b = (const float*)d_in[4]; p.cmp_pos = (const float*)d_in[11]; p.cmp_w1 = cw1; p.out = (float*)d_out; p.ws = (char*)d_ws;
  int tile0 = 0, di = 0;
  auto add = [&](const float* src, size_t dst_off, const float* ksc, int K, int Nsrc, int Ndst, int map) {
    WDesc& d = p.wd[di++]; d.src = src; d.dst = (bf16_t*)((char*)d_ws + dst_off); d.kscale = ksc; d.K = K; d.Nsrc = Nsrc; d.Ndst = Ndst; d.map = map; d.tile0 = tile0; d.ntn = Ndst / 64;
    tile0 += (Ndst / 64) * (K / 128); };
  auto add_ffn_in = [&](int l, int j) { add(ffn_in + (size_t)(l * 2 + j) * 1024 * 5632, OFF_W + (size_t)l * LW_SIZE + LW_FIN + j * SZ_FIN, nullptr, 1024, 5632, 5632, 1); };
  auto add_ffn_out = [&](int l, int j) { add(ffn_out + (size_t)(l * 2 + j) * 2816 * 1024, OFF_W + (size_t)l * LW_SIZE + LW_FOUT + j * SZ_FOUT, nullptr, 2816, 1024, 1024, 0); };
  auto add_mix = [&](int l) { const size_t wb = OFF_W + (size_t)l * LW_SIZE;
    add(w_in + (size_t)l * 1024 * 2738, wb + LW_WIN, nullptr, 1024, 2738, PW, 2);
    add(wuq + (size_t)l * 256 * 384, wb + LW_UQ, qn + l * 256, 256, 384, 384, 0);
    add(wukv + (size_t)l * 128 * 512, wb + LW_UKV, kvn + l * 128, 128, 512, 512, 0);
    for (int kv = 0; kv < 2; ++kv) add(cw1 + (size_t)(l * 2 + kv) * 2048 * 256, wb + LW_C1 + kv * SZ_C1, nullptr, 2048, 256, 256, 0);
    for (int kv = 0; kv < 2; ++kv) add(cw2 + (size_t)(l * 2 + kv) * 256 * 64, wb + LW_C2 + kv * SZ_C2, nullptr, 256, 64, 64, 0); };
  auto add_wout = [&](int l) { add(w_out + (size_t)l * 1024 * 1024, OFF_W + (size_t)l * LW_SIZE + LW_WOUT, nullptr, 1024, 1024, 1024, 0); };
  add_ffn_in(0, 0); add_ffn_out(0, 0); add_mix(0);
  p.n_early = tile0;
  add_wout(0); add_ffn_in(0, 1); add_ffn_out(0, 1); add_ffn_in(1, 0); add_ffn_out(1, 0); add_mix(1); add_wout(1); add_ffn_in(1, 1); add_ffn_out(1, 1);
  p.n_wtiles = tile0;
  hipMemsetAsync((char*)d_ws + OFF_CTRL, 0, 16384, stream);
#if ONE_LAUNCH
  void* args[] = {&p};
  hipError_t e = hipLaunchCooperativeKernel((void*)mega_kernel, dim3(grid_blocks), dim3(256), args, 0, stream);
  if (e != hipSuccess) fprintf(stderr, "cooperative launch failed: %s (grid %d)\n", hipGetErrorString(e), grid_blocks);
#else
  for (int ph = 0; ph < NPHASE; ++ph) phase_kernel<<<dim3(grid_blocks), dim3(256), 0, stream>>>(p, ph);
#endif
}
```

```cpp
#include <hip/hip_runtime.h>
#include <hip/hip_cooperative_groups.h>
#include <cstdio>
#include <cstdint>
#include <cstring>
namespace cg = cooperative_groups;

typedef unsigned short bf16_t;
typedef short bf16x8 __attribute__((ext_vector_type(8)));
typedef short s16x4 __attribute__((ext_vector_type(4)));
typedef float f32x4 __attribute__((ext_vector_type(4)));
typedef unsigned u32x4 __attribute__((ext_vector_type(4)));
typedef unsigned u32x2 __attribute__((ext_vector_type(2)));
#define DI __device__ __forceinline__
#define LDSP(T, p) ((__attribute__((address_space(3))) T*)(p))

#ifndef ENABLE_MIX
#define ENABLE_MIX 1
#endif
#ifndef PROBE_REP
#define PROBE_REP 0
#endif
#ifndef ONE_LAUNCH
#define ONE_LAUNCH 1
#endif

constexpr int T_ = 16384, S_ = 8192, D_ = 1024, F_ = 2816, PW = 3200;
constexpr float ALPHA = 1.41421356237f;
constexpr int C_CQ = 0, C_CKV = 256, C_DQ = 384, C_DK = 768, C_DV = 1152, C_NQ = 1536, C_NQR = 1920, C_KC = 2304, C_VC = 2432,
              C_KSL = 2560, C_VSL = 2688, C_KW = 2816, C_VW = 2944, C_KPE = 3072, C_GL = 3104;
constexpr int NCMP = 511;

constexpr size_t SZ_FIN = 5632ull * 1024 * 2, SZ_FOUT = 1024ull * 2816 * 2, SZ_WIN = (size_t)PW * 1024 * 2, SZ_WOUT = 1024ull * 1024 * 2,
                 SZ_UQ = 384ull * 256 * 2, SZ_UKV = 512ull * 128 * 2, SZ_C1 = 256ull * 2048 * 2, SZ_C2 = 64ull * 256 * 2;
constexpr size_t LW_FIN = 0, LW_FOUT = LW_FIN + 2 * SZ_FIN, LW_WIN = LW_FOUT + 2 * SZ_FOUT, LW_WOUT = LW_WIN + SZ_WIN, LW_UQ = LW_WOUT + SZ_WOUT,
                 LW_UKV = LW_UQ + SZ_UQ, LW_C1 = LW_UKV + SZ_UKV, LW_C2 = LW_C1 + 2 * SZ_C1, LW_SIZE = LW_C2 + 2 * SZ_C2;
constexpr size_t OFF_CTRL = 0, OFF_C64 = 16384, OFF_S64 = OFF_C64 + 8192ull * 32 * 4, OFF_C32 = OFF_S64 + 8192ull * 32 * 4, OFF_S32 = OFF_C32 + 8192ull * 16 * 4,
                 OFF_CBIAS = OFF_S32 + 8192ull * 16 * 4, OFF_W = OFF_CBIAS + 4096, OFF_XB = OFF_W + 2 * LW_SIZE, OFF_BIG = OFF_XB + (size_t)T_ * D_ * 2,
                 OFF_QA = OFF_BIG + (size_t)T_ * PW * 2, OFF_KA = OFF_QA + (size_t)T_ * 384 * 2, OFF_VA = OFF_KA + (size_t)T_ * 384 * 2,
                 OFF_DILO = OFF_VA + (size_t)T_ * 256 * 2, OFF_DILL = OFF_DILO + 3ull * T_ * 384 * 2, OFF_CHID = OFF_DILL + 3ull * T_ * 6 * 4,
                 OFF_KCVC = OFF_CHID + 2ull * 2048 * 256 * 2, OFF_SEL = OFF_KCVC + 2ull * 2048 * 64 * 2, OFF_IMP = OFF_SEL + (size_t)T_ * 2 * 4 * 4,
                 OFF_END = OFF_IMP + (size_t)T_ * 2 * 128 * 4;

struct WDesc { const float* src; bf16_t* dst; const float* kscale; int K, Nsrc, Ndst, map, tile0, ntn; };
struct Params {
  const float* x; const float* ln_g; const float* ln_b; const float* cmp_pos; const float* cmp_w1;
  float* out; char* ws;
  WDesc wd[24];
  int n_wtiles; int n_early;
};
struct Ctx { const float* x; const float* ln_g; const float* ln_b; const float* cmp_pos; const float* cmp_w1; float* out; char* ws; int tid; };

DI bf16_t f2bf(float x) { unsigned u = __float_as_uint(x); u += 0x7fffu + ((u >> 16) & 1u); return (bf16_t)(u >> 16); }
DI float bf2f(bf16_t v) { return __uint_as_float(((unsigned)v) << 16); }
DI unsigned pk2(float a, float b) { return (unsigned)f2bf(a) | ((unsigned)f2bf(b) << 16); }
DI float fast_exp2(float x) { return __builtin_amdgcn_exp2f(x); }
DI float silu(float v) { return v * __builtin_amdgcn_rcpf(1.f + __expf(-v)); }
DI f32x4 mfma16(bf16x8 a, bf16x8 b, f32x4 c) { return __builtin_amdgcn_mfma_f32_16x16x32_bf16(a, b, c, 0, 0, 0); }

DI void sincos_rr(float ang, float& c, float& s) {
  const double rev = (double)ang * 0.15915494309189533577; const float fr = (float)(rev - rint(rev));
  c = __builtin_amdgcn_cosf(fr); s = __builtin_amdgcn_sinf(fr);
}

struct ALin { const bf16_t* A; int lda; int mmax; DI const bf16_t* ptr(int row, int k) const { row = row < mmax ? row : mmax - 1; return A + (size_t)row * lda + k; } };
struct ACmp {
  const bf16_t* proj; int colbase;
  DI const bf16_t* ptr(int m, int k) const { if (m > 2043) m = 2043; int b = m / 1022, rem = m - b * 1022, g = rem / 511, c = rem - g * 511;
    return proj + (size_t)(b * S_ + 16 * c + (k >> 6)) * PW + colbase + g * 64 + (k & 63); } };

template <class AL, class EPI>
DI void gemm_tile(const int tid, const AL al, const bf16_t* __restrict__ Bt, int ldb, int nvalid, int K, int m0, int n0, const EPI epi, char* smem) {
  const int lane = tid & 63, wave = tid >> 6, wr = wave >> 1, wc = wave & 1, g = lane >> 4;
  f32x4 acc[4][4];
#pragma unroll
  for (int i = 0; i < 4; ++i)
#pragma unroll
    for (int j = 0; j < 4; ++j) acc[i][j] = (f32x4){0.f, 0.f, 0.f, 0.f};
  const int srow = wave * 32 + (lane >> 3), sc8 = ((lane & 7) ^ (lane >> 3)) * 8;
  const bf16_t* bp[4];
#pragma unroll
  for (int i = 0; i < 4; ++i) { int r = n0 + srow + 8 * i; r = r < nvalid ? r : nvalid - 1; bp[i] = Bt + (size_t)r * ldb + sc8; }
  const int offA = (wr * 64 + (lane & 15)) * 128 + ((g ^ (lane & 7)) << 4);
  const int offB = (wc * 64 + (lane & 15)) * 128 + ((g ^ (lane & 7)) << 4);
  const int nk = K >> 6;
  auto stage = [&](int kt, int buf) {
    char* da = smem + buf * 32768 + wave * 4096; const int k0 = kt << 6;
#pragma unroll
    for (int i = 0; i < 4; ++i) {
      __builtin_amdgcn_global_load_lds((const unsigned*)al.ptr(m0 + srow + 8 * i, k0 + sc8), LDSP(unsigned, da + i * 1024), 16, 0, 0);
      __builtin_amdgcn_global_load_lds((const unsigned*)(bp[i] + k0), LDSP(unsigned, da + 16384 + i * 1024), 16, 0, 0);
    }
  };
  bf16x8 a0[4], b0[4], a1[4], b1[4];
  auto rd = [&](bf16x8 (&a)[4], bf16x8 (&b)[4], const char* sa, int ks) {
#pragma unroll
    for (int i = 0; i < 4; ++i) { a[i] = *(const bf16x8*)(sa + ((offA + i * 2048) ^ (ks << 6))); b[i] = *(const bf16x8*)(sa + 16384 + ((offB + i * 2048) ^ (ks << 6))); }
  };
  auto mm = [&](const bf16x8 (&a)[4], const bf16x8 (&b)[4]) {
#pragma unroll
    for (int i = 0; i < 4; ++i)
#pragma unroll
      for (int j = 0; j < 4; ++j) acc[i][j] = mfma16(a[i], b[j], acc[i][j]);
  };
  stage(0, 0);
  asm volatile("s_waitcnt vmcnt(0)" ::: "memory");
  __syncthreads();
  if (nk > 1) stage(1, 1);
  rd(a0, b0, smem, 0);
  for (int kt = 0; kt < nk; ++kt) {
    const char* sa = smem + (kt & 1) * 32768;
    rd(a1, b1, sa, 1);
    __builtin_amdgcn_sched_barrier(0);
    mm(a0, b0);
    __builtin_amdgcn_sched_barrier(0);
    asm volatile("s_waitcnt vmcnt(0)" ::: "memory");
    __syncthreads();
    if (kt + 2 < nk) stage(kt + 2, kt & 1);
    if (kt + 1 < nk) rd(a0, b0, smem + ((kt + 1) & 1) * 32768, 0);
    __builtin_amdgcn_sched_barrier(0);
    mm(a1, b1);
    __builtin_amdgcn_sched_barrier(0);
  }
  epi(acc, m0 + wr * 64, n0 + wc * 64, lane);
}

DI void store_plain(bf16_t* dst, int ld, const f32x4 (&acc)[4][4], int row0, int col0, int lane, float sc) {
#pragma unroll
  for (int mi = 0; mi < 4; ++mi)
#pragma unroll
    for (int r = 0; r < 4; ++r) { const int row = row0 + mi * 16 + (lane >> 4) * 4 + r;
#pragma unroll
      for (int ni = 0; ni < 4; ++ni) dst[(size_t)row * ld + col0 + ni * 16 + (lane & 15)] = f2bf(acc[mi][ni][r] * sc); }
}

struct EpiSwiGLU { bf16_t* H;
  DI void operator()(const f32x4 (&acc)[4][4], int row0, int col0, int lane) const {
#pragma unroll
    for (int mi = 0; mi < 4; ++mi)
#pragma unroll
      for (int r = 0; r < 4; ++r) { const int row = row0 + mi * 16 + (lane >> 4) * 4 + r;
#pragma unroll
        for (int pr = 0; pr < 2; ++pr) { const float gt = acc[mi][2 * pr][r], up = acc[mi][2 * pr + 1][r];
          H[(size_t)row * F_ + ((col0 >> 5) + pr) * 16 + (lane & 15)] = f2bf(silu(gt) * up); } }
  } };
struct EpiResid { const float* xin; float* y; float scale;
  DI void operator()(const f32x4 (&acc)[4][4], int row0, int col0, int lane) const {
#pragma unroll
    for (int mi = 0; mi < 4; ++mi)
#pragma unroll
      for (int r = 0; r < 4; ++r) { const int row = row0 + mi * 16 + (lane >> 4) * 4 + r;
#pragma unroll
        for (int ni = 0; ni < 4; ++ni) { const size_t ix = (size_t)row * D_ + col0 + ni * 16 + (lane & 15); y[ix] = ALPHA * xin[ix] + scale * acc[mi][ni][r]; } }
  } };
struct EpiProj { bf16_t* proj; bf16_t* ka; const float* c64; const float* s64; const float* c32; const float* s32;
  DI void operator()(const f32x4 (&acc)[4][4], int row0, int col0, int lane) const {
    const bool rope = (col0 >= C_DQ && col0 < C_DV) || (col0 >= C_NQR && col0 < C_KC) || (col0 >= C_KSL && col0 < C_VSL) || (col0 >= C_KW && col0 < C_VW);
    if (rope) {
#pragma unroll
      for (int mi = 0; mi < 4; ++mi)
#pragma unroll
        for (int r = 0; r < 4; ++r) { const int row = row0 + mi * 16 + (lane >> 4) * 4 + r, pos = row & (S_ - 1);
#pragma unroll
          for (int ni = 0; ni < 2; ++ni) { const int i = ni * 16 + (lane & 15); const float c = c64[pos * 32 + i], s = s64[pos * 32 + i];
            const float x1 = acc[mi][ni][r], x2 = acc[mi][ni + 2][r];
            proj[(size_t)row * PW + col0 + i] = f2bf(x1 * c - x2 * s); proj[(size_t)row * PW + col0 + 32 + i] = f2bf(x1 * s + x2 * c); } }
    } else if (col0 == C_KPE) {
#pragma unroll
      for (int mi = 0; mi < 4; ++mi)
#pragma unroll
        for (int r = 0; r < 4; ++r) { const int row = row0 + mi * 16 + (lane >> 4) * 4 + r, pos = row & (S_ - 1); const int i = lane & 15;
          const float c = c32[pos * 16 + i], s = s32[pos * 16 + i]; const float x1 = acc[mi][0][r], x2 = acc[mi][1][r];
          const bf16_t o1 = f2bf(x1 * c - x2 * s), o2 = f2bf(x1 * s + x2 * c);
#pragma unroll
          for (int h = 0; h < 4; ++h) { ka[(size_t)row * 384 + h * 96 + 64 + i] = o1; ka[(size_t)row * 384 + h * 96 + 80 + i] = o2; }
#pragma unroll
          for (int ni = 2; ni < 4; ++ni) { const float v = acc[mi][ni][r]; proj[(size_t)row * PW + col0 + ni * 16 + i] = f2bf(1.f / (1.f + __expf(-v))); } }
    } else store_plain(proj, PW, acc, row0, col0, lane, 1.f);
  } };
struct EpiMLAq { bf16_t* qa; const float* rs; int m0; const float* c32; const float* s32;
  DI void operator()(const f32x4 (&acc)[4][4], int row0, int col0, int lane) const {
#pragma unroll
    for (int mi = 0; mi < 4; ++mi)
#pragma unroll
      for (int r = 0; r < 4; ++r) { const int row = row0 + mi * 16 + (lane >> 4) * 4 + r, pos = row & (S_ - 1); const float sc = rs[row - m0]; const int i = lane & 15;
#pragma unroll
        for (int ch = 0; ch < 2; ++ch) { const int gc = col0 + 32 * ch; const float x1 = acc[mi][2 * ch][r] * sc, x2 = acc[mi][2 * ch + 1][r] * sc;
          if (((gc >> 5) % 3) == 2) { const float c = c32[pos * 16 + i], s = s32[pos * 16 + i];
            qa[(size_t)row * 384 + gc + i] = f2bf(x1 * c - x2 * s); qa[(size_t)row * 384 + gc + 16 + i] = f2bf(x1 * s + x2 * c); }
          else { qa[(size_t)row * 384 + gc + i] = f2bf(x1); qa[(size_t)row * 384 + gc + 16 + i] = f2bf(x2); } } }
  } };
struct EpiMLAkv { bf16_t* ka; bf16_t* va; const float* rs; int m0;
  DI void operator()(const f32x4 (&acc)[4][4], int row0, int col0, int lane) const {
    const int h = col0 >> 7, part = (col0 >> 6) & 1;
#pragma unroll
    for (int mi = 0; mi < 4; ++mi)
#pragma unroll
      for (int r = 0; r < 4; ++r) { const int row = row0 + mi * 16 + (lane >> 4) * 4 + r; const float sc = rs[row - m0];
#pragma unroll
        for (int ni = 0; ni < 4; ++ni) { const int j = ni * 16 + (lane & 15); const bf16_t v = f2bf(acc[mi][ni][r] * sc);
          if (part == 0) ka[(size_t)row * 384 + h * 96 + j] = v; else va[(size_t)row * 256 + h * 64 + j] = v; } }
  } };
struct EpiCmp1 { bf16_t* hid; const float* bias;
  DI void operator()(const f32x4 (&acc)[4][4], int row0, int col0, int lane) const {
#pragma unroll
    for (int mi = 0; mi < 4; ++mi)
#pragma unroll
      for (int r = 0; r < 4; ++r) { const int row = row0 + mi * 16 + (lane >> 4) * 4 + r;
#pragma unroll
        for (int ni = 0; ni < 4; ++ni) { const int col = col0 + ni * 16 + (lane & 15); hid[(size_t)row * 256 + col] = f2bf(silu(acc[mi][ni][r] + bias[col])); } }
  } };
struct EpiCmp2 { bf16_t* kc;
  DI void operator()(const f32x4 (&acc)[4][4], int row0, int col0, int lane) const {
    if (col0 >= 64) return;
#pragma unroll
    for (int mi = 0; mi < 4; ++mi)
#pragma unroll
      for (int r = 0; r < 4; ++r) { const int row = row0 + mi * 16 + (lane >> 4) * 4 + r;
        if (row < 2044) {
#pragma unroll
          for (int ni = 0; ni < 4; ++ni) kc[(size_t)row * 64 + col0 + ni * 16 + (lane & 15)] = f2bf(acc[mi][ni][r]); } }
  } };

template <int DQ, int MODE, class OUT>
DI void attn_core(const int tid, const bf16_t* __restrict__ Qb, long qs, const bf16_t* __restrict__ Kb, long kst, const bf16_t* __restrict__ Vb, long vst,
                  int q0, int k0, int kmax, int ntiles, const int* tlist, float sl2, int window,
                  const unsigned* selw, float* impg, bool first_head, float (&m_io)[2], float (&l_io)[2], const OUT out, char* smem) {
  constexpr int NKD = DQ / 32, CPR = DQ / 8, KST = (DQ == 64) ? 128 : 256;
  const int lane = tid & 63, wave = tid >> 6, g = lane >> 4, li = lane & 15;
  bf16x8 qf[2][NKD];
#pragma unroll
  for (int qt = 0; qt < 2; ++qt)
#pragma unroll
    for (int kd = 0; kd < NKD; ++kd) qf[qt][kd] = *(const bf16x8*)(Qb + (long)(q0 + wave * 32 + qt * 16 + li) * qs + kd * 32 + g * 8);
  int qidx[2]; qidx[0] = q0 + wave * 32 + li; qidx[1] = qidx[0] + 16;
  f32x4 o[4][2];
#pragma unroll
  for (int i = 0; i < 4; ++i) { o[i][0] = (f32x4){0.f, 0.f, 0.f, 0.f}; o[i][1] = (f32x4){0.f, 0.f, 0.f, 0.f}; }
  float mrun[2], lrun[2], invl[2], prev3[2];
#pragma unroll
  for (int qt = 0; qt < 2; ++qt) { prev3[qt] = 0.f;
    if (MODE == 3) { mrun[qt] = m_io[qt]; lrun[qt] = 0.f; invl[qt] = l_io[qt] > 0.f ? 1.f / l_io[qt] : 0.f; } else { mrun[qt] = -1e30f; lrun[qt] = 0.f; invl[qt] = 0.f; } }
  constexpr int RPP = 1024 / KST, NKP = 64 / RPP / 4;
  auto stage = [&](int jt, int buf) {
    const int kb = k0 + jt * 64; char* kbuf = smem + buf * 16384; char* vbuf = smem + 32768 + buf * 8192;
#pragma unroll
    for (int i = 0; i < NKP; ++i) { const int pc = wave * NKP + i; const int row = pc * RPP + (DQ == 64 ? (lane >> 3) : (lane >> 4));
      int c = (DQ == 64) ? ((lane & 7) ^ (row & 7)) : ((lane & 15) ^ (row & 7)); if (DQ != 64 && c >= CPR) c = 0;
      int ix = kb + row; ix = ix < 0 ? 0 : (ix > kmax ? kmax : ix);
      __builtin_amdgcn_global_load_lds((const unsigned*)(Kb + (long)ix * kst + c * 8), LDSP(unsigned, kbuf + pc * 1024), 16, 0, 0); }
    if (MODE != 2) {
#pragma unroll
      for (int i = 0; i < 2; ++i) { const int pc = wave * 2 + i; const int row = pc * 8 + (lane >> 3); const int pp = lane & 7;
        const int c = ((((pp >> 1) ^ ((row >> 1) & 3)) << 1) | (pp & 1));
        int ix = kb + row; ix = ix < 0 ? 0 : (ix > kmax ? kmax : ix);
        __builtin_amdgcn_global_load_lds((const unsigned*)(Vb + (long)ix * vst + c * 8), LDSP(unsigned, vbuf + pc * 1024), 16, 0, 0); }
    }
  };
  if (ntiles > 0) stage(tlist ? tlist[0] : 0, 0);
  asm volatile("s_waitcnt vmcnt(0)" ::: "memory");
  __syncthreads();
  for (int it = 0; it < ntiles; ++it) {
    const int jt = tlist ? tlist[it] : it;
    const bool more = it + 1 < ntiles;
    if (more) stage(tlist ? tlist[it + 1] : it + 1, (it + 1) & 1);
    const char* kbuf = smem + (it & 1) * 16384; const char* vbuf = smem + 32768 + (it & 1) * 8192;
    f32x4 st[4][2];
#pragma unroll
    for (int kt4 = 0; kt4 < 4; ++kt4) {
      bf16x8 kf[NKD]; const int row = kt4 * 16 + li;
#pragma unroll
      for (int kd = 0; kd < NKD; ++kd) kf[kd] = *(const bf16x8*)(kbuf + row * KST + (((kd * 4 + g) ^ (row & 7)) << 4));
#pragma unroll
      for (int qt = 0; qt < 2; ++qt) { f32x4 a = (f32x4){0.f, 0.f, 0.f, 0.f};
#pragma unroll
        for (int kd = 0; kd < NKD; ++kd) a = mfma16(kf[kd], qf[qt][kd], a);
        st[kt4][qt] = a; }
    }
    const int kbase = k0 + jt * 64;
    bool sb[2] = {true, true};
    if (MODE == 4) { sb[0] = (selw[(wave * 32 + li) * 4 + (jt >> 5)] >> (jt & 31)) & 1u; sb[1] = (selw[(wave * 32 + 16 + li) * 4 + (jt >> 5)] >> (jt & 31)) & 1u; }
    float alpha[2];
#pragma unroll
    for (int qt = 0; qt < 2; ++qt) {
      float mx = -3e38f;
#pragma unroll
      for (int kt4 = 0; kt4 < 4; ++kt4)
#pragma unroll
        for (int r = 0; r < 4; ++r) { const int kidx = kbase + kt4 * 16 + g * 4 + r; bool v;
          if (MODE == 0) v = kidx <= qidx[qt];
          else if (MODE == 1) v = (kidx >= 0) && (kidx <= qidx[qt]) && (qidx[qt] - kidx <= window);
          else if (MODE == 2 || MODE == 3) v = (kidx <= kmax) && (16 * kidx + 31 <= qidx[qt]);
          else v = (kidx <= qidx[qt]) && sb[qt];
          const float sr = v ? st[kt4][qt][r] : -3e38f; st[kt4][qt][r] = sr; mx = fmaxf(mx, sr); }
      if (MODE != 3) {
        mx = fmaxf(mx, __shfl_xor(mx, 16)); mx = fmaxf(mx, __shfl_xor(mx, 32));
        const float mn = fmaxf(mrun[qt], mx * sl2); alpha[qt] = fast_exp2(mrun[qt] - mn); mrun[qt] = mn;
      } else alpha[qt] = 1.f;
      float ls = 0.f; const float nm = -mrun[qt];
#pragma unroll
      for (int kt4 = 0; kt4 < 4; ++kt4)
#pragma unroll
        for (int r = 0; r < 4; ++r) { float p = fast_exp2(fmaf(st[kt4][qt][r], sl2, nm)); if (MODE == 3) p *= invl[qt]; st[kt4][qt][r] = p; ls += p; }
      lrun[qt] = lrun[qt] * alpha[qt] + ls;
    }
    if (MODE == 3) {
#pragma unroll
      for (int qt = 0; qt < 2; ++qt)
#pragma unroll
        for (int kt4 = 0; kt4 < 4; ++kt4) { const float p3 = st[kt4][qt][3]; const float a = (st[kt4][qt][0] + st[kt4][qt][1]) + (st[kt4][qt][2] + p3);
          const float give = (g == 3) ? prev3[qt] : p3; const float up = __shfl(give, (lane + 48) & 63); prev3[qt] = p3;
          float* ip = impg + (size_t)(wave * 32 + qt * 16 + li) * 128 + jt * 16 + kt4 * 4 + g; const float val = a + up;
          if (first_head) *ip = val; else *ip += val; }
    }
    if (MODE != 2) {
      if (MODE != 3) {
#pragma unroll
        for (int dt = 0; dt < 4; ++dt) { o[dt][0] *= alpha[0]; o[dt][1] *= alpha[1]; }
      }
#pragma unroll
      for (int ks2 = 0; ks2 < 2; ++ks2) {
        bf16x8 pf[2];
#pragma unroll
        for (int qt = 0; qt < 2; ++qt) { u32x4 w; w[0] = pk2(st[2 * ks2][qt][0], st[2 * ks2][qt][1]); w[1] = pk2(st[2 * ks2][qt][2], st[2 * ks2][qt][3]);
          w[2] = pk2(st[2 * ks2 + 1][qt][0], st[2 * ks2 + 1][qt][1]); w[3] = pk2(st[2 * ks2 + 1][qt][2], st[2 * ks2 + 1][qt][3]); pf[qt] = __builtin_bit_cast(bf16x8, w); }
        const int rowA = 32 * ks2 + 4 * g + (li >> 2), p_ = li & 3;
#pragma unroll
        for (int dt = 0; dt < 4; ++dt) {
          const int off = rowA * 128 + ((((dt ^ ((rowA >> 1) & 3)) << 1) | (p_ >> 1)) << 4) + 8 * (p_ & 1);
          const s16x4 lo = __builtin_amdgcn_ds_read_tr16_b64_v4i16(LDSP(s16x4, vbuf + off));
          const s16x4 hi = __builtin_amdgcn_ds_read_tr16_b64_v4i16(LDSP(s16x4, vbuf + off + 2048));
          const bf16x8 vf = __builtin_shufflevector(lo, hi, 0, 1, 2, 3, 4, 5, 6, 7);
          o[dt][0] = mfma16(vf, pf[0], o[dt][0]); o[dt][1] = mfma16(vf, pf[1], o[dt][1]);
        }
      }
    }
    asm volatile("s_waitcnt vmcnt(0)" ::: "memory");
    __syncthreads();
  }
#pragma unroll
  for (int qt = 0; qt < 2; ++qt) {
    float lt = lrun[qt]; lt += __shfl_xor(lt, 16); lt += __shfl_xor(lt, 32);
    if (MODE == 2) { m_io[qt] = mrun[qt]; l_io[qt] = lt; }
    else {
      const float inv = (MODE == 3) ? 1.f : (lt > 0.f ? 1.f / lt : 0.f);
#pragma unroll
      for (int dt = 0; dt < 4; ++dt) out(wave * 32 + qt * 16 + li, dt * 16 + g * 4, o[dt][qt] * inv, mrun[qt], lt);
    }
  }
}

struct OutSet { bf16_t* dst; long ld; const bf16_t* gate; long gld; float* lse; long lld;
  DI void operator()(int ql, int d0, f32x4 v, float m, float l) const {
    float gs = 1.f; if (gate) gs = bf2f(gate[ql * gld]);
    u32x2 w; w[0] = pk2(v[0] * gs, v[1] * gs); w[1] = pk2(v[2] * gs, v[3] * gs); *(u32x2*)(dst + ql * ld + d0) = w;
    if (lse && d0 == 0) lse[ql * lld] = (m + __log2f(l)) * 0.69314718056f;
  } };
struct OutAdd { bf16_t* dst; long ld; const bf16_t* gate; long gld;
  DI void operator()(int ql, int d0, f32x4 v, float m, float l) const {
    const float gs = bf2f(gate[ql * gld]); u32x2* p = (u32x2*)(dst + ql * ld + d0); const u32x2 old = *p;
    u32x2 w; w[0] = pk2(__uint_as_float(old[0] << 16) + v[0] * gs, __uint_as_float(old[0] & 0xffff0000u) + v[1] * gs);
    w[1] = pk2(__uint_as_float(old[1] << 16) + v[2] * gs, __uint_as_float(old[1] & 0xffff0000u) + v[3] * gs); *p = w;
  } };

DI bf16_t* lw(char* ws, int l, size_t off) { return (bf16_t*)(ws + OFF_W + (size_t)l * LW_SIZE + off); }

DI int colmap(int map, int n, int nsrc) {
  if (map == 0) return n < nsrc ? n : -1;
  if (map == 1) { const int t = n >> 5, i = n & 31; return i < 16 ? 16 * t + i : 2816 + 16 * t + (i - 16); }
  if (n < 384) return n;
  if (n < C_DV + 384) return 416 + (n - C_DQ);
  if (n < C_NQR) return 1568 + (n - C_NQ);
  if (n < C_KC) return 1568 + (n - C_NQR);
  if (n < C_KPE) return 1952 + (n - C_KC);
  if (n < C_GL) return 384 + (n - C_KPE);
  if (n < C_GL + 18) return 2720 + (n - C_GL);
  return -1;
}

DI void convert_wtile(const Params& P, const int tid, int t, char* smem) {
      int di = 0;
#pragma unroll 1
      for (int i = 1; i < 24; ++i) if (t >= P.wd[i].tile0) di = i;
      const WDesc d = P.wd[di]; const int lt = t - d.tile0, tn = lt % d.ntn, tk = lt / d.ntn, n0 = tn * 64, k0 = tk * 128;
      float* tile = (float*)smem;
      const int nn = tid & 63; const int sc = colmap(d.map, n0 + nn, d.Nsrc);
      float v[32];
#pragma unroll
      for (int i = 0; i < 32; ++i) { const int kk = (tid >> 6) + 4 * i; v[i] = (sc >= 0) ? d.src[(size_t)(k0 + kk) * d.Nsrc + sc] : 0.f; }
      if (d.kscale) {
#pragma unroll
        for (int i = 0; i < 32; ++i) v[i] *= d.kscale[k0 + (tid >> 6) + 4 * i];
      }
#pragma unroll
      for (int i = 0; i < 32; ++i) tile[((tid >> 6) + 4 * i) * 65 + nn] = v[i];
      __syncthreads();
      { const int on = tid >> 2, kq = tid & 3;
        bf16_t* dp = d.dst + (size_t)(n0 + on) * d.K + k0 + kq * 32;
#pragma unroll
        for (int c = 0; c < 4; ++c) { u32x4 w;
#pragma unroll
          for (int j = 0; j < 4; ++j) w[j] = pk2(tile[(kq * 32 + c * 8 + 2 * j) * 65 + on], tile[(kq * 32 + c * 8 + 2 * j + 1) * 65 + on]);
          *(u32x4*)(dp + c * 8) = w; } }
      __syncthreads();
}

DI void phase_prologue(const Params& P, const Ctx& p, char* smem) {
  const int tid = p.tid;
  const int n_w = P.n_early, n_cb = 4, n_r64 = 256, n_r32 = 128, n_xb = 1024;
  const int total = n_w + n_cb + n_r64 + n_r32 + n_xb;
  for (int t = blockIdx.x; t < total; t += gridDim.x) {
    if (t < n_w) { convert_wtile(P, tid, t, smem);
    } else if (t < n_w + n_cb) {
      const int id = t - n_w; const float* pos = p.cmp_pos + (size_t)id * 2048; const float* w1 = p.cmp_w1 + (size_t)id * 2048 * 256; float a = 0.f;
      for (int k = 0; k < 2048; ++k) a += pos[k] * w1[(size_t)k * 256 + tid];
      ((float*)(p.ws + OFF_CBIAS))[id * 256 + tid] = a;
    } else if (t < n_w + n_cb + n_r64) {
      const int e0 = (t - n_w - n_cb) * 1024; float* C = (float*)(p.ws + OFF_C64); float* Sn = (float*)(p.ws + OFF_S64);
      for (int e = e0 + tid; e < e0 + 1024; e += 256) { const int pos = e >> 5, i = e & 31; const float inv = exp2f(-(float)(2 * i) / 64.f * 13.287712379549449f); const float ang = (float)pos * inv;
        sincos_rr(ang, C[e], Sn[e]); }
    } else if (t < n_w + n_cb + n_r64 + n_r32) {
      const int e0 = (t - n_w - n_cb - n_r64) * 1024; float* C = (float*)(p.ws + OFF_C32); float* Sn = (float*)(p.ws + OFF_S32);
      for (int e = e0 + tid; e < e0 + 1024; e += 256) { const int pos = e >> 4, i = e & 15; const float inv = exp2f(-(float)(2 * i) / 32.f * 13.287712379549449f); const float ang = (float)pos * inv;
        sincos_rr(ang, C[e], Sn[e]); }
    } else {
      const size_t e0 = (size_t)(t - n_w - n_cb - n_r64 - n_r32) * 16384 + tid * 8; bf16_t* xb = (bf16_t*)(p.ws + OFF_XB);
      f32x4 a[8], b[8];
#pragma unroll
      for (int i = 0; i < 8; ++i) { a[i] = *(const f32x4*)(p.x + e0 + i * 2048); b[i] = *(const f32x4*)(p.x + e0 + i * 2048 + 4); }
#pragma unroll
      for (int i = 0; i < 8; ++i) { u32x4 w; w[0] = pk2(a[i][0], a[i][1]); w[1] = pk2(a[i][2], a[i][3]); w[2] = pk2(b[i][0], b[i][1]); w[3] = pk2(b[i][2], b[i][3]);
        *(u32x4*)(xb + e0 + i * 2048) = w; }
    }
  }
}

DI bool tile_seq(int k, int NT, int total, int& mt, int& nt) {
  const int G = gridDim.x, b = blockIdx.x; const int s = k * G + (b & 7) * (G >> 3) + (b >> 3);
  if (s >= total) return false;
  const int band = s / (16 * NT), r = s - band * 16 * NT; nt = r >> 4; mt = band * 16 + (r & 15); return true;
}
DI void phase_ffn_up(const Ctx& p, int l, int j, char* smem) {
  const ALin al{(const bf16_t*)(p.ws + OFF_XB), D_, T_}; const bf16_t* Bt = lw(p.ws, l, LW_FIN + j * SZ_FIN); const EpiSwiGLU epi{(bf16_t*)(p.ws + OFF_BIG)};
  for (int k = 0;; ++k) { int mt, nt; if (!tile_seq(k, 44, 128 * 44, mt, nt)) break; gemm_tile(p.tid, al, Bt, D_, 5632, D_, mt * 128, nt * 128, epi, smem); }
}
DI void phase_ffn_down(const Ctx& p, int l, int j, char* smem) {
  const ALin al{(const bf16_t*)(p.ws + OFF_BIG), F_, T_}; const bf16_t* Bt = lw(p.ws, l, LW_FOUT + j * SZ_FOUT);
  const EpiResid epi{(l == 0 && j == 0) ? p.x : p.out, p.out, 0.5f};
  for (int k = 0;; ++k) { int mt, nt; if (!tile_seq(k, 8, 128 * 8, mt, nt)) break; gemm_tile(p.tid, al, Bt, F_, D_, F_, mt * 128, nt * 128, epi, smem); }
}
DI void phase_wout(const Ctx& p, int l, char* smem) {
  const ALin al{(const bf16_t*)(p.ws + OFF_XB), D_, T_}; const bf16_t* Bt = lw(p.ws, l, LW_WOUT); const EpiResid epi{p.out, p.out, 1.0f};
  for (int k = 0;; ++k) { int mt, nt; if (!tile_seq(k, 8, 128 * 8, mt, nt)) break; gemm_tile(p.tid, al, Bt, D_, D_, D_, mt * 128, nt * 128, epi, smem); }
}
DI void phase_ln(const Ctx& p, int l, int j, bool zero_o) {
  const int lane = p.tid & 63, wave = p.tid >> 6; const float* gp = p.ln_g + (size_t)(l * 3 + j) * D_; const float* bp = p.ln_b + (size_t)(l * 3 + j) * D_;
  bf16_t* xb = (bf16_t*)(p.ws + OFF_XB);
  for (int t = blockIdx.x; t < T_ / 8; t += gridDim.x) {
    const int row = t * 8 + wave * 2; float* yr = p.out + (size_t)row * D_; f32x4 v[2][4]; float s[2] = {0.f, 0.f};
#pragma unroll
    for (int r = 0; r < 2; ++r)
#pragma unroll
      for (int i = 0; i < 4; ++i) v[r][i] = *(const f32x4*)(yr + r * D_ + i * 256 + lane * 4);
#pragma unroll
    for (int r = 0; r < 2; ++r) {
#pragma unroll
      for (int i = 0; i < 4; ++i) s[r] += (v[r][i][0] + v[r][i][1]) + (v[r][i][2] + v[r][i][3]);
#pragma unroll
      for (int o = 1; o < 64; o <<= 1) s[r] += __shfl_xor(s[r], o);
    }
#pragma unroll
    for (int r = 0; r < 2; ++r) {
      const float mu = s[r] * (1.f / D_); float q = 0.f;
#pragma unroll
      for (int i = 0; i < 4; ++i)
#pragma unroll
        for (int e = 0; e < 4; ++e) { const float d = v[r][i][e] - mu; q += d * d; }
#pragma unroll
      for (int o = 1; o < 64; o <<= 1) q += __shfl_xor(q, o);
      const float rstd = rsqrtf(q * (1.f / D_) + 1e-5f);
#pragma unroll
      for (int i = 0; i < 4; ++i) { const int c = i * 256 + lane * 4; const f32x4 gg = *(const f32x4*)(gp + c), bb = *(const f32x4*)(bp + c); f32x4 o4;
#pragma unroll
        for (int e = 0; e < 4; ++e) o4[e] = (v[r][i][e] - mu) * rstd * gg[e] + bb[e];
        *(f32x4*)(yr + r * D_ + c) = o4; u32x2 w; w[0] = pk2(o4[0], o4[1]); w[1] = pk2(o4[2], o4[3]); *(u32x2*)(xb + (size_t)(row + r) * D_ + c) = w; }
    }
  }
}
DI void phase_win(const Ctx& p, int l, char* smem) {
  const ALin al{(const bf16_t*)(p.ws + OFF_XB), D_, T_}; const bf16_t* Bt = lw(p.ws, l, LW_WIN);
  const EpiProj epi{(bf16_t*)(p.ws + OFF_BIG), (bf16_t*)(p.ws + OFF_KA), (const float*)(p.ws + OFF_C64), (const float*)(p.ws + OFF_S64), (const float*)(p.ws + OFF_C32), (const float*)(p.ws + OFF_S32)};
  for (int k = 0;; ++k) { int mt, nt; if (!tile_seq(k, 25, 128 * 25, mt, nt)) break; gemm_tile(p.tid, al, Bt, D_, PW, D_, mt * 128, nt * 128, epi, smem); }
}

DI int next_item(const int tid, unsigned* ctr, char* smem) {
  int* slot = (int*)(smem + 69632 - 16);
  __syncthreads();
  if (tid == 0) *slot = (int)atomicAdd(ctr, 1u);
  __syncthreads();
  return *slot;
}

DI void item_dilated(const Ctx& p, int id, char* smem) {
  const int pat = id / 768, r1 = id % 768, b = r1 / 384, r2 = r1 % 384, h = r2 >> 6, blk = r2 & 63;
  const int dil = pat == 0 ? 1 : (pat == 1 ? 4 : 16), nsub = 64 / dil, rho = blk / nsub, i = blk % nsub;
  const bf16_t* proj = (const bf16_t*)(p.ws + OFF_BIG); const bf16_t* base = proj + (size_t)(b * S_ + rho) * PW; const long rs = (long)dil * PW;
  bf16_t* dst = (bf16_t*)(p.ws + OFF_DILO) + ((size_t)pat * T_ + b * S_ + rho + (size_t)dil * 128 * i) * 384 + h * 64;
  float* lse = (float*)(p.ws + OFF_DILL) + ((size_t)pat * T_ + b * S_ + rho + (size_t)dil * 128 * i) * 6 + h;
  const OutSet out{dst, (long)dil * 384, nullptr, 0, lse, (long)dil * 6}; float mm[2], ll[2];
  attn_core<64, 1>(p.tid, base + C_DQ + h * 64, rs, base + C_DK + h * 64, rs, base + C_DV + h * 64, rs, 128 * i, 128 * i - 128, S_ / dil - 1, 4, nullptr,
                   0.125f * 1.44269504089f, 128, nullptr, nullptr, false, mm, ll, out, smem);
}
DI void item_nsawin(const Ctx& p, int id, char* smem) {
  const int b = id / 384, r = id % 384, h = r >> 6, i = r & 63, g = h / 3;
  const bf16_t* proj = (const bf16_t*)(p.ws + OFF_BIG); const bf16_t* base = proj + (size_t)(b * S_) * PW;
  bf16_t* o = (bf16_t*)(p.ws + OFF_XB) + (size_t)(b * S_ + 128 * i) * D_ + 640 + h * 64;
  const OutSet out{o, D_, base + (size_t)(128 * i) * PW + C_GL + h * 3 + 2, PW, nullptr, 0}; float mm[2], ll[2];
  attn_core<64, 1>(p.tid, base + C_NQR + h * 64, PW, base + C_KW + g * 64, PW, base + C_VW + g * 64, PW, 128 * i, 128 * i - 512, S_ - 1, 10, nullptr,
                   0.125f * 1.44269504089f, 512, nullptr, nullptr, false, mm, ll, out, smem);
}
DI void item_expand(const Ctx& p, int l, int id, char* smem) {
  const bf16_t* proj = (const bf16_t*)(p.ws + OFF_BIG); float* rs = (float*)(smem + 65536);
  const bool isq = id < 384; const int lid = isq ? id : id - 384; const int mt = isq ? lid / 3 : lid >> 2, nt = isq ? lid % 3 : lid & 3;
  const int K = isq ? 256 : 128, cb = isq ? C_CQ : C_CKV, tid = p.tid;
  { const int row = tid >> 1, half = tid & 1; const bf16_t* rp = proj + (size_t)(mt * 128 + row) * PW + cb + half * (K / 2); float ss = 0.f;
    for (int c = 0; c < K / 2; c += 8) { const u32x4 w = *(const u32x4*)(rp + c);
#pragma unroll
      for (int e = 0; e < 4; ++e) { const float a = __uint_as_float(w[e] << 16), b2 = __uint_as_float(w[e] & 0xffff0000u); ss += a * a + b2 * b2; } }
    ss += __shfl_xor(ss, 1); if (half == 0) rs[row] = rsqrtf(ss / (float)K + 1e-6f); }
  __syncthreads();
  const ALin al{proj + cb, PW, T_};
  if (isq) { const EpiMLAq epi{(bf16_t*)(p.ws + OFF_QA), rs, mt * 128, (const float*)(p.ws + OFF_C32), (const float*)(p.ws + OFF_S32)};
    gemm_tile(p.tid, al, lw(p.ws, l, LW_UQ), 256, 384, 256, mt * 128, nt * 128, epi, smem); }
  else { const EpiMLAkv epi{(bf16_t*)(p.ws + OFF_KA), (bf16_t*)(p.ws + OFF_VA), rs, mt * 128};
    gemm_tile(p.tid, al, lw(p.ws, l, LW_UKV), 128, 512, 128, mt * 128, nt * 128, epi, smem); }
}
DI void item_cmp(const Ctx& p, int l, int id, char* smem) {
  const int kv = id >> 4, mt = id & 15; const ACmp al1{(const bf16_t*)(p.ws + OFF_BIG), kv ? C_VC : C_KC};
  bf16_t* hid = (bf16_t*)(p.ws + OFF_CHID) + (size_t)kv * 2048 * 256;
  const EpiCmp1 epi1{hid, (const float*)(p.ws + OFF_CBIAS) + (l * 2 + kv) * 256};
#pragma unroll 1
  for (int nt = 0; nt < 2; ++nt) gemm_tile(p.tid, al1, lw(p.ws, l, LW_C1 + kv * SZ_C1), 2048, 256, 2048, mt * 128, nt * 128, epi1, smem);
  asm volatile("s_waitcnt vmcnt(0)" ::: "memory");
  __syncthreads();
  const ALin al2{hid, 256, 2048}; const EpiCmp2 epi2{(bf16_t*)(p.ws + OFF_KCVC) + (size_t)kv * 2048 * 64};
  int t2 = p.tid; asm volatile("" : "+v"(t2));
  gemm_tile(t2, al2, lw(p.ws, l, LW_C2 + kv * SZ_C2), 256, 64, 256, mt * 128, 0, epi2, smem);
}
DI void item_mla(const Ctx& p, int id, char* smem) {
  const int i = 63 - (id >> 3), bh = id & 7, b = bh >> 2, h = bh & 3;
  const bf16_t* qa = (const bf16_t*)(p.ws + OFF_QA) + (size_t)(b * S_) * 384 + h * 96; const bf16_t* ka = (const bf16_t*)(p.ws + OFF_KA) + (size_t)(b * S_) * 384 + h * 96;
  const bf16_t* va = (const bf16_t*)(p.ws + OFF_VA) + (size_t)(b * S_) * 256 + h * 64;
  bf16_t* o = (bf16_t*)(p.ws + OFF_XB) + (size_t)(b * S_ + 128 * i) * D_ + h * 64; const OutSet out{o, D_, nullptr, 0, nullptr, 0}; float mm[2], ll[2];
  attn_core<96, 0>(p.tid, qa, 384, ka, 384, va, 256, 128 * i, 0, S_ - 1, 2 * (i + 1), nullptr, 0.10206207261f * 1.44269504089f, 0, nullptr, nullptr, false, mm, ll, out, smem);
}
DI void item_nsacmp(const Ctx& p, int id, char* smem) {
  const int i = 63 - (id >> 2), bg = id & 3, b = bg >> 1, g = bg & 1, tid = p.tid;
  const bf16_t* proj = (const bf16_t*)(p.ws + OFF_BIG); const bf16_t* base = proj + (size_t)(b * S_) * PW;
  const bf16_t* kc = (const bf16_t*)(p.ws + OFF_KCVC) + (size_t)((b * 2 + g) * NCMP) * 64; const bf16_t* vc = kc + (size_t)2048 * 64;
  float* imp = (float*)(p.ws + OFF_IMP) + ((size_t)((b * 2 + g) * S_) + 128 * i) * 128;
  const int nkt = (i + 8) >> 3;
#pragma unroll 1
  for (int hh = 0; hh < 3; ++hh) { const int h = g * 3 + hh; float mm[2], ll[2];
    bf16_t* o = (bf16_t*)(p.ws + OFF_XB) + (size_t)(b * S_ + 128 * i) * D_ + 640 + h * 64;
    const OutAdd out{o, D_, base + (size_t)(128 * i) * PW + C_GL + h * 3 + 0, PW};
    attn_core<64, 2>(p.tid, base + C_NQ + h * 64, PW, kc, 64, vc, 64, 128 * i, 0, NCMP - 1, nkt, nullptr, 0.125f * 1.44269504089f, 0, nullptr, nullptr, false, mm, ll, out, smem);
    attn_core<64, 3>(p.tid, base + C_NQ + h * 64, PW, kc, 64, vc, 64, 128 * i, 0, NCMP - 1, nkt, nullptr, 0.125f * 1.44269504089f, 0, nullptr, imp, hh == 0, mm, ll, out, smem);
  }
  __syncthreads();
  float* sc = (float*)smem;
  const int q = tid >> 1, half = tid & 1, qpos = 128 * i + q, cur = qpos >> 6;
#pragma unroll 2
  for (int j = half * 64; j < half * 64 + 64; ++j) { const float v = (j < nkt * 16) ? imp[(size_t)q * 128 + j] : 0.f; const bool forced = (j == 0) || (j == cur) || (j == cur - 1);
    sc[q * 129 + j] = forced ? 1e4f : (j <= cur ? v : -1e4f); }
  unsigned m0 = 0, m1 = 0, m2 = 0, m3 = 0;
#pragma unroll 1
  for (int rd = 0; rd < 16; ++rd) {
    float bv = -3e38f; int bj = half * 64;
#pragma unroll 4
    for (int j = half * 64; j < half * 64 + 64; ++j) { const float v = sc[q * 129 + j]; if (v > bv) { bv = v; bj = j; } }
    const float ov = __shfl_xor(bv, 1); const int oj = __shfl_xor(bj, 1);
    if (ov > bv || (ov == bv && oj < bj)) { bv = ov; bj = oj; }
    if ((bj >> 6) == half) sc[q * 129 + bj] = -3.2e38f;
    if (bj <= cur) { const unsigned bit = 1u << (bj & 31); const int w = bj >> 5; m0 |= (w == 0) ? bit : 0u; m1 |= (w == 1) ? bit : 0u; m2 |= (w == 2) ? bit : 0u; m3 |= (w == 3) ? bit : 0u; }
  }
  if (half == 0) { u32x4 w; w[0] = m0; w[1] = m1; w[2] = m2; w[3] = m3; *(u32x4*)((unsigned*)(p.ws + OFF_SEL) + ((size_t)(b * S_ + qpos) * 2 + g) * 4) = w; }
  __syncthreads();
}
DI void item_dilcombine(const Ctx& p, int id) {
  const size_t e = (size_t)id * 256 + p.tid; const int tok = (int)(e / 48), r = (int)(e % 48), h = r >> 3, d0 = (r & 7) * 8;
  const float* L = (const float*)(p.ws + OFF_DILL); const bf16_t* O = (const bf16_t*)(p.ws + OFF_DILO);
  const float l0 = L[(size_t)tok * 6 + h], l1 = L[((size_t)T_ + tok) * 6 + h], l2 = L[((size_t)2 * T_ + tok) * 6 + h]; const float mx = fmaxf(l0, fmaxf(l1, l2));
  float w0 = __expf(l0 - mx), w1 = __expf(l1 - mx), w2 = __expf(l2 - mx); const float inv = 1.f / (w0 + w1 + w2); w0 *= inv; w1 *= inv; w2 *= inv;
  const u32x4 a = *(const u32x4*)(O + (size_t)tok * 384 + h * 64 + d0), b = *(const u32x4*)(O + ((size_t)T_ + tok) * 384 + h * 64 + d0), c = *(const u32x4*)(O + ((size_t)2 * T_ + tok) * 384 + h * 64 + d0);
  u32x4 w;
#pragma unroll
  for (int k = 0; k < 4; ++k) { const float lo = w0 * __uint_as_float(a[k] << 16) + w1 * __uint_as_float(b[k] << 16) + w2 * __uint_as_float(c[k] << 16);
    const float hi = w0 * __uint_as_float(a[k] & 0xffff0000u) + w1 * __uint_as_float(b[k] & 0xffff0000u) + w2 * __uint_as_float(c[k] & 0xffff0000u); w[k] = pk2(lo, hi); }
  *(u32x4*)((bf16_t*)(p.ws + OFF_XB) + (size_t)tok * D_ + 256 + h * 64 + d0) = w;
}
DI void item_nsaslc(const Ctx& p, int id, char* smem) {
  const int i = 63 - id / 12, r = id % 12, b = r / 6, h = r % 6, g = h / 3, tid = p.tid;
  const bf16_t* proj = (const bf16_t*)(p.ws + OFF_BIG); const bf16_t* base = proj + (size_t)(b * S_) * PW;
  unsigned* selw = (unsigned*)(smem + 49152 + 2048); int* tlist = (int*)(smem + 49152); unsigned* un = (unsigned*)(smem + 49152 + 1024);
  __syncthreads();
  if (tid < 4) un[tid] = 0u;
  __syncthreads();
  if (tid < 128) { const u32x4 w = *(const u32x4*)((const unsigned*)(p.ws + OFF_SEL) + ((size_t)(b * S_ + 128 * i + tid) * 2 + g) * 4);
    selw[tid * 4 + 0] = w[0]; selw[tid * 4 + 1] = w[1]; selw[tid * 4 + 2] = w[2]; selw[tid * 4 + 3] = w[3];
    atomicOr(&un[0], w[0]); atomicOr(&un[1], w[1]); atomicOr(&un[2], w[2]); atomicOr(&un[3], w[3]); }
  __syncthreads();
  if (tid == 0) { int n = 0; for (int jt = 0; jt < 2 * (i + 1); ++jt) if ((un[jt >> 5] >> (jt & 31)) & 1u) tlist[n++] = jt; tlist[255] = n; }
  __syncthreads();
  const int nt = tlist[255];
  bf16_t* o = (bf16_t*)(p.ws + OFF_XB) + (size_t)(b * S_ + 128 * i) * D_ + 640 + h * 64;
  const OutAdd out{o, D_, base + (size_t)(128 * i) * PW + C_GL + h * 3 + 1, PW}; float mm[2], ll[2];
  attn_core<64, 4>(p.tid, base + C_NQR + h * 64, PW, base + C_KSL + g * 64, PW, base + C_VSL + g * 64, PW, 128 * i, 0, S_ - 1, nt, tlist, 0.125f * 1.44269504089f, 0, selw, nullptr, false, mm, ll, out, smem);
}

DI void phase_mix_a(const Params& P, const Ctx& p0, int l, char* smem, int ci, int f0, int f1) {
  unsigned* ctr = (unsigned*)(p0.ws + OFF_CTRL) + l * 8 + ci; const int total = 32 + 768 + 2304 + 896;
  for (;;) { Ctx q = p0; asm volatile("" : "+v"(q.tid)); asm volatile("" : "+v"(q.ws)); const Ctx& p = q; const int t = next_item(p.tid, ctr, smem);
    if (t >= total) { if (t - total < f1 - f0) { convert_wtile(P, p.tid, f0 + t - total, smem); continue; } break; }
    if (t < 32) item_cmp(p, l, t, smem); else if (t < 32 + 768) item_nsawin(p, t - 32, smem); else if (t < 32 + 768 + 2304) item_dilated(p, t - 32 - 768, smem);
    else item_expand(p, l, t - 32 - 768 - 2304, smem); }
}
DI void phase_mix_b(const Params& P, const Ctx& p0, int l, char* smem, int ci, int f0, int f1) {
  unsigned* ctr = (unsigned*)(p0.ws + OFF_CTRL) + l * 8 + ci; const int total = 512 + 256 + 3072;
  for (;;) { Ctx q = p0; asm volatile("" : "+v"(q.tid)); asm volatile("" : "+v"(q.ws)); const Ctx& p = q; const int t = next_item(p.tid, ctr, smem);
    if (t >= total) { if (t - total < f1 - f0) { convert_wtile(P, p.tid, f0 + t - total, smem); continue; } break; }
    if (t < 512) item_mla(p, t, smem);
    else if (t < 512 + 256) item_nsacmp(p, t - 512, smem); else item_dilcombine(p, t - 512 - 256); }
}
DI void phase_mix_d(const Params& P, const Ctx& p0, int l, char* smem, int f0, int f1) {
  unsigned* ctr = (unsigned*)(p0.ws + OFF_CTRL) + l * 8 + 3; const int total = 768;
  for (;;) { Ctx q = p0; asm volatile("" : "+v"(q.tid)); asm volatile("" : "+v"(q.ws)); const Ctx& p = q; const int t = next_item(p.tid, ctr, smem);
    if (t >= total) { if (t - total < f1 - f0) { convert_wtile(P, p.tid, f0 + t - total, smem); continue; } break; }
    item_nsaslc(p, t, smem); }
}
DI void phase_zero_o(const Ctx& p) {
  u32x4* o = (u32x4*)(p.ws + OFF_XB); const u32x4 z = (u32x4){0u, 0u, 0u, 0u};
  for (size_t e = (size_t)blockIdx.x * 256 + p.tid; e < (size_t)T_ * D_ / 8; e += (size_t)gridDim.x * 256) o[e] = z;
}

DI void run_phase(const Params& P, int ph, char* smem) {
  Ctx p; p.x = P.x; p.ln_g = P.ln_g; p.ln_b = P.ln_b; p.cmp_pos = P.cmp_pos; p.cmp_w1 = P.cmp_w1; p.out = P.out; p.ws = P.ws; p.tid = threadIdx.x;
  asm volatile("" : "+v"(p.tid));
  if (ph == 0) { phase_prologue(P, p, smem); return; }
  const int l = (ph - 1) / 12; int s = (ph - 1) % 12;
#ifdef ONLY_S
  if (s != ONLY_S) return;
  s = ONLY_S;
#endif
  switch (s) {
    case 0: phase_ffn_up(p, l, 0, smem); break;
    case 1: phase_ffn_down(p, l, 0, smem); break;
    case 2: phase_ln(p, l, 0, false); break;
#if ENABLE_MIX
    case 3: phase_win(p, l, smem); break;
    case 4: { const int nl = P.n_wtiles - P.n_early, a = P.n_early, b = a + (l == 0 ? nl / 3 : 0); phase_mix_a(P, p, l, smem, 0, a, b); } break;
    case 5: { const int nl = P.n_wtiles - P.n_early, a = P.n_early + nl / 3, b = a + (l == 0 ? nl / 3 : 0); phase_mix_b(P, p, l, smem, 1, a, b); } break;
    case 6: { const int nl = P.n_wtiles - P.n_early, a = P.n_early + 2 * (nl / 3), b = (l == 0 ? P.n_wtiles : a); phase_mix_d(P, p, l, smem, a, b); } break;
#else
    case 3: phase_zero_o(p); break;
    case 4: case 5: case 6: break;
#endif
    case 7: phase_wout(p, l, smem); break;
    case 8: phase_ln(p, l, 1, false); break;
    case 9: phase_ffn_up(p, l, 1, smem); break;
    case 10: phase_ffn_down(p, l, 1, smem); break;
    case 11: phase_ln(p, l, 2, false); break;
  }
}
constexpr int NPHASE = 25;

#if ONE_LAUNCH
DI unsigned xb_ld(unsigned* p) { return __hip_atomic_load(p, __ATOMIC_RELAXED, __HIP_MEMORY_SCOPE_AGENT); }
DI unsigned xb_add(unsigned* p, unsigned v) { return __hip_atomic_fetch_add(p, v, __ATOMIC_RELAXED, __HIP_MEMORY_SCOPE_AGENT); }
DI void xb_st(unsigned* p, unsigned v) { __hip_atomic_store(p, v, __ATOMIC_RELAXED, __HIP_MEMORY_SCOPE_AGENT); }
constexpr int XB_CNT = 256, XB_SUB = 256 + 64 * 16, XB_GEN = 256 + 64 * 32, XB_TOP = 256 + 64 * 48, XB_TOPGEN = 256 + 64 * 49, XB_WORDS = 256 + 64 * 50;
DI void grid_bar(const Params& P, unsigned idx, char* smem) {
  asm volatile("s_waitcnt vmcnt(0)" ::: "memory");
  __syncthreads();
  int t = threadIdx.x; asm volatile("" : "+v"(t));
  if (t == 0) {
    unsigned* bar = (unsigned*)(P.ws + OFF_CTRL);
    volatile unsigned* st = (volatile unsigned*)(smem + 69632 - 16);
    const unsigned x = st[1], nloc = st[2], nx = st[3];
    const unsigned old = xb_add(&bar[XB_SUB + 64 * x], 1u);
    if (old + 1u == idx * nloc) {
      __builtin_amdgcn_fence(__ATOMIC_RELEASE, "agent");
      asm volatile("s_waitcnt vmcnt(0)" ::: "memory");
      const unsigned og = xb_add(&bar[XB_TOP], 1u);
      if (og + 1u == idx * nx) xb_st(&bar[XB_TOPGEN], idx);
      else { while (xb_ld(&bar[XB_TOPGEN]) < idx) __builtin_amdgcn_s_sleep(1); }
      xb_st(&bar[XB_GEN + 64 * x], idx);
    } else { while (xb_ld(&bar[XB_GEN + 64 * x]) < idx) __builtin_amdgcn_s_sleep(1); }
    __builtin_amdgcn_fence(__ATOMIC_ACQUIRE, "agent");
    asm volatile("s_waitcnt vmcnt(0)" ::: "memory");
  }
  __syncthreads();
}
template <int PH> DI void run_all(const Params& p, char* smem) {
  run_phase(p, PH, smem);
  if constexpr (PH + 1 < NPHASE) { grid_bar(p, PH + 1, smem); run_all<PH + 1>(p, smem); }
}
__global__ void __launch_bounds__(256, 2) mega_kernel(Params p) {
  __shared__ __attribute__((aligned(16))) char smem[69632];
  {
    unsigned* bar = (unsigned*)(p.ws + OFF_CTRL); volatile unsigned* st = (volatile unsigned*)(smem + 69632 - 16);
    const unsigned x = (unsigned)__builtin_amdgcn_s_getreg((3 << 11) | 20) & 0xFu;
    if (threadIdx.x == 0) xb_add(&bar[XB_CNT + 64 * x], 1u);
    cg::this_grid().sync();
    if (threadIdx.x == 0) { unsigned nx = 0, mine = 1;
      for (unsigned j = 0; j < 16; ++j) { const unsigned c = xb_ld(&bar[XB_CNT + 64 * j]); nx += (c > 0u) ? 1u : 0u; if (j == x) mine = c; }
      st[1] = x; st[2] = mine; st[3] = nx; }
    __syncthreads();
  }
  run_all<0>(p, smem);
}
#define MAIN_KERNEL mega_kernel
#else
#define MAIN_KERNEL phase_kernel
#endif
__global__ void __launch_bounds__(256, 2) phase_kernel(Params p, int ph) {
  __shared__ __attribute__((aligned(16))) char smem[69632];
  run_phase(p, ph, smem);
}

extern "C" void kernel_launch(void* const* d_in, const int* in_sizes, int n_in, void* d_out, int out_size, void* d_ws, size_t ws_size, hipStream_t stream) {
  static int grid_blocks = 0;
  if (!grid_blocks) { int dev = 0, cus = 0, per_cu = 0; hipGetDevice(&dev); hipDeviceGetAttribute(&cus, hipDeviceAttributeMultiprocessorCount, dev);
    hipOccupancyMaxActiveBlocksPerMultiprocessor(&per_cu, MAIN_KERNEL, 256, 0); if (per_cu > 2) per_cu = 2; if (per_cu < 1) per_cu = 1; grid_blocks = cus * per_cu; }
  if (ws_size < OFF_END) { fprintf(stderr, "workspace too small: %zu < %zu\n", ws_size, (size_t)OFF_END); return; }
  Params p; memset(&p, 0, sizeof(p));
  const float* x = (const float*)d_in[0]; const float* ffn_in = (const float*)d_in[1]; const float* ffn_out = (const float*)d_in[2];
  const float* w_in = (const float*)d_in[5]; const float* w_out = (const float*)d_in[6]; const float* qn = (const float*)d_in[7]; const float* kvn = (const float*)d_in[8];
  const float* wuq = (const float*)d_in[9]; const float* wukv = (const float*)d_in[10]; const float* cw1 = (const float*)d_in[12]; const float* cw2 = (const float*)d_in[13];
  p.x = x; p.ln_g = (const float*)d_in[3]; p.ln_b = (const float*)d_in[4]; p.cmp_pos = (const float*)d_in[11]; p.cmp_w1 = cw1; p.out = (float*)d_out; p.ws = (char*)d_ws;
  int tile0 = 0, di = 0;
  auto add = [&](const float* src, size_t dst_off, const float* ksc, int K, int Nsrc, int Ndst, int map) {
    WDesc& d = p.wd[di++]; d.src = src; d.dst = (bf16_t*)((char*)d_ws + dst_off); d.kscale = ksc; d.K = K; d.Nsrc = Nsrc; d.Ndst = Ndst; d.map = map; d.tile0 = tile0; d.ntn = Ndst / 64;
    tile0 += (Ndst / 64) * (K / 128); };
  auto add_ffn_in = [&](int l, int j) { add(ffn_in + (size_t)(l * 2 + j) * 1024 * 5632, OFF_W + (size_t)l * LW_SIZE + LW_FIN + j * SZ_FIN, nullptr, 1024, 5632, 5632, 1); };
  auto add_ffn_out = [&](int l, int j) { add(ffn_out + (size_t)(l * 2 + j) * 2816 * 1024, OFF_W + (size_t)l * LW_SIZE + LW_FOUT + j * SZ_FOUT, nullptr, 2816, 1024, 1024, 0); };
  auto add_mix = [&](int l) { const size_t wb = OFF_W + (size_t)l * LW_SIZE;
    add(w_in + (size_t)l * 1024 * 2738, wb + LW_WIN, nullptr, 1024, 2738, PW, 2);
    add(wuq + (size_t)l * 256 * 384, wb + LW_UQ, qn + l * 256, 256, 384, 384, 0);
    add(wukv + (size_t)l * 128 * 512, wb + LW_UKV, kvn + l * 128, 128, 512, 512, 0);
    for (int kv = 0; kv < 2; ++kv) add(cw1 + (size_t)(l * 2 + kv) * 2048 * 256, wb + LW_C1 + kv * SZ_C1, nullptr, 2048, 256, 256, 0);
    for (int kv = 0; kv < 2; ++kv) add(cw2 + (size_t)(l * 2 + kv) * 256 * 64, wb + LW_C2 + kv * SZ_C2, nullptr, 256, 64, 64, 0); };
  auto add_wout = [&](int l) { add(w_out + (size_t)l * 1024 * 1024, OFF_W + (size_t)l * LW_SIZE + LW_WOUT, nullptr, 1024, 1024, 1024, 0); };
  add_ffn_in(0, 0); add_ffn_out(0, 0); add_mix(0);
  p.n_early = tile0;
  add_wout(0); add_ffn_in(0, 1); add_ffn_out(0, 1); add_ffn_in(1, 0); add_ffn_out(1, 0); add_mix(1); add_wout(1); add_ffn_in(1, 1); add_ffn_out(1, 1);
  p.n_wtiles = tile0;
  hipMemsetAsync((char*)d_ws + OFF_CTRL, 0, 16384, stream);
#if ONE_LAUNCH
  void* args[] = {&p};
  hipError_t e = hipLaunchCooperativeKernel((void*)mega_kernel, dim3(grid_blocks), dim3(256), args, 0, stream);
  if (e != hipSuccess) fprintf(stderr, "cooperative launch failed: %s (grid %d)\n", hipGetErrorString(e), grid_blocks);
#else
  for (int ph = 0; ph < NPHASE; ++ph) phase_kernel<<<dim3(grid_blocks), dim3(256), 0, stream>>>(p, ph);
#endif
}
```

```cpp
#include <hip/hip_runtime.h>
#include <hip/hip_cooperative_groups.h>
#include <cstdio>
#include <cstdint>
#include <cstring>
namespace cg = cooperative_groups;

typedef unsigned short bf16_t;
typedef short bf16x8 __attribute__((ext_vector_type(8)));
typedef short s16x4 __attribute__((ext_vector_type(4)));
typedef float f32x4 __attribute__((ext_vector_type(4)));
typedef unsigned u32x4 __attribute__((ext_vector_type(4)));
typedef unsigned u32x2 __attribute__((ext_vector_type(2)));
#define DI __device__ __forceinline__
#define LDSP(T, p) ((__attribute__((address_space(3))) T*)(p))

#ifndef ENABLE_MIX
#define ENABLE_MIX 1
#endif
#ifndef PROBE_REP
#define PROBE_REP 0
#endif
#ifndef ONE_LAUNCH
#define ONE_LAUNCH 1
#endif

constexpr int T_ = 16384, S_ = 8192, D_ = 1024, F_ = 2816, PW = 3200;
constexpr float ALPHA = 1.41421356237f;
constexpr int C_CQ = 0, C_CKV = 256, C_DQ = 384, C_DK = 768, C_DV = 1152, C_NQ = 1536, C_NQR = 1920, C_KC = 2304, C_VC = 2432,
              C_KSL = 2560, C_VSL = 2688, C_KW = 2816, C_VW = 2944, C_KPE = 3072, C_GL = 3104;
constexpr int NCMP = 511;

constexpr size_t SZ_FIN = 5632ull * 1024 * 2, SZ_FOUT = 1024ull * 2816 * 2, SZ_WIN = (size_t)PW * 1024 * 2, SZ_WOUT = 1024ull * 1024 * 2,
                 SZ_UQ = 384ull * 256 * 2, SZ_UKV = 512ull * 128 * 2, SZ_C1 = 256ull * 2048 * 2, SZ_C2 = 64ull * 256 * 2;
constexpr size_t LW_FIN = 0, LW_FOUT = LW_FIN + 2 * SZ_FIN, LW_WIN = LW_FOUT + 2 * SZ_FOUT, LW_WOUT = LW_WIN + SZ_WIN, LW_UQ = LW_WOUT + SZ_WOUT,
                 LW_UKV = LW_UQ + SZ_UQ, LW_C1 = LW_UKV + SZ_UKV, LW_C2 = LW_C1 + 2 * SZ_C1, LW_SIZE = LW_C2 + 2 * SZ_C2;
constexpr size_t OFF_CTRL = 0, OFF_C64 = 16384, OFF_S64 = OFF_C64 + 8192ull * 32 * 4, OFF_C32 = OFF_S64 + 8192ull * 32 * 4, OFF_S32 = OFF_C32 + 8192ull * 16 * 4,
                 OFF_CBIAS = OFF_S32 + 8192ull * 16 * 4, OFF_W = OFF_CBIAS + 4096, OFF_XB = OFF_W + 2 * LW_SIZE, OFF_BIG = OFF_XB + (size_t)T_ * D_ * 2,
                 OFF_QA = OFF_BIG + (size_t)T_ * PW * 2, OFF_KA = OFF_QA + (size_t)T_ * 384 * 2, OFF_VA = OFF_KA + (size_t)T_ * 384 * 2,
                 OFF_DILO = OFF_VA + (size_t)T_ * 256 * 2, OFF_DILL = OFF_DILO + 3ull * T_ * 384 * 2, OFF_CHID = OFF_DILL + 3ull * T_ * 6 * 4,
                 OFF_KCVC = OFF_CHID + 2ull * 2048 * 256 * 2, OFF_SEL = OFF_KCVC + 2ull * 2048 * 64 * 2, OFF_IMP = OFF_SEL + (size_t)T_ * 2 * 4 * 4,
                 OFF_END = OFF_IMP + (size_t)T_ * 2 * 128 * 4;

struct WDesc { const float* src; bf16_t* dst; const float* kscale; int K, Nsrc, Ndst, map, tile0, ntn; };
struct Params {
  const float* x; const float* ln_g; const float* ln_b; const float* cmp_pos; const float* cmp_w1;
  float* out; char* ws;
  WDesc wd[24];
  int n_wtiles; int n_early;
};
struct Ctx { const float* x; const float* ln_g; const float* ln_b; const float* cmp_pos; const float* cmp_w1; float* out; char* ws; int tid; };

DI bf16_t f2bf(float x) { unsigned u = __float_as_uint(x); u += 0x7fffu + ((u >> 16) & 1u); return (bf16_t)(u >> 16); }
DI float bf2f(bf16_t v) { return __uint_as_float(((unsigned)v) << 16); }
DI unsigned pk2(float a, float b) { return (unsigned)f2bf(a) | ((unsigned)f2bf(b) << 16); }
DI float fast_exp2(float x) { return __builtin_amdgcn_exp2f(x); }
DI float silu(float v) { return v * __builtin_amdgcn_rcpf(1.f + __expf(-v)); }
DI bf16x8 pack8(const f32x4& a, const f32x4& b) {
  u32x4 p;
  asm volatile("v_cvt_pk_bf16_f32 %0, %4, %5\n\tv_cvt_pk_bf16_f32 %1, %6, %7\n\tv_cvt_pk_bf16_f32 %2, %8, %9\n\tv_cvt_pk_bf16_f32 %3, %10, %11\n\ts_nop 1"
               : "=&v"(p[0]), "=&v"(p[1]), "=&v"(p[2]), "=&v"(p[3])
               : "v"(a[0]), "v"(a[1]), "v"(a[2]), "v"(a[3]), "v"(b[0]), "v"(b[1]), "v"(b[2]), "v"(b[3]));
  return __builtin_bit_cast(bf16x8, p);
}
DI f32x4 mfma16(bf16x8 a, bf16x8 b, f32x4 c) { return __builtin_amdgcn_mfma_f32_16x16x32_bf16(a, b, c, 0, 0, 0); }

DI void sincos_rr(float ang, float& c, float& s) {
  const double rev = (double)ang * 0.15915494309189533577; const float fr = (float)(rev - rint(rev));
  c = __builtin_amdgcn_cosf(fr); s = __builtin_amdgcn_sinf(fr);
}

struct ALin { const bf16_t* A; int lda; int mmax; DI const bf16_t* ptr(int row, int k) const { row = row < mmax ? row : mmax - 1; return A + (size_t)row * lda + k; } };
struct ACmp {
  const bf16_t* proj; int colbase;
  DI const bf16_t* ptr(int m, int k) const { if (m > 2043) m = 2043; int b = m / 1022, rem = m - b * 1022, g = rem / 511, c = rem - g * 511;
    return proj + (size_t)(b * S_ + 16 * c + (k >> 6)) * PW + colbase + g * 64 + (k & 63); } };

template <class AL, class EPI>
DI void gemm_tile(const int tid, const AL al, const bf16_t* __restrict__ Bt, int ldb, int nvalid, int K, int m0, int n0, const EPI epi, char* smem) {
  const int lane = tid & 63, wave = tid >> 6, wr = wave >> 1, wc = wave & 1, g = lane >> 4;
  f32x4 acc[4][4];
#pragma unroll
  for (int i = 0; i < 4; ++i)
#pragma unroll
    for (int j = 0; j < 4; ++j) acc[i][j] = (f32x4){0.f, 0.f, 0.f, 0.f};
  const int srow = wave * 32 + (lane >> 3), sc8 = ((lane & 7) ^ (lane >> 3)) * 8;
  const bf16_t* bp[4];
#pragma unroll
  for (int i = 0; i < 4; ++i) { int r = n0 + srow + 8 * i; r = r < nvalid ? r : nvalid - 1; bp[i] = Bt + (size_t)r * ldb + sc8; }
  const int offA = (wr * 64 + (lane & 15)) * 128 + ((g ^ (lane & 7)) << 4);
  const int offB = (wc * 64 + (lane & 15)) * 128 + ((g ^ (lane & 7)) << 4);
  const int nk = K >> 6;
  auto stage = [&](int kt, int buf) {
    char* da = smem + buf * 32768 + wave * 4096; const int k0 = kt << 6;
#pragma unroll
    for (int i = 0; i < 4; ++i) {
      __builtin_amdgcn_global_load_lds((const unsigned*)al.ptr(m0 + srow + 8 * i, k0 + sc8), LDSP(unsigned, da + i * 1024), 16, 0, 0);
      __builtin_amdgcn_global_load_lds((const unsigned*)(bp[i] + k0), LDSP(unsigned, da + 16384 + i * 1024), 16, 0, 0);
    }
  };
  bf16x8 a0[4], b0[4], a1[4], b1[4];
  auto rd = [&](bf16x8 (&a)[4], bf16x8 (&b)[4], const char* sa, int ks) {
#pragma unroll
    for (int i = 0; i < 4; ++i) { a[i] = *(const bf16x8*)(sa + ((offA + i * 2048) ^ (ks << 6))); b[i] = *(const bf16x8*)(sa + 16384 + ((offB + i * 2048) ^ (ks << 6))); }
  };
  auto mm = [&](const bf16x8 (&a)[4], const bf16x8 (&b)[4]) {
#pragma unroll
    for (int i = 0; i < 4; ++i)
#pragma unroll
      for (int j = 0; j < 4; ++j) acc[i][j] = mfma16(a[i], b[j], acc[i][j]);
  };
  stage(0, 0);
  asm volatile("s_waitcnt vmcnt(0)" ::: "memory");
  __syncthreads();
  if (nk > 1) stage(1, 1);
  rd(a0, b0, smem, 0);
  for (int kt = 0; kt < nk; ++kt) {
    const char* sa = smem + (kt & 1) * 32768;
    rd(a1, b1, sa, 1);
    __builtin_amdgcn_sched_barrier(0);
    mm(a0, b0);
    __builtin_amdgcn_sched_barrier(0);
    asm volatile("s_waitcnt vmcnt(0)" ::: "memory");
    __syncthreads();
    if (kt + 2 < nk) stage(kt + 2, kt & 1);
    if (kt + 1 < nk) rd(a0, b0, smem + ((kt + 1) & 1) * 32768, 0);
    __builtin_amdgcn_sched_barrier(0);
    mm(a1, b1);
    __builtin_amdgcn_sched_barrier(0);
  }
  epi(acc, m0 + wr * 64, n0 + wc * 64, lane);
}

DI void store_plain(bf16_t* dst, int ld, const f32x4 (&acc)[4][4], int row0, int col0, int lane, float sc) {
#pragma unroll
  for (int mi = 0; mi < 4; ++mi)
#pragma unroll
    for (int r = 0; r < 4; ++r) { const int row = row0 + mi * 16 + (lane >> 4) * 4 + r;
#pragma unroll
      for (int ni = 0; ni < 4; ++ni) dst[(size_t)row * ld + col0 + ni * 16 + (lane & 15)] = f2bf(acc[mi][ni][r] * sc); }
}

struct EpiSwiGLU { bf16_t* H;
  DI void operator()(const f32x4 (&acc)[4][4], int row0, int col0, int lane) const {
#pragma unroll
    for (int mi = 0; mi < 4; ++mi)
#pragma unroll
      for (int r = 0; r < 4; ++r) { const int row = row0 + mi * 16 + (lane >> 4) * 4 + r;
#pragma unroll
        for (int pr = 0; pr < 2; ++pr) { const float gt = acc[mi][2 * pr][r], up = acc[mi][2 * pr + 1][r];
          H[(size_t)row * F_ + ((col0 >> 5) + pr) * 16 + (lane & 15)] = f2bf(silu(gt) * up); } }
  } };
struct EpiResid { const float* xin; float* y; float scale;
  DI void operator()(const f32x4 (&acc)[4][4], int row0, int col0, int lane) const {
#pragma unroll
    for (int mi = 0; mi < 4; ++mi)
#pragma unroll
      for (int r = 0; r < 4; ++r) { const int row = row0 + mi * 16 + (lane >> 4) * 4 + r;
#pragma unroll
        for (int ni = 0; ni < 4; ++ni) { const size_t ix = (size_t)row * D_ + col0 + ni * 16 + (lane & 15); y[ix] = ALPHA * xin[ix] + scale * acc[mi][ni][r]; } }
  } };
struct EpiProj { bf16_t* proj; bf16_t* ka; const float* c64; const float* s64; const float* c32; const float* s32;
  DI void operator()(const f32x4 (&acc)[4][4], int row0, int col0, int lane) const {
    const bool rope = (col0 >= C_DQ && col0 < C_DV) || (col0 >= C_NQR && col0 < C_KC) || (col0 >= C_KSL && col0 < C_VSL) || (col0 >= C_KW && col0 < C_VW);
    if (rope) {
#pragma unroll
      for (int mi = 0; mi < 4; ++mi)
#pragma unroll
        for (int r = 0; r < 4; ++r) { const int row = row0 + mi * 16 + (lane >> 4) * 4 + r, pos = row & (S_ - 1);
#pragma unroll
          for (int ni = 0; ni < 2; ++ni) { const int i = ni * 16 + (lane & 15); const float c = c64[pos * 32 + i], s = s64[pos * 32 + i];
            const float x1 = acc[mi][ni][r], x2 = acc[mi][ni + 2][r];
            proj[(size_t)row * PW + col0 + i] = f2bf(x1 * c - x2 * s); proj[(size_t)row * PW + col0 + 32 + i] = f2bf(x1 * s + x2 * c); } }
    } else if (col0 == C_KPE) {
#pragma unroll
      for (int mi = 0; mi < 4; ++mi)
#pragma unroll
        for (int r = 0; r < 4; ++r) { const int row = row0 + mi * 16 + (lane >> 4) * 4 + r, pos = row & (S_ - 1); const int i = lane & 15;
          const float c = c32[pos * 16 + i], s = s32[pos * 16 + i]; const float x1 = acc[mi][0][r], x2 = acc[mi][1][r];
          const bf16_t o1 = f2bf(x1 * c - x2 * s), o2 = f2bf(x1 * s + x2 * c);
#pragma unroll
          for (int h = 0; h < 4; ++h) { ka[(size_t)row * 384 + h * 96 + 64 + i] = o1; ka[(size_t)row * 384 + h * 96 + 80 + i] = o2; }
#pragma unroll
          for (int ni = 2; ni < 4; ++ni) { const float v = acc[mi][ni][r]; proj[(size_t)row * PW + col0 + ni * 16 + i] = f2bf(1.f / (1.f + __expf(-v))); } }
    } else store_plain(proj, PW, acc, row0, col0, lane, 1.f);
  } };
struct EpiMLAq { bf16_t* qa; const float* rs; int m0; const float* c32; const float* s32;
  DI void operator()(const f32x4 (&acc)[4][4], int row0, int col0, int lane) const {
#pragma unroll
    for (int mi = 0; mi < 4; ++mi)
#pragma unroll
      for (int r = 0; r < 4; ++r) { const int row = row0 + mi * 16 + (lane >> 4) * 4 + r, pos = row & (S_ - 1); const float sc = rs[row - m0]; const int i = lane & 15;
#pragma unroll
        for (int ch = 0; ch < 2; ++ch) { const int gc = col0 + 32 * ch; const float x1 = acc[mi][2 * ch][r] * sc, x2 = acc[mi][2 * ch + 1][r] * sc;
          if (((gc >> 5) % 3) == 2) { const float c = c32[pos * 16 + i], s = s32[pos * 16 + i];
            qa[(size_t)row * 384 + gc + i] = f2bf(x1 * c - x2 * s); qa[(size_t)row * 384 + gc + 16 + i] = f2bf(x1 * s + x2 * c); }
          else { qa[(size_t)row * 384 + gc + i] = f2bf(x1); qa[(size_t)row * 384 + gc + 16 + i] = f2bf(x2); } } }
  } };
struct EpiMLAkv { bf16_t* ka; bf16_t* va; const float* rs; int m0;
  DI void operator()(const f32x4 (&acc)[4][4], int row0, int col0, int lane) const {
    const int h = col0 >> 7, part = (col0 >> 6) & 1;
#pragma unroll
    for (int mi = 0; mi < 4; ++mi)
#pragma unroll
      for (int r = 0; r < 4; ++r) { const int row = row0 + mi * 16 + (lane >> 4) * 4 + r; const float sc = rs[row - m0];
#pragma unroll
        for (int ni = 0; ni < 4; ++ni) { const int j = ni * 16 + (lane & 15); const bf16_t v = f2bf(acc[mi][ni][r] * sc);
          if (part == 0) ka[(size_t)row * 384 + h * 96 + j] = v; else va[(size_t)row * 256 + h * 64 + j] = v; } }
  } };
struct EpiCmp1 { bf16_t* hid; const float* bias;
  DI void operator()(const f32x4 (&acc)[4][4], int row0, int col0, int lane) const {
#pragma unroll
    for (int mi = 0; mi < 4; ++mi)
#pragma unroll
      for (int r = 0; r < 4; ++r) { const int row = row0 + mi * 16 + (lane >> 4) * 4 + r;
#pragma unroll
        for (int ni = 0; ni < 4; ++ni) { const int col = col0 + ni * 16 + (lane & 15); hid[(size_t)row * 256 + col] = f2bf(silu(acc[mi][ni][r] + bias[col])); } }
  } };
struct EpiCmp2 { bf16_t* kc;
  DI void operator()(const f32x4 (&acc)[4][4], int row0, int col0, int lane) const {
    if (col0 >= 64) return;
#pragma unroll
    for (int mi = 0; mi < 4; ++mi)
#pragma unroll
      for (int r = 0; r < 4; ++r) { const int row = row0 + mi * 16 + (lane >> 4) * 4 + r;
        if (row < 2044) {
#pragma unroll
          for (int ni = 0; ni < 4; ++ni) kc[(size_t)row * 64 + col0 + ni * 16 + (lane & 15)] = f2bf(acc[mi][ni][r]); } }
  } };

template <int DQ, int MODE, class OUT>
DI void attn_core(const int tid, const bf16_t* __restrict__ Qb, long qs, const bf16_t* __restrict__ Kb, long kst, const bf16_t* __restrict__ Vb, long vst,
                  int q0, int k0, int kmax, int ntiles, const int* tlist, float sl2, int window,
                  const unsigned* selw, float* impg, bool first_head, float (&m_io)[2], float (&l_io)[2], const OUT out, char* smem) {
  constexpr int NKD = DQ / 32, CPR = DQ / 8, KST = (DQ == 64) ? 128 : 256;
  const int lane = tid & 63, wave = tid >> 6, g = lane >> 4, li = lane & 15;
  bf16x8 qf[2][NKD];
#pragma unroll
  for (int qt = 0; qt < 2; ++qt)
#pragma unroll
    for (int kd = 0; kd < NKD; ++kd) qf[qt][kd] = *(const bf16x8*)(Qb + (long)(q0 + wave * 32 + qt * 16 + li) * qs + kd * 32 + g * 8);
  int qidx[2]; qidx[0] = q0 + wave * 32 + li; qidx[1] = qidx[0] + 16;
  f32x4 o[4][2];
#pragma unroll
  for (int i = 0; i < 4; ++i) { o[i][0] = (f32x4){0.f, 0.f, 0.f, 0.f}; o[i][1] = (f32x4){0.f, 0.f, 0.f, 0.f}; }
  float mrun[2], lrun[2], invl[2], prev3[2];
#pragma unroll
  for (int qt = 0; qt < 2; ++qt) { prev3[qt] = 0.f;
    if (MODE == 3) { mrun[qt] = m_io[qt]; lrun[qt] = 0.f; invl[qt] = l_io[qt] > 0.f ? 1.f / l_io[qt] : 0.f; } else { mrun[qt] = -1e30f; lrun[qt] = 0.f; invl[qt] = 0.f; } }
  constexpr int RPP = 1024 / KST, NKP = 64 / RPP / 4;
  auto stage = [&](int jt, int buf) {
    const int kb = k0 + jt * 64; char* kbuf = smem + buf * 16384; char* vbuf = smem + 32768 + buf * 8192;
#pragma unroll
    for (int i = 0; i < NKP; ++i) { const int pc = wave * NKP + i; const int row = pc * RPP + (DQ == 64 ? (lane >> 3) : (lane >> 4));
      int c = (DQ == 64) ? ((lane & 7) ^ (row & 7)) : ((lane & 15) ^ (row & 7)); if (DQ != 64 && c >= CPR) c = 0;
      int ix = kb + row; ix = ix < 0 ? 0 : (ix > kmax ? kmax : ix);
      __builtin_amdgcn_global_load_lds((const unsigned*)(Kb + (long)ix * kst + c * 8), LDSP(unsigned, kbuf + pc * 1024), 16, 0, 0); }
    if (MODE != 2) {
#pragma unroll
      for (int i = 0; i < 2; ++i) { const int pc = wave * 2 + i; const int row = pc * 8 + (lane >> 3); const int pp = lane & 7;
        const int c = ((((pp >> 1) ^ ((row >> 1) & 3)) << 1) | (pp & 1));
        int ix = kb + row; ix = ix < 0 ? 0 : (ix > kmax ? kmax : ix);
        __builtin_amdgcn_global_load_lds((const unsigned*)(Vb + (long)ix * vst + c * 8), LDSP(unsigned, vbuf + pc * 1024), 16, 0, 0); }
    }
  };
  if (ntiles > 0) stage(tlist ? tlist[0] : 0, 0);
  asm volatile("s_waitcnt vmcnt(0)" ::: "memory");
  __syncthreads();
  for (int it = 0; it < ntiles; ++it) {
    const int jt = tlist ? tlist[it] : it;
    const bool more = it + 1 < ntiles;
    if (more) stage(tlist ? tlist[it + 1] : it + 1, (it + 1) & 1);
    const char* kbuf = smem + (it & 1) * 16384; const char* vbuf = smem + 32768 + (it & 1) * 8192;
    f32x4 st[4][2];
#pragma unroll
    for (int kt4 = 0; kt4 < 4; ++kt4) {
      bf16x8 kf[NKD]; const int row = kt4 * 16 + li;
#pragma unroll
      for (int kd = 0; kd < NKD; ++kd) kf[kd] = *(const bf16x8*)(kbuf + row * KST + (((kd * 4 + g) ^ (row & 7)) << 4));
#pragma unroll
      for (int qt = 0; qt < 2; ++qt) { f32x4 a = (f32x4){0.f, 0.f, 0.f, 0.f};
#pragma unroll
        for (int kd = 0; kd < NKD; ++kd) a = mfma16(kf[kd], qf[qt][kd], a);
        st[kt4][qt] = a; }
    }
    const int kbase = k0 + jt * 64;
    bool sb[2] = {true, true};
    if (MODE == 4) { sb[0] = (selw[(wave * 32 + li) * 4 + (jt >> 5)] >> (jt & 31)) & 1u; sb[1] = (selw[(wave * 32 + 16 + li) * 4 + (jt >> 5)] >> (jt & 31)) & 1u; }
    float alpha[2];
#pragma unroll
    for (int qt = 0; qt < 2; ++qt) {
      float mx = -3e38f;
#pragma unroll
      for (int kt4 = 0; kt4 < 4; ++kt4)
#pragma unroll
        for (int r = 0; r < 4; ++r) { const int kidx = kbase + kt4 * 16 + g * 4 + r; bool v;
          if (MODE == 0) v = kidx <= qidx[qt];
          else if (MODE == 1) v = (kidx >= 0) && (kidx <= qidx[qt]) && (qidx[qt] - kidx <= window);
          else if (MODE == 2 || MODE == 3) v = (kidx <= kmax) && (16 * kidx + 31 <= qidx[qt]);
          else v = (kidx <= qidx[qt]) && sb[qt];
          const float sr = v ? st[kt4][qt][r] : -3e38f; st[kt4][qt][r] = sr; mx = fmaxf(mx, sr); }
      if (MODE != 3) {
        mx = fmaxf(mx, __shfl_xor(mx, 16)); mx = fmaxf(mx, __shfl_xor(mx, 32));
        const float mn = fmaxf(mrun[qt], mx * sl2); alpha[qt] = fast_exp2(mrun[qt] - mn); mrun[qt] = mn;
      } else alpha[qt] = 1.f;
      float ls = 0.f; const float nm = -mrun[qt];
#pragma unroll
      for (int kt4 = 0; kt4 < 4; ++kt4)
#pragma unroll
        for (int r = 0; r < 4; ++r) { float p = fast_exp2(fmaf(st[kt4][qt][r], sl2, nm)); if (MODE == 3) p *= invl[qt]; st[kt4][qt][r] = p; ls += p; }
      lrun[qt] = lrun[qt] * alpha[qt] + ls;
    }
    if (MODE == 3) {
#pragma unroll
      for (int qt = 0; qt < 2; ++qt)
#pragma unroll
        for (int kt4 = 0; kt4 < 4; ++kt4) { const float p3 = st[kt4][qt][3]; const float a = (st[kt4][qt][0] + st[kt4][qt][1]) + (st[kt4][qt][2] + p3);
          const float give = (g == 3) ? prev3[qt] : p3; const float up = __shfl(give, (lane + 48) & 63); prev3[qt] = p3;
          float* ip = impg + (size_t)(wave * 32 + qt * 16 + li) * 128 + jt * 16 + kt4 * 4 + g; const float val = a + up;
          if (first_head) *ip = val; else *ip += val; }
    }
    if (MODE != 2) {
      if (MODE != 3) {
#pragma unroll
        for (int dt = 0; dt < 4; ++dt) { o[dt][0] *= alpha[0]; o[dt][1] *= alpha[1]; }
      }
#pragma unroll
      for (int ks2 = 0; ks2 < 2; ++ks2) {
        bf16x8 pf[2];
#pragma unroll
        for (int qt = 0; qt < 2; ++qt) pf[qt] = pack8(st[2 * ks2][qt], st[2 * ks2 + 1][qt]);
        const int rowA = 32 * ks2 + 4 * g + (li >> 2), p_ = li & 3;
#pragma unroll
        for (int dt = 0; dt < 4; ++dt) {
          const int off = rowA * 128 + ((((dt ^ ((rowA >> 1) & 3)) << 1) | (p_ >> 1)) << 4) + 8 * (p_ & 1);
          const s16x4 lo = __builtin_amdgcn_ds_read_tr16_b64_v4i16(LDSP(s16x4, vbuf + off));
          const s16x4 hi = __builtin_amdgcn_ds_read_tr16_b64_v4i16(LDSP(s16x4, vbuf + off + 2048));
          const bf16x8 vf = __builtin_shufflevector(lo, hi, 0, 1, 2, 3, 4, 5, 6, 7);
          o[dt][0] = mfma16(vf, pf[0], o[dt][0]); o[dt][1] = mfma16(vf, pf[1], o[dt][1]);
        }
      }
    }
    asm volatile("s_waitcnt vmcnt(0)" ::: "memory");
    __syncthreads();
  }
#pragma unroll
  for (int qt = 0; qt < 2; ++qt) {
    float lt = lrun[qt]; lt += __shfl_xor(lt, 16); lt += __shfl_xor(lt, 32);
    if (MODE == 2) { m_io[qt] = mrun[qt]; l_io[qt] = lt; }
    else {
      const float inv = (MODE == 3) ? 1.f : (lt > 0.f ? 1.f / lt : 0.f);
#pragma unroll
      for (int dt = 0; dt < 4; ++dt) out(wave * 32 + qt * 16 + li, dt * 16 + g * 4, o[dt][qt] * inv, mrun[qt], lt);
    }
  }
}

struct OutSet { bf16_t* dst; long ld; const bf16_t* gate; long gld; float* lse; long lld;
  DI void operator()(int ql, int d0, f32x4 v, float m, float l) const {
    float gs = 1.f; if (gate) gs = bf2f(gate[ql * gld]);
    u32x2 w; w[0] = pk2(v[0] * gs, v[1] * gs); w[1] = pk2(v[2] * gs, v[3] * gs); *(u32x2*)(dst + ql * ld + d0) = w;
    if (lse && d0 == 0) lse[ql * lld] = (m + __log2f(l)) * 0.69314718056f;
  } };
struct OutAdd { bf16_t* dst; long ld; const bf16_t* gate; long gld;
  DI void operator()(int ql, int d0, f32x4 v, float m, float l) const {
    const float gs = bf2f(gate[ql * gld]); u32x2* p = (u32x2*)(dst + ql * ld + d0); const u32x2 old = *p;
    u32x2 w; w[0] = pk2(__uint_as_float(old[0] << 16) + v[0] * gs, __uint_as_float(old[0] & 0xffff0000u) + v[1] * gs);
    w[1] = pk2(__uint_as_float(old[1] << 16) + v[2] * gs, __uint_as_float(old[1] & 0xffff0000u) + v[3] * gs); *p = w;
  } };

DI bf16_t* lw(char* ws, int l, size_t off) { return (bf16_t*)(ws + OFF_W + (size_t)l * LW_SIZE + off); }

DI int colmap(int map, int n, int nsrc) {
  if (map == 0) return n < nsrc ? n : -1;
  if (map == 1) { const int t = n >> 5, i = n & 31; return i < 16 ? 16 * t + i : 2816 + 16 * t + (i - 16); }
  if (n < 384) return n;
  if (n < C_DV + 384) return 416 + (n - C_DQ);
  if (n < C_NQR) return 1568 + (n - C_NQ);
  if (n < C_KC) return 1568 + (n - C_NQR);
  if (n < C_KPE) return 1952 + (n - C_KC);
  if (n < C_GL) return 384 + (n - C_KPE);
  if (n < C_GL + 18) return 2720 + (n - C_GL);
  return -1;
}

DI void convert_wtile(const Params& P, const int tid, int t, char* smem) {
      int di = 0;
#pragma unroll 1
      for (int i = 1; i < 24; ++i) if (t >= P.wd[i].tile0) di = i;
      const WDesc d = P.wd[di]; const int lt = t - d.tile0, tn = lt % d.ntn, tk = lt / d.ntn, n0 = tn * 64, k0 = tk * 128;
      float* tile = (float*)smem;
      const int nn = tid & 63; const int sc = colmap(d.map, n0 + nn, d.Nsrc);
      float v[32];
#pragma unroll
      for (int i = 0; i < 32; ++i) { const int kk = (tid >> 6) + 4 * i; v[i] = (sc >= 0) ? d.src[(size_t)(k0 + kk) * d.Nsrc + sc] : 0.f; }
      if (d.kscale) {
#pragma unroll
        for (int i = 0; i < 32; ++i) v[i] *= d.kscale[k0 + (tid >> 6) + 4 * i];
      }
#pragma unroll
      for (int i = 0; i < 32; ++i) tile[((tid >> 6) + 4 * i) * 65 + nn] = v[i];
      __syncthreads();
      { const int on = tid >> 2, kq = tid & 3;
        bf16_t* dp = d.dst + (size_t)(n0 + on) * d.K + k0 + kq * 32;
#pragma unroll
        for (int c = 0; c < 4; ++c) { u32x4 w;
#pragma unroll
          for (int j = 0; j < 4; ++j) w[j] = pk2(tile[(kq * 32 + c * 8 + 2 * j) * 65 + on], tile[(kq * 32 + c * 8 + 2 * j + 1) * 65 + on]);
          *(u32x4*)(dp + c * 8) = w; } }
      __syncthreads();
}

DI void phase_prologue(const Params& P, const Ctx& p, char* smem) {
  const int tid = p.tid;
  const int n_w = P.n_early, n_cb = 4, n_r64 = 256, n_r32 = 128, n_xb = 1024;
  const int total = n_w + n_cb + n_r64 + n_r32 + n_xb;
  for (int t = blockIdx.x; t < total; t += gridDim.x) {
    if (t < n_w) { convert_wtile(P, tid, t, smem);
    } else if (t < n_w + n_cb) {
      const int id = t - n_w; const float* pos = p.cmp_pos + (size_t)id * 2048; const float* w1 = p.cmp_w1 + (size_t)id * 2048 * 256; float a = 0.f;
      for (int k = 0; k < 2048; ++k) a += pos[k] * w1[(size_t)k * 256 + tid];
      ((float*)(p.ws + OFF_CBIAS))[id * 256 + tid] = a;
    } else if (t < n_w + n_cb + n_r64) {
      const int e0 = (t - n_w - n_cb) * 1024; float* C = (float*)(p.ws + OFF_C64); float* Sn = (float*)(p.ws + OFF_S64);
      for (int e = e0 + tid; e < e0 + 1024; e += 256) { const int pos = e >> 5, i = e & 31; const float inv = exp2f(-(float)(2 * i) / 64.f * 13.287712379549449f); const float ang = (float)pos * inv;
        sincos_rr(ang, C[e], Sn[e]); }
    } else if (t < n_w + n_cb + n_r64 + n_r32) {
      const int e0 = (t - n_w - n_cb - n_r64) * 1024; float* C = (float*)(p.ws + OFF_C32); float* Sn = (float*)(p.ws + OFF_S32);
      for (int e = e0 + tid; e < e0 + 1024; e += 256) { const int pos = e >> 4, i = e & 15; const float inv = exp2f(-(float)(2 * i) / 32.f * 13.287712379549449f); const float ang = (float)pos * inv;
        sincos_rr(ang, C[e], Sn[e]); }
    } else {
      const size_t e0 = (size_t)(t - n_w - n_cb - n_r64 - n_r32) * 16384 + tid * 8; bf16_t* xb = (bf16_t*)(p.ws + OFF_XB);
      f32x4 a[8], b[8];
#pragma unroll
      for (int i = 0; i < 8; ++i) { a[i] = *(const f32x4*)(p.x + e0 + i * 2048); b[i] = *(const f32x4*)(p.x + e0 + i * 2048 + 4); }
#pragma unroll
      for (int i = 0; i < 8; ++i) { u32x4 w; w[0] = pk2(a[i][0], a[i][1]); w[1] = pk2(a[i][2], a[i][3]); w[2] = pk2(b[i][0], b[i][1]); w[3] = pk2(b[i][2], b[i][3]);
        *(u32x4*)(xb + e0 + i * 2048) = w; }
    }
  }
}

DI bool tile_seq(int k, int NT, int total, int& mt, int& nt) {
  const int G = gridDim.x, b = blockIdx.x; const int s = k * G + (b & 7) * (G >> 3) + (b >> 3);
  if (s >= total) return false;
  const int band = s / (16 * NT), r = s - band * 16 * NT; nt = r >> 4; mt = band * 16 + (r & 15); return true;
}
DI void phase_ffn_up(const Ctx& p, int l, int j, char* smem) {
  const ALin al{(const bf16_t*)(p.ws + OFF_XB), D_, T_}; const bf16_t* Bt = lw(p.ws, l, LW_FIN + j * SZ_FIN); const EpiSwiGLU epi{(bf16_t*)(p.ws + OFF_BIG)};
  for (int k = 0;; ++k) { int mt, nt; if (!tile_seq(k, 44, 128 * 44, mt, nt)) break; gemm_tile(p.tid, al, Bt, D_, 5632, D_, mt * 128, nt * 128, epi, smem); }
}
DI void phase_ffn_down(const Ctx& p, int l, int j, char* smem) {
  const ALin al{(const bf16_t*)(p.ws + OFF_BIG), F_, T_}; const bf16_t* Bt = lw(p.ws, l, LW_FOUT + j * SZ_FOUT);
  const EpiResid epi{(l == 0 && j == 0) ? p.x : p.out, p.out, 0.5f};
  for (int k = 0;; ++k) { int mt, nt; if (!tile_seq(k, 8, 128 * 8, mt, nt)) break; gemm_tile(p.tid, al, Bt, F_, D_, F_, mt * 128, nt * 128, epi, smem); }
}
DI void phase_wout(const Ctx& p, int l, char* smem) {
  const ALin al{(const bf16_t*)(p.ws + OFF_XB), D_, T_}; const bf16_t* Bt = lw(p.ws, l, LW_WOUT); const EpiResid epi{p.out, p.out, 1.0f};
  for (int k = 0;; ++k) { int mt, nt; if (!tile_seq(k, 8, 128 * 8, mt, nt)) break; gemm_tile(p.tid, al, Bt, D_, D_, D_, mt * 128, nt * 128, epi, smem); }
}
DI void phase_ln(const Ctx& p, int l, int j, bool zero_o) {
  const int lane = p.tid & 63, wave = p.tid >> 6; const float* gp = p.ln_g + (size_t)(l * 3 + j) * D_; const float* bp = p.ln_b + (size_t)(l * 3 + j) * D_;
  bf16_t* xb = (bf16_t*)(p.ws + OFF_XB);
  for (int t = blockIdx.x; t < T_ / 8; t += gridDim.x) {
    const int row = t * 8 + wave * 2; float* yr = p.out + (size_t)row * D_; f32x4 v[2][4]; float s[2] = {0.f, 0.f};
#pragma unroll
    for (int r = 0; r < 2; ++r)
#pragma unroll
      for (int i = 0; i < 4; ++i) v[r][i] = *(const f32x4*)(yr + r * D_ + i * 256 + lane * 4);
#pragma unroll
    for (int r = 0; r < 2; ++r) {
#pragma unroll
      for (int i = 0; i < 4; ++i) s[r] += (v[r][i][0] + v[r][i][1]) + (v[r][i][2] + v[r][i][3]);
#pragma unroll
      for (int o = 1; o < 64; o <<= 1) s[r] += __shfl_xor(s[r], o);
    }
#pragma unroll
    for (int r = 0; r < 2; ++r) {
      const float mu = s[r] * (1.f / D_); float q = 0.f;
#pragma unroll
      for (int i = 0; i < 4; ++i)
#pragma unroll
        for (int e = 0; e < 4; ++e) { const float d = v[r][i][e] - mu; q += d * d; }
#pragma unroll
      for (int o = 1; o < 64; o <<= 1) q += __shfl_xor(q, o);
      const float rstd = rsqrtf(q * (1.f / D_) + 1e-5f);
#pragma unroll
      for (int i = 0; i < 4; ++i) { const int c = i * 256 + lane * 4; const f32x4 gg = *(const f32x4*)(gp + c), bb = *(const f32x4*)(bp + c); f32x4 o4;
#pragma unroll
        for (int e = 0; e < 4; ++e) o4[e] = (v[r][i][e] - mu) * rstd * gg[e] + bb[e];
        *(f32x4*)(yr + r * D_ + c) = o4; u32x2 w; w[0] = pk2(o4[0], o4[1]); w[1] = pk2(o4[2], o4[3]); *(u32x2*)(xb + (size_t)(row + r) * D_ + c) = w; }
    }
  }
}
DI void phase_win(const Ctx& p, int l, char* smem) {
  const ALin al{(const bf16_t*)(p.ws + OFF_XB), D_, T_}; const bf16_t* Bt = lw(p.ws, l, LW_WIN);
  const EpiProj epi{(bf16_t*)(p.ws + OFF_BIG), (bf16_t*)(p.ws + OFF_KA), (const float*)(p.ws + OFF_C64), (const float*)(p.ws + OFF_S64), (const float*)(p.ws + OFF_C32), (const float*)(p.ws + OFF_S32)};
  for (int k = 0;; ++k) { int mt, nt; if (!tile_seq(k, 25, 128 * 25, mt, nt)) break; gemm_tile(p.tid, al, Bt, D_, PW, D_, mt * 128, nt * 128, epi, smem); }
}

DI int next_item(const int tid, unsigned* ctr, char* smem) {
  int* slot = (int*)(smem + 69632 - 16);
  __syncthreads();
  if (tid == 0) *slot = (int)atomicAdd(ctr, 1u);
  __syncthreads();
  return *slot;
}

DI void item_dilated(const Ctx& p, int id, char* smem) {
  const int pat = id / 768, r1 = id % 768, b = r1 / 384, r2 = r1 % 384, h = r2 >> 6, blk = r2 & 63;
  const int dil = pat == 0 ? 1 : (pat == 1 ? 4 : 16), nsub = 64 / dil, rho = blk / nsub, i = blk % nsub;
  const bf16_t* proj = (const bf16_t*)(p.ws + OFF_BIG); const bf16_t* base = proj + (size_t)(b * S_ + rho) * PW; const long rs = (long)dil * PW;
  bf16_t* dst = (bf16_t*)(p.ws + OFF_DILO) + ((size_t)pat * T_ + b * S_ + rho + (size_t)dil * 128 * i) * 384 + h * 64;
  float* lse = (float*)(p.ws + OFF_DILL) + ((size_t)pat * T_ + b * S_ + rho + (size_t)dil * 128 * i) * 6 + h;
  const OutSet out{dst, (long)dil * 384, nullptr, 0, lse, (long)dil * 6}; float mm[2], ll[2];
  attn_core<64, 1>(p.tid, base + C_DQ + h * 64, rs, base + C_DK + h * 64, rs, base + C_DV + h * 64, rs, 128 * i, 128 * i - 128, S_ / dil - 1, 4, nullptr,
                   0.125f * 1.44269504089f, 128, nullptr, nullptr, false, mm, ll, out, smem);
}
DI void item_nsawin(const Ctx& p, int id, char* smem) {
  const int b = id / 384, r = id % 384, h = r >> 6, i = r & 63, g = h / 3;
  const bf16_t* proj = (const bf16_t*)(p.ws + OFF_BIG); const bf16_t* base = proj + (size_t)(b * S_) * PW;
  bf16_t* o = (bf16_t*)(p.ws + OFF_XB) + (size_t)(b * S_ + 128 * i) * D_ + 640 + h * 64;
  const OutSet out{o, D_, base + (size_t)(128 * i) * PW + C_GL + h * 3 + 2, PW, nullptr, 0}; float mm[2], ll[2];
  attn_core<64, 1>(p.tid, base + C_NQR + h * 64, PW, base + C_KW + g * 64, PW, base + C_VW + g * 64, PW, 128 * i, 128 * i - 512, S_ - 1, 10, nullptr,
                   0.125f * 1.44269504089f, 512, nullptr, nullptr, false, mm, ll, out, smem);
}
DI void item_expand(const Ctx& p, int l, int id, char* smem) {
  const bf16_t* proj = (const bf16_t*)(p.ws + OFF_BIG); float* rs = (float*)(smem + 65536);
  const bool isq = id < 384; const int lid = isq ? id : id - 384; const int mt = isq ? lid / 3 : lid >> 2, nt = isq ? lid % 3 : lid & 3;
  const int K = isq ? 256 : 128, cb = isq ? C_CQ : C_CKV, tid = p.tid;
  { const int row = tid >> 1, half = tid & 1; const bf16_t* rp = proj + (size_t)(mt * 128 + row) * PW + cb + half * (K / 2); float ss = 0.f;
    for (int c = 0; c < K / 2; c += 8) { const u32x4 w = *(const u32x4*)(rp + c);
#pragma unroll
      for (int e = 0; e < 4; ++e) { const float a = __uint_as_float(w[e] << 16), b2 = __uint_as_float(w[e] & 0xffff0000u); ss += a * a + b2 * b2; } }
    ss += __shfl_xor(ss, 1); if (half == 0) rs[row] = rsqrtf(ss / (float)K + 1e-6f); }
  __syncthreads();
  const ALin al{proj + cb, PW, T_};
  if (isq) { const EpiMLAq epi{(bf16_t*)(p.ws + OFF_QA), rs, mt * 128, (const float*)(p.ws + OFF_C32), (const float*)(p.ws + OFF_S32)};
    gemm_tile(p.tid, al, lw(p.ws, l, LW_UQ), 256, 384, 256, mt * 128, nt * 128, epi, smem); }
  else { const EpiMLAkv epi{(bf16_t*)(p.ws + OFF_KA), (bf16_t*)(p.ws + OFF_VA), rs, mt * 128};
    gemm_tile(p.tid, al, lw(p.ws, l, LW_UKV), 128, 512, 128, mt * 128, nt * 128, epi, smem); }
}
DI void item_cmp(const Ctx& p, int l, int id, char* smem) {
  const int kv = id >> 4, mt = id & 15; const ACmp al1{(const bf16_t*)(p.ws + OFF_BIG), kv ? C_VC : C_KC};
  bf16_t* hid = (bf16_t*)(p.ws + OFF_CHID) + (size_t)kv * 2048 * 256;
  const EpiCmp1 epi1{hid, (const float*)(p.ws + OFF_CBIAS) + (l * 2 + kv) * 256};
#pragma unroll 1
  for (int nt = 0; nt < 2; ++nt) gemm_tile(p.tid, al1, lw(p.ws, l, LW_C1 + kv * SZ_C1), 2048, 256, 2048, mt * 128, nt * 128, epi1, smem);
  asm volatile("s_waitcnt vmcnt(0)" ::: "memory");
  __syncthreads();
  const ALin al2{hid, 256, 2048}; const EpiCmp2 epi2{(bf16_t*)(p.ws + OFF_KCVC) + (size_t)kv * 2048 * 64};
  int t2 = p.tid; asm volatile("" : "+v"(t2));
  gemm_tile(t2, al2, lw(p.ws, l, LW_C2 + kv * SZ_C2), 256, 64, 256, mt * 128, 0, epi2, smem);
}
DI void item_mla(const Ctx& p, int id, char* smem) {
  const int i = 63 - (id >> 3), bh = id & 7, b = bh >> 2, h = bh & 3;
  const bf16_t* qa = (const bf16_t*)(p.ws + OFF_QA) + (size_t)(b * S_) * 384 + h * 96; const bf16_t* ka = (const bf16_t*)(p.ws + OFF_KA) + (size_t)(b * S_) * 384 + h * 96;
  const bf16_t* va = (const bf16_t*)(p.ws + OFF_VA) + (size_t)(b * S_) * 256 + h * 64;
  bf16_t* o = (bf16_t*)(p.ws + OFF_XB) + (size_t)(b * S_ + 128 * i) * D_ + h * 64; const OutSet out{o, D_, nullptr, 0, nullptr, 0}; float mm[2], ll[2];
  attn_core<96, 0>(p.tid, qa, 384, ka, 384, va, 256, 128 * i, 0, S_ - 1, 2 * (i + 1), nullptr, 0.10206207261f * 1.44269504089f, 0, nullptr, nullptr, false, mm, ll, out, smem);
}
DI void item_nsacmp(const Ctx& p, int id, char* smem) {
  const int i = 63 - (id >> 2), bg = id & 3, b = bg >> 1, g = bg & 1, tid = p.tid;
  const bf16_t* proj = (const bf16_t*)(p.ws + OFF_BIG); const bf16_t* base = proj + (size_t)(b * S_) * PW;
  const bf16_t* kc = (const bf16_t*)(p.ws + OFF_KCVC) + (size_t)((b * 2 + g) * NCMP) * 64; const bf16_t* vc = kc + (size_t)2048 * 64;
  float* imp = (float*)(p.ws + OFF_IMP) + ((size_t)((b * 2 + g) * S_) + 128 * i) * 128;
  const int nkt = (i + 8) >> 3;
#pragma unroll 1
  for (int hh = 0; hh < 3; ++hh) { const int h = g * 3 + hh; float mm[2], ll[2];
    bf16_t* o = (bf16_t*)(p.ws + OFF_XB) + (size_t)(b * S_ + 128 * i) * D_ + 640 + h * 64;
    const OutAdd out{o, D_, base + (size_t)(128 * i) * PW + C_GL + h * 3 + 0, PW};
    attn_core<64, 2>(p.tid, base + C_NQ + h * 64, PW, kc, 64, vc, 64, 128 * i, 0, NCMP - 1, nkt, nullptr, 0.125f * 1.44269504089f, 0, nullptr, nullptr, false, mm, ll, out, smem);
    attn_core<64, 3>(p.tid, base + C_NQ + h * 64, PW, kc, 64, vc, 64, 128 * i, 0, NCMP - 1, nkt, nullptr, 0.125f * 1.44269504089f, 0, nullptr, imp, hh == 0, mm, ll, out, smem);
  }
  __syncthreads();
  float* sc = (float*)smem;
  const int q = tid >> 1, half = tid & 1, qpos = 128 * i + q, cur = qpos >> 6;
#pragma unroll 2
  for (int j = half * 64; j < half * 64 + 64; ++j) { const float v = (j < nkt * 16) ? imp[(size_t)q * 128 + j] : 0.f; const bool forced = (j == 0) || (j == cur) || (j == cur - 1);
    sc[q * 129 + j] = forced ? 1e4f : (j <= cur ? v : -1e4f); }
  unsigned m0 = 0, m1 = 0, m2 = 0, m3 = 0;
#pragma unroll 1
  for (int rd = 0; rd < 16; ++rd) {
    float bv = -3e38f; int bj = half * 64;
#pragma unroll 4
    for (int j = half * 64; j < half * 64 + 64; ++j) { const float v = sc[q * 129 + j]; if (v > bv) { bv = v; bj = j; } }
    const float ov = __shfl_xor(bv, 1); const int oj = __shfl_xor(bj, 1);
    if (ov > bv || (ov == bv && oj < bj)) { bv = ov; bj = oj; }
    if ((bj >> 6) == half) sc[q * 129 + bj] = -3.2e38f;
    if (bj <= cur) { const unsigned bit = 1u << (bj & 31); const int w = bj >> 5; m0 |= (w == 0) ? bit : 0u; m1 |= (w == 1) ? bit : 0u; m2 |= (w == 2) ? bit : 0u; m3 |= (w == 3) ? bit : 0u; }
  }
  if (half == 0) { u32x4 w; w[0] = m0; w[1] = m1; w[2] = m2; w[3] = m3; *(u32x4*)((unsigned*)(p.ws + OFF_SEL) + ((size_t)(b * S_ + qpos) * 2 + g) * 4) = w; }
  __syncthreads();
}
DI void item_dilcombine(const Ctx& p, int id) {
  const size_t e = (size_t)id * 256 + p.tid; const int tok = (int)(e / 48), r = (int)(e % 48), h = r >> 3, d0 = (r & 7) * 8;
  const float* L = (const float*)(p.ws + OFF_DILL); const bf16_t* O = (const bf16_t*)(p.ws + OFF_DILO);
  const float l0 = L[(size_t)tok * 6 + h], l1 = L[((size_t)T_ + tok) * 6 + h], l2 = L[((size_t)2 * T_ + tok) * 6 + h]; const float mx = fmaxf(l0, fmaxf(l1, l2));
  float w0 = __expf(l0 - mx), w1 = __expf(l1 - mx), w2 = __expf(l2 - mx); const float inv = 1.f / (w0 + w1 + w2); w0 *= inv; w1 *= inv; w2 *= inv;
  const u32x4 a = *(const u32x4*)(O + (size_t)tok * 384 + h * 64 + d0), b = *(const u32x4*)(O + ((size_t)T_ + tok) * 384 + h * 64 + d0), c = *(const u32x4*)(O + ((size_t)2 * T_ + tok) * 384 + h * 64 + d0);
  u32x4 w;
#pragma unroll
  for (int k = 0; k < 4; ++k) { const float lo = w0 * __uint_as_float(a[k] << 16) + w1 * __uint_as_float(b[k] << 16) + w2 * __uint_as_float(c[k] << 16);
    const float hi = w0 * __uint_as_float(a[k] & 0xffff0000u) + w1 * __uint_as_float(b[k] & 0xffff0000u) + w2 * __uint_as_float(c[k] & 0xffff0000u); w[k] = pk2(lo, hi); }
  *(u32x4*)((bf16_t*)(p.ws + OFF_XB) + (size_t)tok * D_ + 256 + h * 64 + d0) = w;
}
DI void item_nsaslc(const Ctx& p, int id, char* smem) {
  const int i = 63 - id / 12, r = id % 12, b = r / 6, h = r % 6, g = h / 3, tid = p.tid;
  const bf16_t* proj = (const bf16_t*)(p.ws + OFF_BIG); const bf16_t* base = proj + (size_t)(b * S_) * PW;
  unsigned* selw = (unsigned*)(smem + 49152 + 2048); int* tlist = (int*)(smem + 49152); unsigned* un = (unsigned*)(smem + 49152 + 1024);
  __syncthreads();
  if (tid < 4) un[tid] = 0u;
  __syncthreads();
  if (tid < 128) { const u32x4 w = *(const u32x4*)((const unsigned*)(p.ws + OFF_SEL) + ((size_t)(b * S_ + 128 * i + tid) * 2 + g) * 4);
    selw[tid * 4 + 0] = w[0]; selw[tid * 4 + 1] = w[1]; selw[tid * 4 + 2] = w[2]; selw[tid * 4 + 3] = w[3];
    atomicOr(&un[0], w[0]); atomicOr(&un[1], w[1]); atomicOr(&un[2], w[2]); atomicOr(&un[3], w[3]); }
  __syncthreads();
  if (tid == 0) { int n = 0; for (int jt = 0; jt < 2 * (i + 1); ++jt) if ((un[jt >> 5] >> (jt & 31)) & 1u) tlist[n++] = jt; tlist[255] = n; }
  __syncthreads();
  const int nt = tlist[255];
  bf16_t* o = (bf16_t*)(p.ws + OFF_XB) + (size_t)(b * S_ + 128 * i) * D_ + 640 + h * 64;
  const OutAdd out{o, D_, base + (size_t)(128 * i) * PW + C_GL + h * 3 + 1, PW}; float mm[2], ll[2];
  attn_core<64, 4>(p.tid, base + C_NQR + h * 64, PW, base + C_KSL + g * 64, PW, base + C_VSL + g * 64, PW, 128 * i, 0, S_ - 1, nt, tlist, 0.125f * 1.44269504089f, 0, selw, nullptr, false, mm, ll, out, smem);
}

DI void phase_mix_a(const Params& P, const Ctx& p0, int l, char* smem, int ci, int f0, int f1) {
  unsigned* ctr = (unsigned*)(p0.ws + OFF_CTRL) + l * 8 + ci; const int total = 32 + 768 + 2304 + 896;
  for (;;) { Ctx q = p0; asm volatile("" : "+v"(q.tid)); asm volatile("" : "+v"(q.ws)); const Ctx& p = q; const int t = next_item(p.tid, ctr, smem);
    if (t >= total) { if (t - total < f1 - f0) { convert_wtile(P, p.tid, f0 + t - total, smem); continue; } break; }
    if (t < 32) item_cmp(p, l, t, smem); else if (t < 32 + 768) item_nsawin(p, t - 32, smem); else if (t < 32 + 768 + 2304) item_dilated(p, t - 32 - 768, smem);
    else item_expand(p, l, t - 32 - 768 - 2304, smem); }
}
DI void phase_mix_b(const Params& P, const Ctx& p0, int l, char* smem, int ci, int f0, int f1) {
  unsigned* ctr = (unsigned*)(p0.ws + OFF_CTRL) + l * 8 + ci; const int total = 512 + 256 + 3072;
  for (;;) { Ctx q = p0; asm volatile("" : "+v"(q.tid)); asm volatile("" : "+v"(q.ws)); const Ctx& p = q; const int t = next_item(p.tid, ctr, smem);
    if (t >= total) { if (t - total < f1 - f0) { convert_wtile(P, p.tid, f0 + t - total, smem); continue; } break; }
    if (t < 512) item_mla(p, t, smem);
    else if (t < 512 + 256) item_nsacmp(p, t - 512, smem); else item_dilcombine(p, t - 512 - 256); }
}
DI void phase_mix_d(const Params& P, const Ctx& p0, int l, char* smem, int f0, int f1) {
  unsigned* ctr = (unsigned*)(p0.ws + OFF_CTRL) + l * 8 + 3; const int total = 768;
  for (;;) { Ctx q = p0; asm volatile("" : "+v"(q.tid)); asm volatile("" : "+v"(q.ws)); const Ctx& p = q; const int t = next_item(p.tid, ctr, smem);
    if (t >= total) { if (t - total < f1 - f0) { convert_wtile(P, p.tid, f0 + t - total, smem); continue; } break; }
    item_nsaslc(p, t, smem); }
}
DI void phase_zero_o(const Ctx& p) {
  u32x4* o = (u32x4*)(p.ws + OFF_XB); const u32x4 z = (u32x4){0u, 0u, 0u, 0u};
  for (size_t e = (size_t)blockIdx.x * 256 + p.tid; e < (size_t)T_ * D_ / 8; e += (size_t)gridDim.x * 256) o[e] = z;
}

DI void run_phase(const Params& P, int ph, char* smem) {
  Ctx p; p.x = P.x; p.ln_g = P.ln_g; p.ln_b = P.ln_b; p.cmp_pos = P.cmp_pos; p.cmp_w1 = P.cmp_w1; p.out = P.out; p.ws = P.ws; p.tid = threadIdx.x;
  asm volatile("" : "+v"(p.tid));
  if (ph == 0) { phase_prologue(P, p, smem); return; }
  const int l = (ph - 1) / 12; int s = (ph - 1) % 12;
#ifdef ONLY_S
  if (s != ONLY_S) return;
  s = ONLY_S;
#endif
  switch (s) {
    case 0: phase_ffn_up(p, l, 0, smem); break;
    case 1: phase_ffn_down(p, l, 0, smem); break;
    case 2: phase_ln(p, l, 0, false); break;
#if ENABLE_MIX
    case 3: phase_win(p, l, smem); break;
    case 4: { const int nl = P.n_wtiles - P.n_early, a = P.n_early, b = a + (l == 0 ? nl / 3 : 0); phase_mix_a(P, p, l, smem, 0, a, b); } break;
    case 5: { const int nl = P.n_wtiles - P.n_early, a = P.n_early + nl / 3, b = a + (l == 0 ? nl / 3 : 0); phase_mix_b(P, p, l, smem, 1, a, b); } break;
    case 6: { const int nl = P.n_wtiles - P.n_early, a = P.n_early + 2 * (nl / 3), b = (l == 0 ? P.n_wtiles : a); phase_mix_d(P, p, l, smem, a, b); } break;
#else
    case 3: phase_zero_o(p); break;
    case 4: case 5: case 6: break;
#endif
    case 7: phase_wout(p, l, smem); break;
    case 8: phase_ln(p, l, 1, false); break;
    case 9: phase_ffn_up(p, l, 1, smem); break;
    case 10: phase_ffn_down(p, l, 1, smem); break;
    case 11: phase_ln(p, l, 2, false); break;
  }
}
constexpr int NPHASE = 25;

#if ONE_LAUNCH
DI unsigned xb_ld(unsigned* p) { return __hip_atomic_load(p, __ATOMIC_RELAXED, __HIP_MEMORY_SCOPE_AGENT); }
DI unsigned xb_add(unsigned* p, unsigned v) { return __hip_atomic_fetch_add(p, v, __ATOMIC_RELAXED, __HIP_MEMORY_SCOPE_AGENT); }
DI void xb_st(unsigned* p, unsigned v) { __hip_atomic_store(p, v, __ATOMIC_RELAXED, __HIP_MEMORY_SCOPE_AGENT); }
constexpr int XB_CNT = 256, XB_SUB = 256 + 64 * 16, XB_GEN = 256 + 64 * 32, XB_TOP = 256 + 64 * 48, XB_TOPGEN = 256 + 64 * 49, XB_WORDS = 256 + 64 * 50;
DI void grid_bar(const Params& P, unsigned idx, char* smem) {
  asm volatile("s_waitcnt vmcnt(0)" ::: "memory");
  __syncthreads();
  int t = threadIdx.x; asm volatile("" : "+v"(t));
  if (t == 0) {
    unsigned* bar = (unsigned*)(P.ws + OFF_CTRL);
    volatile unsigned* st = (volatile unsigned*)(smem + 69632 - 16);
    const unsigned x = st[1], nloc = st[2], nx = st[3];
    const unsigned old = xb_add(&bar[XB_SUB + 64 * x], 1u);
    if (old + 1u == idx * nloc) {
      __builtin_amdgcn_fence(__ATOMIC_RELEASE, "agent");
      asm volatile("s_waitcnt vmcnt(0)" ::: "memory");
      const unsigned og = xb_add(&bar[XB_TOP], 1u);
      if (og + 1u == idx * nx) xb_st(&bar[XB_TOPGEN], idx);
      else { while (xb_ld(&bar[XB_TOPGEN]) < idx) __builtin_amdgcn_s_sleep(1); }
      xb_st(&bar[XB_GEN + 64 * x], idx);
    } else { while (xb_ld(&bar[XB_GEN + 64 * x]) < idx) __builtin_amdgcn_s_sleep(1); }
    __builtin_amdgcn_fence(__ATOMIC_ACQUIRE, "agent");
    asm volatile("s_waitcnt vmcnt(0)" ::: "memory");
  }
  __syncthreads();
}
template <int PH> DI void run_all(const Params& p, char* smem) {
  run_phase(p, PH, smem);
  if constexpr (PH + 1 < NPHASE) { grid_bar(p, PH + 1, smem); run_all<PH + 1>(p, smem); }
}
__global__ void __launch_bounds__(256, 2) mega_kernel(Params p) {
  __shared__ __attribute__((aligned(16))) char smem[69632];
  {
    unsigned* bar = (unsigned*)(p.ws + OFF_CTRL); volatile unsigned* st = (volatile unsigned*)(smem + 69632 - 16);
    const unsigned x = (unsigned)__builtin_amdgcn_s_getreg((3 << 11) | 20) & 0xFu;
    if (threadIdx.x == 0) xb_add(&bar[XB_CNT + 64 * x], 1u);
    cg::this_grid().sync();
    if (threadIdx.x == 0) { unsigned nx = 0, mine = 1;
      for (unsigned j = 0; j < 16; ++j) { const unsigned c = xb_ld(&bar[XB_CNT + 64 * j]); nx += (c > 0u) ? 1u : 0u; if (j == x) mine = c; }
      st[1] = x; st[2] = mine; st[3] = nx; }
    __syncthreads();
  }
  run_all<0>(p, smem);
}
#define MAIN_KERNEL mega_kernel
#else
#define MAIN_KERNEL phase_kernel
#endif
__global__ void __launch_bounds__(256, 2) phase_kernel(Params p, int ph) {
  __shared__ __attribute__((aligned(16))) char smem[69632];
  run_phase(p, ph, smem);
}

extern "C" void kernel_launch(void* const* d_in, const int* in_sizes, int n_in, void* d_out, int out_size, void* d_ws, size_t ws_size, hipStream_t stream) {
  static int grid_blocks = 0;
  if (!grid_blocks) { int dev = 0, cus = 0, per_cu = 0; hipGetDevice(&dev); hipDeviceGetAttribute(&cus, hipDeviceAttributeMultiprocessorCount, dev);
    hipOccupancyMaxActiveBlocksPerMultiprocessor(&per_cu, MAIN_KERNEL, 256, 0); if (per_cu > 2) per_cu = 2; if (per_cu < 1) per_cu = 1; grid_blocks = cus * per_cu; }
  if (ws_size < OFF_END) { fprintf(stderr, "workspace too small: %zu < %zu\n", ws_size, (size_t)OFF_END); return; }
  Params p; memset(&p, 0, sizeof(p));
  const float* x = (const float*)d_in[0]; const float* ffn_in = (const float*)d_in[1]; const float* ffn_out = (const float*)d_in[2];
  const float* w_in = (const float*)d_in[5]; const float* w_out = (const float*)d_in[6]; const float* qn = (const float*)d_in[7]; const float* kvn = (const float*)d_in[8];
  const float* wuq = (const float*)d_in[9]; const float* wukv = (const float*)d_in[10]; const float* cw1 = (const float*)d_in[12]; const float* cw2 = (const float*)d_in[13];
  p.x = x; p.ln_g = (const float*)d_in[3]; p.ln_b = (const float*)d_in[4]; p.cmp_pos = (const float*)d_in[11]; p.cmp_w1 = cw1; p.out = (float*)d_out; p.ws = (char*)d_ws;
  int tile0 = 0, di = 0;
  auto add = [&](const float* src, size_t dst_off, const float* ksc, int K, int Nsrc, int Ndst, int map) {
    WDesc& d = p.wd[di++]; d.src = src; d.dst = (bf16_t*)((char*)d_ws + dst_off); d.kscale = ksc; d.K = K; d.Nsrc = Nsrc; d.Ndst = Ndst; d.map = map; d.tile0 = tile0; d.ntn = Ndst / 64;
    tile0 += (Ndst / 64) * (K / 128); };
  auto add_ffn_in = [&](int l, int j) { add(ffn_in + (size_t)(l * 2 + j) * 1024 * 5632, OFF_W + (size_t)l * LW_SIZE + LW_FIN + j * SZ_FIN, nullptr, 1024, 5632, 5632, 1); };
  auto add_ffn_out = [&](int l, int j) { add(ffn_out + (size_t)(l * 2 + j) * 2816 * 1024, OFF_W + (size_t)l * LW_SIZE + LW_FOUT + j * SZ_FOUT, nullptr, 2816, 1024, 1024, 0); };
  auto add_mix = [&](int l) { const size_t wb = OFF_W + (size_t)l * LW_SIZE;
    add(w_in + (size_t)l * 1024 * 2738, wb + LW_WIN, nullptr, 1024, 2738, PW, 2);
    add(wuq + (size_t)l * 256 * 384, wb + LW_UQ, qn + l * 256, 256, 384, 384, 0);
    add(wukv + (size_t)l * 128 * 512, wb + LW_UKV, kvn + l * 128, 128, 512, 512, 0);
    for (int kv = 0; kv < 2; ++kv) add(cw1 + (size_t)(l * 2 + kv) * 2048 * 256, wb + LW_C1 + kv * SZ_C1, nullptr, 2048, 256, 256, 0);
    for (int kv = 0; kv < 2; ++kv) add(cw2 + (size_t)(l * 2 + kv) * 256 * 64, wb + LW_C2 + kv * SZ_C2, nullptr, 256, 64, 64, 0); };
  auto add_wout = [&](int l) { add(w_out + (size_t)l * 1024 * 1024, OFF_W + (size_t)l * LW_SIZE + LW_WOUT, nullptr, 1024, 1024, 1024, 0); };
  add_ffn_in(0, 0); add_ffn_out(0, 0); add_mix(0);
  p.n_early = tile0;
  add_wout(0); add_ffn_in(0, 1); add_ffn_out(0, 1); add_ffn_in(1, 0); add_ffn_out(1, 0); add_mix(1); add_wout(1); add_ffn_in(1, 1); add_ffn_out(1, 1);
  p.n_wtiles = tile0;
  hipMemsetAsync((char*)d_ws + OFF_CTRL, 0, 16384, stream);
#if ONE_LAUNCH
  void* args[] = {&p};
  hipError_t e = hipLaunchCooperativeKernel((void*)mega_kernel, dim3(grid_blocks), dim3(256), args, 0, stream);
  if (e != hipSuccess) fprintf(stderr, "cooperative launch failed: %s (grid %d)\n", hipGetErrorString(e), grid_blocks);
#else
  for (int ph = 0; ph < NPHASE; ++ph) phase_kernel<<<dim3(grid_blocks), dim3(256), 0, stream>>>(p, ph);
#endif
}
```

```cpp
#include <hip/hip_runtime.h>
#include <hip/hip_cooperative_groups.h>
#include <cstdio>
#include <cstdint>
#include <cstring>
namespace cg = cooperative_groups;

typedef unsigned short bf16_t;
typedef short bf16x8 __attribute__((ext_vector_type(8)));
typedef short s16x4 __attribute__((ext_vector_type(4)));
typedef float f32x4 __attribute__((ext_vector_type(4)));
typedef unsigned u32x4 __attribute__((ext_vector_type(4)));
typedef unsigned u32x2 __attribute__((ext_vector_type(2)));
#define DI __device__ __forceinline__
#define LDSP(T, p) ((__attribute__((address_space(3))) T*)(p))

#ifndef ENABLE_MIX
#define ENABLE_MIX 1
#endif
#ifndef PROBE_REP
#define PROBE_REP 0
#endif
#ifndef ONE_LAUNCH
#define ONE_LAUNCH 1
#endif

constexpr int T_ = 16384, S_ = 8192, D_ = 1024, F_ = 2816, PW = 3200;
constexpr float ALPHA = 1.41421356237f;
constexpr int C_CQ = 0, C_CKV = 256, C_DQ = 384, C_DK = 768, C_DV = 1152, C_NQ = 1536, C_NQR = 1920, C_KC = 2304, C_VC = 2432,
              C_KSL = 2560, C_VSL = 2688, C_KW = 2816, C_VW = 2944, C_KPE = 3072, C_GL = 3104;
constexpr int NCMP = 511;

constexpr size_t SZ_FIN = 5632ull * 1024 * 2, SZ_FOUT = 1024ull * 2816 * 2, SZ_WIN = (size_t)PW * 1024 * 2, SZ_WOUT = 1024ull * 1024 * 2,
                 SZ_UQ = 384ull * 256 * 2, SZ_UKV = 512ull * 128 * 2, SZ_C1 = 256ull * 2048 * 2, SZ_C2 = 64ull * 256 * 2;
constexpr size_t LW_FIN = 0, LW_FOUT = LW_FIN + 2 * SZ_FIN, LW_WIN = LW_FOUT + 2 * SZ_FOUT, LW_WOUT = LW_WIN + SZ_WIN, LW_UQ = LW_WOUT + SZ_WOUT,
                 LW_UKV = LW_UQ + SZ_UQ, LW_C1 = LW_UKV + SZ_UKV, LW_C2 = LW_C1 + 2 * SZ_C1, LW_SIZE = LW_C2 + 2 * SZ_C2;
constexpr size_t OFF_CTRL = 0, OFF_C64 = 16384, OFF_S64 = OFF_C64 + 8192ull * 32 * 4, OFF_C32 = OFF_S64 + 8192ull * 32 * 4, OFF_S32 = OFF_C32 + 8192ull * 16 * 4,
                 OFF_CBIAS = OFF_S32 + 8192ull * 16 * 4, OFF_W = OFF_CBIAS + 4096, OFF_XB = OFF_W + 2 * LW_SIZE, OFF_BIG = OFF_XB + (size_t)T_ * D_ * 2,
                 OFF_QA = OFF_BIG + (size_t)T_ * PW * 2, OFF_KA = OFF_QA + (size_t)T_ * 384 * 2, OFF_VA = OFF_KA + (size_t)T_ * 384 * 2,
                 OFF_DILO = OFF_VA + (size_t)T_ * 256 * 2, OFF_DILL = OFF_DILO + 3ull * T_ * 384 * 2, OFF_CHID = OFF_DILL + 3ull * T_ * 6 * 4,
                 OFF_KCVC = OFF_CHID + 2ull * 2048 * 256 * 2, OFF_SEL = OFF_KCVC + 2ull * 2048 * 64 * 2, OFF_IMP = OFF_SEL + (size_t)T_ * 2 * 4 * 4,
                 OFF_END = OFF_IMP + (size_t)T_ * 2 * 128 * 4;

struct WDesc { const float* src; bf16_t* dst; const float* kscale; int K, Nsrc, Ndst, map, tile0, ntn; };
struct Params {
  const float* x; const float* ln_g; const float* ln_b; const float* cmp_pos; const float* cmp_w1;
  float* out; char* ws;
  WDesc wd[24];
  int n_wtiles; int n_early;
};
struct Ctx { const float* x; const float* ln_g; const float* ln_b; const float* cmp_pos; const float* cmp_w1; float* out; char* ws; int tid; };

DI bf16_t f2bf(float x) { unsigned u = __float_as_uint(x); u += 0x7fffu + ((u >> 16) & 1u); return (bf16_t)(u >> 16); }
DI float bf2f(bf16_t v) { return __uint_as_float(((unsigned)v) << 16); }
DI unsigned pk2(float a, float b) { return (unsigned)f2bf(a) | ((unsigned)f2bf(b) << 16); }
DI float fast_exp2(float x) { return __builtin_amdgcn_exp2f(x); }
DI float silu(float v) { return v * __builtin_amdgcn_rcpf(1.f + __expf(-v)); }
DI bf16x8 pack8(const f32x4& a, const f32x4& b) {
  u32x4 p;
  asm volatile("v_cvt_pk_bf16_f32 %0, %4, %5\n\tv_cvt_pk_bf16_f32 %1, %6, %7\n\tv_cvt_pk_bf16_f32 %2, %8, %9\n\tv_cvt_pk_bf16_f32 %3, %10, %11\n\ts_nop 1"
               : "=&v"(p[0]), "=&v"(p[1]), "=&v"(p[2]), "=&v"(p[3])
               : "v"(a[0]), "v"(a[1]), "v"(a[2]), "v"(a[3]), "v"(b[0]), "v"(b[1]), "v"(b[2]), "v"(b[3]));
  return __builtin_bit_cast(bf16x8, p);
}
DI f32x4 mfma16(bf16x8 a, bf16x8 b, f32x4 c) { return __builtin_amdgcn_mfma_f32_16x16x32_bf16(a, b, c, 0, 0, 0); }

DI void sincos_rr(float ang, float& c, float& s) {
  const double rev = (double)ang * 0.15915494309189533577; const float fr = (float)(rev - rint(rev));
  c = __builtin_amdgcn_cosf(fr); s = __builtin_amdgcn_sinf(fr);
}

struct ALin { const bf16_t* A; int lda; int mmax; DI const bf16_t* ptr(int row, int k) const { row = row < mmax ? row : mmax - 1; return A + (size_t)row * lda + k; } };
struct ACmp {
  const bf16_t* proj; int colbase;
  DI const bf16_t* ptr(int m, int k) const { if (m > 2043) m = 2043; int b = m / 1022, rem = m - b * 1022, g = rem / 511, c = rem - g * 511;
    return proj + (size_t)(b * S_ + 16 * c + (k >> 6)) * PW + colbase + g * 64 + (k & 63); } };

template <class AL, class EPI>
DI void gemm_tile(const int tid, const AL al, const bf16_t* __restrict__ Bt, int ldb, int nvalid, int K, int m0, int n0, const EPI epi, char* smem) {
  const int lane = tid & 63, wave = tid >> 6, wr = wave >> 1, wc = wave & 1, g = lane >> 4;
  f32x4 acc[4][4];
#pragma unroll
  for (int i = 0; i < 4; ++i)
#pragma unroll
    for (int j = 0; j < 4; ++j) acc[i][j] = (f32x4){0.f, 0.f, 0.f, 0.f};
  const int srow = wave * 32 + (lane >> 3), sc8 = ((lane & 7) ^ (lane >> 3)) * 8;
  const bf16_t* bp[4];
#pragma unroll
  for (int i = 0; i < 4; ++i) { int r = n0 + srow + 8 * i; r = r < nvalid ? r : nvalid - 1; bp[i] = Bt + (size_t)r * ldb + sc8; }
  const int offA = (wr * 64 + (lane & 15)) * 128 + ((g ^ (lane & 7)) << 4);
  const int offB = (wc * 64 + (lane & 15)) * 128 + ((g ^ (lane & 7)) << 4);
  const int nk = K >> 6;
  auto stage = [&](int kt, int buf) {
    char* da = smem + buf * 32768 + wave * 4096; const int k0 = kt << 6;
#pragma unroll
    for (int i = 0; i < 4; ++i) {
      __builtin_amdgcn_global_load_lds((const unsigned*)al.ptr(m0 + srow + 8 * i, k0 + sc8), LDSP(unsigned, da + i * 1024), 16, 0, 0);
      __builtin_amdgcn_global_load_lds((const unsigned*)(bp[i] + k0), LDSP(unsigned, da + 16384 + i * 1024), 16, 0, 0);
    }
  };
  bf16x8 a0[4], b0[4], a1[4], b1[4];
  auto rd = [&](bf16x8 (&a)[4], bf16x8 (&b)[4], const char* sa, int ks) {
#pragma unroll
    for (int i = 0; i < 4; ++i) { a[i] = *(const bf16x8*)(sa + ((offA + i * 2048) ^ (ks << 6))); b[i] = *(const bf16x8*)(sa + 16384 + ((offB + i * 2048) ^ (ks << 6))); }
  };
  auto mm = [&](const bf16x8 (&a)[4], const bf16x8 (&b)[4]) {
#pragma unroll
    for (int i = 0; i < 4; ++i)
#pragma unroll
      for (int j = 0; j < 4; ++j) acc[i][j] = mfma16(a[i], b[j], acc[i][j]);
  };
  stage(0, 0);
  asm volatile("s_waitcnt vmcnt(0)" ::: "memory");
  __syncthreads();
  if (nk > 1) stage(1, 1);
  rd(a0, b0, smem, 0);
  for (int kt = 0; kt < nk; ++kt) {
    const char* sa = smem + (kt & 1) * 32768;
    rd(a1, b1, sa, 1);
    __builtin_amdgcn_sched_barrier(0);
    mm(a0, b0);
    __builtin_amdgcn_sched_barrier(0);
    asm volatile("s_waitcnt vmcnt(0)" ::: "memory");
    __syncthreads();
    if (kt + 2 < nk) stage(kt + 2, kt & 1);
    if (kt + 1 < nk) rd(a0, b0, smem + ((kt + 1) & 1) * 32768, 0);
    __builtin_amdgcn_sched_barrier(0);
    mm(a1, b1);
    __builtin_amdgcn_sched_barrier(0);
  }
  epi(acc, m0 + wr * 64, n0 + wc * 64, lane);
}

DI void store_plain(bf16_t* dst, int ld, const f32x4 (&acc)[4][4], int row0, int col0, int lane, float sc) {
#pragma unroll
  for (int mi = 0; mi < 4; ++mi)
#pragma unroll
    for (int r = 0; r < 4; ++r) { const int row = row0 + mi * 16 + (lane >> 4) * 4 + r;
#pragma unroll
      for (int ni = 0; ni < 4; ++ni) dst[(size_t)row * ld + col0 + ni * 16 + (lane & 15)] = f2bf(acc[mi][ni][r] * sc); }
}

struct EpiSwiGLU { bf16_t* H;
  DI void operator()(const f32x4 (&acc)[4][4], int row0, int col0, int lane) const {
#pragma unroll
    for (int mi = 0; mi < 4; ++mi)
#pragma unroll
      for (int r = 0; r < 4; ++r) { const int row = row0 + mi * 16 + (lane >> 4) * 4 + r;
#pragma unroll
        for (int pr = 0; pr < 2; ++pr) { const float gt = acc[mi][2 * pr][r], up = acc[mi][2 * pr + 1][r];
          H[(size_t)row * F_ + ((col0 >> 5) + pr) * 16 + (lane & 15)] = f2bf(silu(gt) * up); } }
  } };
struct EpiResid { const float* xin; float* y; float scale;
  DI void operator()(const f32x4 (&acc)[4][4], int row0, int col0, int lane) const {
#pragma unroll
    for (int mi = 0; mi < 4; ++mi)
#pragma unroll
      for (int r = 0; r < 4; ++r) { const int row = row0 + mi * 16 + (lane >> 4) * 4 + r;
#pragma unroll
        for (int ni = 0; ni < 4; ++ni) { const size_t ix = (size_t)row * D_ + col0 + ni * 16 + (lane & 15); y[ix] = ALPHA * xin[ix] + scale * acc[mi][ni][r]; } }
  } };
struct EpiProj { bf16_t* proj; bf16_t* ka; const float* c64; const float* s64; const float* c32; const float* s32;
  DI void operator()(const f32x4 (&acc)[4][4], int row0, int col0, int lane) const {
    const bool rope = (col0 >= C_DQ && col0 < C_DV) || (col0 >= C_NQR && col0 < C_KC) || (col0 >= C_KSL && col0 < C_VSL) || (col0 >= C_KW && col0 < C_VW);
    if (rope) {
#pragma unroll
      for (int mi = 0; mi < 4; ++mi)
#pragma unroll
        for (int r = 0; r < 4; ++r) { const int row = row0 + mi * 16 + (lane >> 4) * 4 + r, pos = row & (S_ - 1);
#pragma unroll
          for (int ni = 0; ni < 2; ++ni) { const int i = ni * 16 + (lane & 15); const float c = c64[pos * 32 + i], s = s64[pos * 32 + i];
            const float x1 = acc[mi][ni][r], x2 = acc[mi][ni + 2][r];
            proj[(size_t)row * PW + col0 + i] = f2bf(x1 * c - x2 * s); proj[(size_t)row * PW + col0 + 32 + i] = f2bf(x1 * s + x2 * c); } }
    } else if (col0 == C_KPE) {
#pragma unroll
      for (int mi = 0; mi < 4; ++mi)
#pragma unroll
        for (int r = 0; r < 4; ++r) { const int row = row0 + mi * 16 + (lane >> 4) * 4 + r, pos = row & (S_ - 1); const int i = lane & 15;
          const float c = c32[pos * 16 + i], s = s32[pos * 16 + i]; const float x1 = acc[mi][0][r], x2 = acc[mi][1][r];
          const bf16_t o1 = f2bf(x1 * c - x2 * s), o2 = f2bf(x1 * s + x2 * c);
#pragma unroll
          for (int h = 0; h < 4; ++h) { ka[(size_t)row * 384 + h * 96 + 64 + i] = o1; ka[(size_t)row * 384 + h * 96 + 80 + i] = o2; }
#pragma unroll
          for (int ni = 2; ni < 4; ++ni) { const float v = acc[mi][ni][r]; proj[(size_t)row * PW + col0 + ni * 16 + i] = f2bf(1.f / (1.f + __expf(-v))); } }
    } else store_plain(proj, PW, acc, row0, col0, lane, 1.f);
  } };
struct EpiMLAq { bf16_t* qa; const float* rs; int m0; const float* c32; const float* s32;
  DI void operator()(const f32x4 (&acc)[4][4], int row0, int col0, int lane) const {
#pragma unroll
    for (int mi = 0; mi < 4; ++mi)
#pragma unroll
      for (int r = 0; r < 4; ++r) { const int row = row0 + mi * 16 + (lane >> 4) * 4 + r, pos = row & (S_ - 1); const float sc = rs[row - m0]; const int i = lane & 15;
#pragma unroll
        for (int ch = 0; ch < 2; ++ch) { const int gc = col0 + 32 * ch; const float x1 = acc[mi][2 * ch][r] * sc, x2 = acc[mi][2 * ch + 1][r] * sc;
          if (((gc >> 5) % 3) == 2) { const float c = c32[pos * 16 + i], s = s32[pos * 16 + i];
            qa[(size_t)row * 384 + gc + i] = f2bf(x1 * c - x2 * s); qa[(size_t)row * 384 + gc + 16 + i] = f2bf(x1 * s + x2 * c); }
          else { qa[(size_t)row * 384 + gc + i] = f2bf(x1); qa[(size_t)row * 384 + gc + 16 + i] = f2bf(x2); } } }
  } };
struct EpiMLAkv { bf16_t* ka; bf16_t* va; const float* rs; int m0;
  DI void operator()(const f32x4 (&acc)[4][4], int row0, int col0, int lane) const {
    const int h = col0 >> 7, part = (col0 >> 6) & 1;
#pragma unroll
    for (int mi = 0; mi < 4; ++mi)
#pragma unroll
      for (int r = 0; r < 4; ++r) { const int row = row0 + mi * 16 + (lane >> 4) * 4 + r; const float sc = rs[row - m0];
#pragma unroll
        for (int ni = 0; ni < 4; ++ni) { const int j = ni * 16 + (lane & 15); const bf16_t v = f2bf(acc[mi][ni][r] * sc);
          if (part == 0) ka[(size_t)row * 384 + h * 96 + j] = v; else va[(size_t)row * 256 + h * 64 + j] = v; } }
  } };
struct EpiCmp1 { bf16_t* hid; const float* bias;
  DI void operator()(const f32x4 (&acc)[4][4], int row0, int col0, int lane) const {
#pragma unroll
    for (int mi = 0; mi < 4; ++mi)
#pragma unroll
      for (int r = 0; r < 4; ++r) { const int row = row0 + mi * 16 + (lane >> 4) * 4 + r;
#pragma unroll
        for (int ni = 0; ni < 4; ++ni) { const int col = col0 + ni * 16 + (lane & 15); hid[(size_t)row * 256 + col] = f2bf(silu(acc[mi][ni][r] + bias[col])); } }
  } };
struct EpiCmp2 { bf16_t* kc;
  DI void operator()(const f32x4 (&acc)[4][4], int row0, int col0, int lane) const {
    if (col0 >= 64) return;
#pragma unroll
    for (int mi = 0; mi < 4; ++mi)
#pragma unroll
      for (int r = 0; r < 4; ++r) { const int row = row0 + mi * 16 + (lane >> 4) * 4 + r;
        if (row < 2044) {
#pragma unroll
          for (int ni = 0; ni < 4; ++ni) kc[(size_t)row * 64 + col0 + ni * 16 + (lane & 15)] = f2bf(acc[mi][ni][r]); } }
  } };

template <int DQ, int MODE, class OUT>
DI void attn_core(const int tid, const bf16_t* __restrict__ Qb, long qs, const bf16_t* __restrict__ Kb, long kst, const bf16_t* __restrict__ Vb, long vst,
                  int q0, int k0, int kmax, int ntiles, const int* tlist, float sl2, int window,
                  const unsigned* selw, float* impg, bool first_head, float (&m_io)[2], float (&l_io)[2], const OUT out, char* smem) {
  constexpr int NKD = DQ / 32, CPR = DQ / 8, KST = (DQ == 64) ? 128 : 256;
  const int lane = tid & 63, wave = tid >> 6, g = lane >> 4, li = lane & 15;
  bf16x8 qf[2][NKD];
#pragma unroll
  for (int qt = 0; qt < 2; ++qt)
#pragma unroll
    for (int kd = 0; kd < NKD; ++kd) qf[qt][kd] = *(const bf16x8*)(Qb + (long)(q0 + wave * 32 + qt * 16 + li) * qs + kd * 32 + g * 8);
  int qidx[2]; qidx[0] = q0 + wave * 32 + li; qidx[1] = qidx[0] + 16;
  f32x4 o[4][2];
#pragma unroll
  for (int i = 0; i < 4; ++i) { o[i][0] = (f32x4){0.f, 0.f, 0.f, 0.f}; o[i][1] = (f32x4){0.f, 0.f, 0.f, 0.f}; }
  float mrun[2], lrun[2], invl[2], prev3[2];
#pragma unroll
  for (int qt = 0; qt < 2; ++qt) { prev3[qt] = 0.f;
    if (MODE == 3) { mrun[qt] = m_io[qt]; lrun[qt] = 0.f; invl[qt] = l_io[qt] > 0.f ? 1.f / l_io[qt] : 0.f; } else { mrun[qt] = -1e30f; lrun[qt] = 0.f; invl[qt] = 0.f; } }
  constexpr int RPP = 1024 / KST, NKP = 64 / RPP / 4;
  auto stage = [&](int jt, int buf) {
    const int kb = k0 + jt * 64; char* kbuf = smem + buf * 16384; char* vbuf = smem + 32768 + buf * 8192;
#pragma unroll
    for (int i = 0; i < NKP; ++i) { const int pc = wave * NKP + i; const int row = pc * RPP + (DQ == 64 ? (lane >> 3) : (lane >> 4));
      int c = (DQ == 64) ? ((lane & 7) ^ (row & 7)) : ((lane & 15) ^ (row & 7)); if (DQ != 64 && c >= CPR) c = 0;
      int ix = kb + row; ix = ix < 0 ? 0 : (ix > kmax ? kmax : ix);
      __builtin_amdgcn_global_load_lds((const unsigned*)(Kb + (long)ix * kst + c * 8), LDSP(unsigned, kbuf + pc * 1024), 16, 0, 0); }
    if (MODE != 2) {
#pragma unroll
      for (int i = 0; i < 2; ++i) { const int pc = wave * 2 + i; const int row = pc * 8 + (lane >> 3); const int pp = lane & 7;
        const int c = ((((pp >> 1) ^ ((row >> 1) & 3)) << 1) | (pp & 1));
        int ix = kb + row; ix = ix < 0 ? 0 : (ix > kmax ? kmax : ix);
        __builtin_amdgcn_global_load_lds((const unsigned*)(Vb + (long)ix * vst + c * 8), LDSP(unsigned, vbuf + pc * 1024), 16, 0, 0); }
    }
  };
  if (ntiles > 0) stage(tlist ? tlist[0] : 0, 0);
  asm volatile("s_waitcnt vmcnt(0)" ::: "memory");
  __syncthreads();
  for (int it = 0; it < ntiles; ++it) {
    const int jt = tlist ? tlist[it] : it;
    const bool more = it + 1 < ntiles;
    if (more) stage(tlist ? tlist[it + 1] : it + 1, (it + 1) & 1);
    const char* kbuf = smem + (it & 1) * 16384; const char* vbuf = smem + 32768 + (it & 1) * 8192;
    f32x4 st[4][2];
#pragma unroll
    for (int kt4 = 0; kt4 < 4; ++kt4) {
      bf16x8 kf[NKD]; const int row = kt4 * 16 + li;
#pragma unroll
      for (int kd = 0; kd < NKD; ++kd) kf[kd] = *(const bf16x8*)(kbuf + row * KST + (((kd * 4 + g) ^ (row & 7)) << 4));
#pragma unroll
      for (int qt = 0; qt < 2; ++qt) { f32x4 a = (f32x4){0.f, 0.f, 0.f, 0.f};
#pragma unroll
        for (int kd = 0; kd < NKD; ++kd) a = mfma16(kf[kd], qf[qt][kd], a);
        st[kt4][qt] = a; }
    }
    const int kbase = k0 + jt * 64;
    bool sb[2] = {true, true};
    if (MODE == 4) { sb[0] = (selw[(wave * 32 + li) * 4 + (jt >> 5)] >> (jt & 31)) & 1u; sb[1] = (selw[(wave * 32 + 16 + li) * 4 + (jt >> 5)] >> (jt & 31)) & 1u; }
    float alpha[2];
    bool fullc = false;
    if (MODE == 0 || MODE == 4) fullc = (kbase + 63 <= q0 + wave * 32);
    if (MODE == 1) fullc = (kbase >= 0) && (kbase + 63 <= q0 + wave * 32) && (q0 + wave * 32 + 31 - kbase <= window);
    const bool full = __builtin_amdgcn_readfirstlane((int)fullc) != 0;
    if (!full) {
#pragma unroll
      for (int qt = 0; qt < 2; ++qt)
#pragma unroll
        for (int kt4 = 0; kt4 < 4; ++kt4)
#pragma unroll
          for (int r = 0; r < 4; ++r) { const int kidx = kbase + kt4 * 16 + g * 4 + r; bool v;
            if (MODE == 0) v = kidx <= qidx[qt];
            else if (MODE == 1) v = (kidx >= 0) && (kidx <= qidx[qt]) && (qidx[qt] - kidx <= window);
            else if (MODE == 2 || MODE == 3) v = (kidx <= kmax) && (16 * kidx + 31 <= qidx[qt]);
            else v = (kidx <= qidx[qt]) && sb[qt];
            st[kt4][qt][r] = v ? st[kt4][qt][r] : -3e38f; }
    } else if (MODE == 4) {
#pragma unroll
      for (int qt = 0; qt < 2; ++qt)
#pragma unroll
        for (int kt4 = 0; kt4 < 4; ++kt4)
#pragma unroll
          for (int r = 0; r < 4; ++r) st[kt4][qt][r] = sb[qt] ? st[kt4][qt][r] : -3e38f;
    }
#pragma unroll
    for (int qt = 0; qt < 2; ++qt) {
      float mx = -3e38f;
#pragma unroll
      for (int kt4 = 0; kt4 < 4; ++kt4)
#pragma unroll
        for (int r = 0; r < 4; ++r) mx = fmaxf(mx, st[kt4][qt][r]);
      if (MODE != 3) {
        mx = fmaxf(mx, __shfl_xor(mx, 16)); mx = fmaxf(mx, __shfl_xor(mx, 32));
        const float mn = fmaxf(mrun[qt], mx * sl2); alpha[qt] = fast_exp2(mrun[qt] - mn); mrun[qt] = mn;
      } else alpha[qt] = 1.f;
      float ls = 0.f; const float nm = -mrun[qt];
#pragma unroll
      for (int kt4 = 0; kt4 < 4; ++kt4)
#pragma unroll
        for (int r = 0; r < 4; ++r) { float p = fast_exp2(fmaf(st[kt4][qt][r], sl2, nm)); if (MODE == 3) p *= invl[qt]; st[kt4][qt][r] = p; ls += p; }
      lrun[qt] = lrun[qt] * alpha[qt] + ls;
    }
    if (MODE == 3) {
#pragma unroll
      for (int qt = 0; qt < 2; ++qt)
#pragma unroll
        for (int kt4 = 0; kt4 < 4; ++kt4) { const float p3 = st[kt4][qt][3]; const float a = (st[kt4][qt][0] + st[kt4][qt][1]) + (st[kt4][qt][2] + p3);
          const float give = (g == 3) ? prev3[qt] : p3; const float up = __shfl(give, (lane + 48) & 63); prev3[qt] = p3;
          float* ip = impg + (size_t)(wave * 32 + qt * 16 + li) * 128 + jt * 16 + kt4 * 4 + g; const float val = a + up;
          if (first_head) *ip = val; else *ip += val; }
    }
    if (MODE != 2) {
      if (MODE != 3) {
#pragma unroll
        for (int dt = 0; dt < 4; ++dt) { o[dt][0] *= alpha[0]; o[dt][1] *= alpha[1]; }
      }
#pragma unroll
      for (int ks2 = 0; ks2 < 2; ++ks2) {
        bf16x8 pf[2];
#pragma unroll
        for (int qt = 0; qt < 2; ++qt) pf[qt] = pack8(st[2 * ks2][qt], st[2 * ks2 + 1][qt]);
        const int rowA = 32 * ks2 + 4 * g + (li >> 2), p_ = li & 3;
#pragma unroll
        for (int dt = 0; dt < 4; ++dt) {
          const int off = rowA * 128 + ((((dt ^ ((rowA >> 1) & 3)) << 1) | (p_ >> 1)) << 4) + 8 * (p_ & 1);
          const s16x4 lo = __builtin_amdgcn_ds_read_tr16_b64_v4i16(LDSP(s16x4, vbuf + off));
          const s16x4 hi = __builtin_amdgcn_ds_read_tr16_b64_v4i16(LDSP(s16x4, vbuf + off + 2048));
          const bf16x8 vf = __builtin_shufflevector(lo, hi, 0, 1, 2, 3, 4, 5, 6, 7);
          o[dt][0] = mfma16(vf, pf[0], o[dt][0]); o[dt][1] = mfma16(vf, pf[1], o[dt][1]);
        }
      }
    }
    asm volatile("s_waitcnt vmcnt(0)" ::: "memory");
    __syncthreads();
  }
#pragma unroll
  for (int qt = 0; qt < 2; ++qt) {
    float lt = lrun[qt]; lt += __shfl_xor(lt, 16); lt += __shfl_xor(lt, 32);
    if (MODE == 2) { m_io[qt] = mrun[qt]; l_io[qt] = lt; }
    else {
      const float inv = (MODE == 3) ? 1.f : (lt > 0.f ? 1.f / lt : 0.f);
#pragma unroll
      for (int dt = 0; dt < 4; ++dt) out(wave * 32 + qt * 16 + li, dt * 16 + g * 4, o[dt][qt] * inv, mrun[qt], lt);
    }
  }
}

struct OutSet { bf16_t* dst; long ld; const bf16_t* gate; long gld; float* lse; long lld;
  DI void operator()(int ql, int d0, f32x4 v, float m, float l) const {
    float gs = 1.f; if (gate) gs = bf2f(gate[ql * gld]);
    u32x2 w; w[0] = pk2(v[0] * gs, v[1] * gs); w[1] = pk2(v[2] * gs, v[3] * gs); *(u32x2*)(dst + ql * ld + d0) = w;
    if (lse && d0 == 0) lse[ql * lld] = (m + __log2f(l)) * 0.69314718056f;
  } };
struct OutAdd { bf16_t* dst; long ld; const bf16_t* gate; long gld;
  DI void operator()(int ql, int d0, f32x4 v, float m, float l) const {
    const float gs = bf2f(gate[ql * gld]); u32x2* p = (u32x2*)(dst + ql * ld + d0); const u32x2 old = *p;
    u32x2 w; w[0] = pk2(__uint_as_float(old[0] << 16) + v[0] * gs, __uint_as_float(old[0] & 0xffff0000u) + v[1] * gs);
    w[1] = pk2(__uint_as_float(old[1] << 16) + v[2] * gs, __uint_as_float(old[1] & 0xffff0000u) + v[3] * gs); *p = w;
  } };

DI bf16_t* lw(char* ws, int l, size_t off) { return (bf16_t*)(ws + OFF_W + (size_t)l * LW_SIZE + off); }

DI int colmap(int map, int n, int nsrc) {
  if (map == 0) return n < nsrc ? n : -1;
  if (map == 1) { const int t = n >> 5, i = n & 31; return i < 16 ? 16 * t + i : 2816 + 16 * t + (i - 16); }
  if (n < 384) return n;
  if (n < C_DV + 384) return 416 + (n - C_DQ);
  if (n < C_NQR) return 1568 + (n - C_NQ);
  if (n < C_KC) return 1568 + (n - C_NQR);
  if (n < C_KPE) return 1952 + (n - C_KC);
  if (n < C_GL) return 384 + (n - C_KPE);
  if (n < C_GL + 18) return 2720 + (n - C_GL);
  return -1;
}

DI void convert_wtile(const Params& P, const int tid, int t, char* smem) {
      int di = 0;
#pragma unroll 1
      for (int i = 1; i < 24; ++i) if (t >= P.wd[i].tile0) di = i;
      const WDesc d = P.wd[di]; const int lt = t - d.tile0, tn = lt % d.ntn, tk = lt / d.ntn, n0 = tn * 64, k0 = tk * 128;
      float* tile = (float*)smem;
      const int nn = tid & 63; const int sc = colmap(d.map, n0 + nn, d.Nsrc);
      float v[32];
#pragma unroll
      for (int i = 0; i < 32; ++i) { const int kk = (tid >> 6) + 4 * i; v[i] = (sc >= 0) ? d.src[(size_t)(k0 + kk) * d.Nsrc + sc] : 0.f; }
      if (d.kscale) {
#pragma unroll
        for (int i = 0; i < 32; ++i) v[i] *= d.kscale[k0 + (tid >> 6) + 4 * i];
      }
#pragma unroll
      for (int i = 0; i < 32; ++i) tile[((tid >> 6) + 4 * i) * 65 + nn] = v[i];
      __syncthreads();
      { const int on = tid >> 2, kq = tid & 3;
        bf16_t* dp = d.dst + (size_t)(n0 + on) * d.K + k0 + kq * 32;
#pragma unroll
        for (int c = 0; c < 4; ++c) { u32x4 w;
#pragma unroll
          for (int j = 0; j < 4; ++j) w[j] = pk2(tile[(kq * 32 + c * 8 + 2 * j) * 65 + on], tile[(kq * 32 + c * 8 + 2 * j + 1) * 65 + on]);
          *(u32x4*)(dp + c * 8) = w; } }
      __syncthreads();
}

DI void phase_prologue(const Params& P, const Ctx& p, char* smem) {
  const int tid = p.tid;
  const int n_w = P.n_early, n_cb = 4, n_r64 = 256, n_r32 = 128, n_xb = 1024;
  const int total = n_w + n_cb + n_r64 + n_r32 + n_xb;
  for (int t = blockIdx.x; t < total; t += gridDim.x) {
    if (t < n_w) { convert_wtile(P, tid, t, smem);
    } else if (t < n_w + n_cb) {
      const int id = t - n_w; const float* pos = p.cmp_pos + (size_t)id * 2048; const float* w1 = p.cmp_w1 + (size_t)id * 2048 * 256; float a = 0.f;
      for (int k = 0; k < 2048; ++k) a += pos[k] * w1[(size_t)k * 256 + tid];
      ((float*)(p.ws + OFF_CBIAS))[id * 256 + tid] = a;
    } else if (t < n_w + n_cb + n_r64) {
      const int e0 = (t - n_w - n_cb) * 1024; float* C = (float*)(p.ws + OFF_C64); float* Sn = (float*)(p.ws + OFF_S64);
      for (int e = e0 + tid; e < e0 + 1024; e += 256) { const int pos = e >> 5, i = e & 31; const float inv = exp2f(-(float)(2 * i) / 64.f * 13.287712379549449f); const float ang = (float)pos * inv;
        sincos_rr(ang, C[e], Sn[e]); }
    } else if (t < n_w + n_cb + n_r64 + n_r32) {
      const int e0 = (t - n_w - n_cb - n_r64) * 1024; float* C = (float*)(p.ws + OFF_C32); float* Sn = (float*)(p.ws + OFF_S32);
      for (int e = e0 + tid; e < e0 + 1024; e += 256) { const int pos = e >> 4, i = e & 15; const float inv = exp2f(-(float)(2 * i) / 32.f * 13.287712379549449f); const float ang = (float)pos * inv;
        sincos_rr(ang, C[e], Sn[e]); }
    } else {
      const size_t e0 = (size_t)(t - n_w - n_cb - n_r64 - n_r32) * 16384 + tid * 8; bf16_t* xb = (bf16_t*)(p.ws + OFF_XB);
      f32x4 a[8], b[8];
#pragma unroll
      for (int i = 0; i < 8; ++i) { a[i] = *(const f32x4*)(p.x + e0 + i * 2048); b[i] = *(const f32x4*)(p.x + e0 + i * 2048 + 4); }
#pragma unroll
      for (int i = 0; i < 8; ++i) { u32x4 w; w[0] = pk2(a[i][0], a[i][1]); w[1] = pk2(a[i][2], a[i][3]); w[2] = pk2(b[i][0], b[i][1]); w[3] = pk2(b[i][2], b[i][3]);
        *(u32x4*)(xb + e0 + i * 2048) = w; }
    }
  }
}

DI bool tile_seq(int k, int NT, int total, int& mt, int& nt) {
  const int G = gridDim.x, b = blockIdx.x; const int s = k * G + (b & 7) * (G >> 3) + (b >> 3);
  if (s >= total) return false;
  const int band = s / (16 * NT), r = s - band * 16 * NT; nt = r >> 4; mt = band * 16 + (r & 15); return true;
}
DI void phase_ffn_up(const Ctx& p, int l, int j, char* smem) {
  const ALin al{(const bf16_t*)(p.ws + OFF_XB), D_, T_}; const bf16_t* Bt = lw(p.ws, l, LW_FIN + j * SZ_FIN); const EpiSwiGLU epi{(bf16_t*)(p.ws + OFF_BIG)};
  for (int k = 0;; ++k) { int mt, nt; if (!tile_seq(k, 44, 128 * 44, mt, nt)) break; gemm_tile(p.tid, al, Bt, D_, 5632, D_, mt * 128, nt * 128, epi, smem); }
}
DI void phase_ffn_down(const Ctx& p, int l, int j, char* smem) {
  const ALin al{(const bf16_t*)(p.ws + OFF_BIG), F_, T_}; const bf16_t* Bt = lw(p.ws, l, LW_FOUT + j * SZ_FOUT);
  const EpiResid epi{(l == 0 && j == 0) ? p.x : p.out, p.out, 0.5f};
  for (int k = 0;; ++k) { int mt, nt; if (!tile_seq(k, 8, 128 * 8, mt, nt)) break; gemm_tile(p.tid, al, Bt, F_, D_, F_, mt * 128, nt * 128, epi, smem); }
}
DI void phase_wout(const Ctx& p, int l, char* smem) {
  const ALin al{(const bf16_t*)(p.ws + OFF_XB), D_, T_}; const bf16_t* Bt = lw(p.ws, l, LW_WOUT); const EpiResid epi{p.out, p.out, 1.0f};
  for (int k = 0;; ++k) { int mt, nt; if (!tile_seq(k, 8, 128 * 8, mt, nt)) break; gemm_tile(p.tid, al, Bt, D_, D_, D_, mt * 128, nt * 128, epi, smem); }
}
DI void phase_ln(const Ctx& p, int l, int j, bool zero_o) {
  const int lane = p.tid & 63, wave = p.tid >> 6; const float* gp = p.ln_g + (size_t)(l * 3 + j) * D_; const float* bp = p.ln_b + (size_t)(l * 3 + j) * D_;
  bf16_t* xb = (bf16_t*)(p.ws + OFF_XB);
  for (int t = blockIdx.x; t < T_ / 8; t += gridDim.x) {
    const int row = t * 8 + wave * 2; float* yr = p.out + (size_t)row * D_; f32x4 v[2][4]; float s[2] = {0.f, 0.f};
#pragma unroll
    for (int r = 0; r < 2; ++r)
#pragma unroll
      for (int i = 0; i < 4; ++i) v[r][i] = *(const f32x4*)(yr + r * D_ + i * 256 + lane * 4);
#pragma unroll
    for (int r = 0; r < 2; ++r) {
#pragma unroll
      for (int i = 0; i < 4; ++i) s[r] += (v[r][i][0] + v[r][i][1]) + (v[r][i][2] + v[r][i][3]);
#pragma unroll
      for (int o = 1; o < 64; o <<= 1) s[r] += __shfl_xor(s[r], o);
    }
#pragma unroll
    for (int r = 0; r < 2; ++r) {
      const float mu = s[r] * (1.f / D_); float q = 0.f;
#pragma unroll
      for (int i = 0; i < 4; ++i)
#pragma unroll
        for (int e = 0; e < 4; ++e) { const float d = v[r][i][e] - mu; q += d * d; }
#pragma unroll
      for (int o = 1; o < 64; o <<= 1) q += __shfl_xor(q, o);
      const float rstd = rsqrtf(q * (1.f / D_) + 1e-5f);
#pragma unroll
      for (int i = 0; i < 4; ++i) { const int c = i * 256 + lane * 4; const f32x4 gg = *(const f32x4*)(gp + c), bb = *(const f32x4*)(bp + c); f32x4 o4;
#pragma unroll
        for (int e = 0; e < 4; ++e) o4[e] = (v[r][i][e] - mu) * rstd * gg[e] + bb[e];
        *(f32x4*)(yr + r * D_ + c) = o4; u32x2 w; w[0] = pk2(o4[0], o4[1]); w[1] = pk2(o4[2], o4[3]); *(u32x2*)(xb + (size_t)(row + r) * D_ + c) = w; }
    }
  }
}
DI void phase_win(const Ctx& p, int l, char* smem) {
  const ALin al{(const bf16_t*)(p.ws + OFF_XB), D_, T_}; const bf16_t* Bt = lw(p.ws, l, LW_WIN);
  const EpiProj epi{(bf16_t*)(p.ws + OFF_BIG), (bf16_t*)(p.ws + OFF_KA), (const float*)(p.ws + OFF_C64), (const float*)(p.ws + OFF_S64), (const float*)(p.ws + OFF_C32), (const float*)(p.ws + OFF_S32)};
  for (int k = 0;; ++k) { int mt, nt; if (!tile_seq(k, 25, 128 * 25, mt, nt)) break; gemm_tile(p.tid, al, Bt, D_, PW, D_, mt * 128, nt * 128, epi, smem); }
}

DI int next_item(const int tid, unsigned* ctr, char* smem) {
  int* slot = (int*)(smem + 69632 - 16);
  __syncthreads();
  if (tid == 0) *slot = (int)atomicAdd(ctr, 1u);
  __syncthreads();
  return *slot;
}

DI void item_dilated(const Ctx& p, int id, char* smem) {
  const int pat = id / 768, r1 = id % 768, b = r1 / 384, r2 = r1 % 384, h = r2 >> 6, blk = r2 & 63;
  const int dil = pat == 0 ? 1 : (pat == 1 ? 4 : 16), nsub = 64 / dil, rho = blk / nsub, i = blk % nsub;
  const bf16_t* proj = (const bf16_t*)(p.ws + OFF_BIG); const bf16_t* base = proj + (size_t)(b * S_ + rho) * PW; const long rs = (long)dil * PW;
  bf16_t* dst = (bf16_t*)(p.ws + OFF_DILO) + ((size_t)pat * T_ + b * S_ + rho + (size_t)dil * 128 * i) * 384 + h * 64;
  float* lse = (float*)(p.ws + OFF_DILL) + ((size_t)pat * T_ + b * S_ + rho + (size_t)dil * 128 * i) * 6 + h;
  const OutSet out{dst, (long)dil * 384, nullptr, 0, lse, (long)dil * 6}; float mm[2], ll[2];
  attn_core<64, 1>(p.tid, base + C_DQ + h * 64, rs, base + C_DK + h * 64, rs, base + C_DV + h * 64, rs, 128 * i, 128 * i - 128, S_ / dil - 1, 4, nullptr,
                   0.125f * 1.44269504089f, 128, nullptr, nullptr, false, mm, ll, out, smem);
}
DI void item_nsawin(const Ctx& p, int id, char* smem) {
  const int b = id / 384, r = id % 384, h = r >> 6, i = r & 63, g = h / 3;
  const bf16_t* proj = (const bf16_t*)(p.ws + OFF_BIG); const bf16_t* base = proj + (size_t)(b * S_) * PW;
  bf16_t* o = (bf16_t*)(p.ws + OFF_XB) + (size_t)(b * S_ + 128 * i) * D_ + 640 + h * 64;
  const OutSet out{o, D_, base + (size_t)(128 * i) * PW + C_GL + h * 3 + 2, PW, nullptr, 0}; float mm[2], ll[2];
  attn_core<64, 1>(p.tid, base + C_NQR + h * 64, PW, base + C_KW + g * 64, PW, base + C_VW + g * 64, PW, 128 * i, 128 * i - 512, S_ - 1, 10, nullptr,
                   0.125f * 1.44269504089f, 512, nullptr, nullptr, false, mm, ll, out, smem);
}
DI void item_expand(const Ctx& p, int l, int id, char* smem) {
  const bf16_t* proj = (const bf16_t*)(p.ws + OFF_BIG); float* rs = (float*)(smem + 65536);
  const bool isq = id < 384; const int lid = isq ? id : id - 384; const int mt = isq ? lid / 3 : lid >> 2, nt = isq ? lid % 3 : lid & 3;
  const int K = isq ? 256 : 128, cb = isq ? C_CQ : C_CKV, tid = p.tid;
  { const int row = tid >> 1, half = tid & 1; const bf16_t* rp = proj + (size_t)(mt * 128 + row) * PW + cb + half * (K / 2); float ss = 0.f;
    for (int c = 0; c < K / 2; c += 8) { const u32x4 w = *(const u32x4*)(rp + c);
#pragma unroll
      for (int e = 0; e < 4; ++e) { const float a = __uint_as_float(w[e] << 16), b2 = __uint_as_float(w[e] & 0xffff0000u); ss += a * a + b2 * b2; } }
    ss += __shfl_xor(ss, 1); if (half == 0) rs[row] = rsqrtf(ss / (float)K + 1e-6f); }
  __syncthreads();
  const ALin al{proj + cb, PW, T_};
  if (isq) { const EpiMLAq epi{(bf16_t*)(p.ws + OFF_QA), rs, mt * 128, (const float*)(p.ws + OFF_C32), (const float*)(p.ws + OFF_S32)};
    gemm_tile(p.tid, al, lw(p.ws, l, LW_UQ), 256, 384, 256, mt * 128, nt * 128, epi, smem); }
  else { const EpiMLAkv epi{(bf16_t*)(p.ws + OFF_KA), (bf16_t*)(p.ws + OFF_VA), rs, mt * 128};
    gemm_tile(p.tid, al, lw(p.ws, l, LW_UKV), 128, 512, 128, mt * 128, nt * 128, epi, smem); }
}
DI void item_cmp(const Ctx& p, int l, int id, char* smem) {
  const int kv = id >> 4, mt = id & 15; const ACmp al1{(const bf16_t*)(p.ws + OFF_BIG), kv ? C_VC : C_KC};
  bf16_t* hid = (bf16_t*)(p.ws + OFF_CHID) + (size_t)kv * 2048 * 256;
  const EpiCmp1 epi1{hid, (const float*)(p.ws + OFF_CBIAS) + (l * 2 + kv) * 256};
#pragma unroll 1
  for (int nt = 0; nt < 2; ++nt) gemm_tile(p.tid, al1, lw(p.ws, l, LW_C1 + kv * SZ_C1), 2048, 256, 2048, mt * 128, nt * 128, epi1, smem);
  asm volatile("s_waitcnt vmcnt(0)" ::: "memory");
  __syncthreads();
  const ALin al2{hid, 256, 2048}; const EpiCmp2 epi2{(bf16_t*)(p.ws + OFF_KCVC) + (size_t)kv * 2048 * 64};
  int t2 = p.tid; asm volatile("" : "+v"(t2));
  gemm_tile(t2, al2, lw(p.ws, l, LW_C2 + kv * SZ_C2), 256, 64, 256, mt * 128, 0, epi2, smem);
}
DI void item_mla(const Ctx& p, int id, char* smem) {
  const int i = 63 - (id >> 3), bh = id & 7, b = bh >> 2, h = bh & 3;
  const bf16_t* qa = (const bf16_t*)(p.ws + OFF_QA) + (size_t)(b * S_) * 384 + h * 96; const bf16_t* ka = (const bf16_t*)(p.ws + OFF_KA) + (size_t)(b * S_) * 384 + h * 96;
  const bf16_t* va = (const bf16_t*)(p.ws + OFF_VA) + (size_t)(b * S_) * 256 + h * 64;
  bf16_t* o = (bf16_t*)(p.ws + OFF_XB) + (size_t)(b * S_ + 128 * i) * D_ + h * 64; const OutSet out{o, D_, nullptr, 0, nullptr, 0}; float mm[2], ll[2];
  attn_core<96, 0>(p.tid, qa, 384, ka, 384, va, 256, 128 * i, 0, S_ - 1, 2 * (i + 1), nullptr, 0.10206207261f * 1.44269504089f, 0, nullptr, nullptr, false, mm, ll, out, smem);
}
DI void item_nsacmp(const Ctx& p, int id, char* smem) {
  const int i = 63 - (id >> 2), bg = id & 3, b = bg >> 1, g = bg & 1, tid = p.tid;
  const bf16_t* proj = (const bf16_t*)(p.ws + OFF_BIG); const bf16_t* base = proj + (size_t)(b * S_) * PW;
  const bf16_t* kc = (const bf16_t*)(p.ws + OFF_KCVC) + (size_t)((b * 2 + g) * NCMP) * 64; const bf16_t* vc = kc + (size_t)2048 * 64;
  float* imp = (float*)(p.ws + OFF_IMP) + ((size_t)((b * 2 + g) * S_) + 128 * i) * 128;
  const int nkt = (i + 8) >> 3;
#pragma unroll 1
  for (int hh = 0; hh < 3; ++hh) { const int h = g * 3 + hh; float mm[2], ll[2];
    bf16_t* o = (bf16_t*)(p.ws + OFF_XB) + (size_t)(b * S_ + 128 * i) * D_ + 640 + h * 64;
    const OutAdd out{o, D_, base + (size_t)(128 * i) * PW + C_GL + h * 3 + 0, PW};
    attn_core<64, 2>(p.tid, base + C_NQ + h * 64, PW, kc, 64, vc, 64, 128 * i, 0, NCMP - 1, nkt, nullptr, 0.125f * 1.44269504089f, 0, nullptr, nullptr, false, mm, ll, out, smem);
    attn_core<64, 3>(p.tid, base + C_NQ + h * 64, PW, kc, 64, vc, 64, 128 * i, 0, NCMP - 1, nkt, nullptr, 0.125f * 1.44269504089f, 0, nullptr, imp, hh == 0, mm, ll, out, smem);
  }
  __syncthreads();
  float* sc = (float*)smem;
  const int q = tid >> 1, half = tid & 1, qpos = 128 * i + q, cur = qpos >> 6;
#pragma unroll 2
  for (int j = half * 64; j < half * 64 + 64; ++j) { const float v = (j < nkt * 16) ? imp[(size_t)q * 128 + j] : 0.f; const bool forced = (j == 0) || (j == cur) || (j == cur - 1);
    sc[q * 129 + j] = forced ? 1e4f : (j <= cur ? v : -1e4f); }
  unsigned m0 = 0, m1 = 0, m2 = 0, m3 = 0;
#pragma unroll 1
  for (int rd = 0; rd < 16; ++rd) {
    float bv = -3e38f; int bj = half * 64;
#pragma unroll 4
    for (int j = half * 64; j < half * 64 + 64; ++j) { const float v = sc[q * 129 + j]; if (v > bv) { bv = v; bj = j; } }
    const float ov = __shfl_xor(bv, 1); const int oj = __shfl_xor(bj, 1);
    if (ov > bv || (ov == bv && oj < bj)) { bv = ov; bj = oj; }
    if ((bj >> 6) == half) sc[q * 129 + bj] = -3.2e38f;
    if (bj <= cur) { const unsigned bit = 1u << (bj & 31); const int w = bj >> 5; m0 |= (w == 0) ? bit : 0u; m1 |= (w == 1) ? bit : 0u; m2 |= (w == 2) ? bit : 0u; m3 |= (w == 3) ? bit : 0u; }
  }
  if (half == 0) { u32x4 w; w[0] = m0; w[1] = m1; w[2] = m2; w[3] = m3; *(u32x4*)((unsigned*)(p.ws + OFF_SEL) + ((size_t)(b * S_ + qpos) * 2 + g) * 4) = w; }
  __syncthreads();
}
DI void item_dilcombine(const Ctx& p, int id) {
  const size_t e = (size_t)id * 256 + p.tid; const int tok = (int)(e / 48), r = (int)(e % 48), h = r >> 3, d0 = (r & 7) * 8;
  const float* L = (const float*)(p.ws + OFF_DILL); const bf16_t* O = (const bf16_t*)(p.ws + OFF_DILO);
  const float l0 = L[(size_t)tok * 6 + h], l1 = L[((size_t)T_ + tok) * 6 + h], l2 = L[((size_t)2 * T_ + tok) * 6 + h]; const float mx = fmaxf(l0, fmaxf(l1, l2));
  float w0 = __expf(l0 - mx), w1 = __expf(l1 - mx), w2 = __expf(l2 - mx); const float inv = 1.f / (w0 + w1 + w2); w0 *= inv; w1 *= inv; w2 *= inv;
  const u32x4 a = *(const u32x4*)(O + (size_t)tok * 384 + h * 64 + d0), b = *(const u32x4*)(O + ((size_t)T_ + tok) * 384 + h * 64 + d0), c = *(const u32x4*)(O + ((size_t)2 * T_ + tok) * 384 + h * 64 + d0);
  u32x4 w;
#pragma unroll
  for (int k = 0; k < 4; ++k) { const float lo = w0 * __uint_as_float(a[k] << 16) + w1 * __uint_as_float(b[k] << 16) + w2 * __uint_as_float(c[k] << 16);
    const float hi = w0 * __uint_as_float(a[k] & 0xffff0000u) + w1 * __uint_as_float(b[k] & 0xffff0000u) + w2 * __uint_as_float(c[k] & 0xffff0000u); w[k] = pk2(lo, hi); }
  *(u32x4*)((bf16_t*)(p.ws + OFF_XB) + (size_t)tok * D_ + 256 + h * 64 + d0) = w;
}
DI void item_nsaslc(const Ctx& p, int id, char* smem) {
  const int i = 63 - id / 12, r = id % 12, b = r / 6, h = r % 6, g = h / 3, tid = p.tid;
  const bf16_t* proj = (const bf16_t*)(p.ws + OFF_BIG); const bf16_t* base = proj + (size_t)(b * S_) * PW;
  unsigned* selw = (unsigned*)(smem + 49152 + 2048); int* tlist = (int*)(smem + 49152); unsigned* un = (unsigned*)(smem + 49152 + 1024);
  __syncthreads();
  if (tid < 4) un[tid] = 0u;
  __syncthreads();
  if (tid < 128) { const u32x4 w = *(const u32x4*)((const unsigned*)(p.ws + OFF_SEL) + ((size_t)(b * S_ + 128 * i + tid) * 2 + g) * 4);
    selw[tid * 4 + 0] = w[0]; selw[tid * 4 + 1] = w[1]; selw[tid * 4 + 2] = w[2]; selw[tid * 4 + 3] = w[3];
    atomicOr(&un[0], w[0]); atomicOr(&un[1], w[1]); atomicOr(&un[2], w[2]); atomicOr(&un[3], w[3]); }
  __syncthreads();
  if (tid == 0) { int n = 0; for (int jt = 0; jt < 2 * (i + 1); ++jt) if ((un[jt >> 5] >> (jt & 31)) & 1u) tlist[n++] = jt; tlist[255] = n; }
  __syncthreads();
  const int nt = tlist[255];
  bf16_t* o = (bf16_t*)(p.ws + OFF_XB) + (size_t)(b * S_ + 128 * i) * D_ + 640 + h * 64;
  const OutAdd out{o, D_, base + (size_t)(128 * i) * PW + C_GL + h * 3 + 1, PW}; float mm[2], ll[2];
  attn_core<64, 4>(p.tid, base + C_NQR + h * 64, PW, base + C_KSL + g * 64, PW, base + C_VSL + g * 64, PW, 128 * i, 0, S_ - 1, nt, tlist, 0.125f * 1.44269504089f, 0, selw, nullptr, false, mm, ll, out, smem);
}

DI void phase_mix_a(const Params& P, const Ctx& p0, int l, char* smem, int ci, int f0, int f1) {
  unsigned* ctr = (unsigned*)(p0.ws + OFF_CTRL) + l * 8 + ci; const int total = 32 + 768 + 2304 + 896;
  for (;;) { Ctx q = p0; asm volatile("" : "+v"(q.tid)); asm volatile("" : "+v"(q.ws)); const Ctx& p = q; const int t = next_item(p.tid, ctr, smem);
    if (t >= total) { if (t - total < f1 - f0) { convert_wtile(P, p.tid, f0 + t - total, smem); continue; } break; }
    if (t < 32) item_cmp(p, l, t, smem); else if (t < 32 + 768) item_nsawin(p, t - 32, smem); else if (t < 32 + 768 + 2304) item_dilated(p, t - 32 - 768, smem);
    else item_expand(p, l, t - 32 - 768 - 2304, smem); }
}
DI void phase_mix_b(const Params& P, const Ctx& p0, int l, char* smem, int ci, int f0, int f1) {
  unsigned* ctr = (unsigned*)(p0.ws + OFF_CTRL) + l * 8 + ci; const int total = 512 + 256 + 3072;
  for (;;) { Ctx q = p0; asm volatile("" : "+v"(q.tid)); asm volatile("" : "+v"(q.ws)); const Ctx& p = q; const int t = next_item(p.tid, ctr, smem);
    if (t >= total) { if (t - total < f1 - f0) { convert_wtile(P, p.tid, f0 + t - total, smem); continue; } break; }
    if (t < 512) item_mla(p, t, smem);
    else if (t < 512 + 256) item_nsacmp(p, t - 512, smem); else item_dilcombine(p, t - 512 - 256); }
}
DI void phase_mix_d(const Params& P, const Ctx& p0, int l, char* smem, int f0, int f1) {
  unsigned* ctr = (unsigned*)(p0.ws + OFF_CTRL) + l * 8 + 3; const int total = 768;
  for (;;) { Ctx q = p0; asm volatile("" : "+v"(q.tid)); asm volatile("" : "+v"(q.ws)); const Ctx& p = q; const int t = next_item(p.tid, ctr, smem);
    if (t >= total) { if (t - total < f1 - f0) { convert_wtile(P, p.tid, f0 + t - total, smem); continue; } break; }
    item_nsaslc(p, t, smem); }
}
DI void phase_zero_o(const Ctx& p) {
  u32x4* o = (u32x4*)(p.ws + OFF_XB); const u32x4 z = (u32x4){0u, 0u, 0u, 0u};
  for (size_t e = (size_t)blockIdx.x * 256 + p.tid; e < (size_t)T_ * D_ / 8; e += (size_t)gridDim.x * 256) o[e] = z;
}

DI void run_phase(const Params& P, int ph, char* smem) {
  Ctx p; p.x = P.x; p.ln_g = P.ln_g; p.ln_b = P.ln_b; p.cmp_pos = P.cmp_pos; p.cmp_w1 = P.cmp_w1; p.out = P.out; p.ws = P.ws; p.tid = threadIdx.x;
  asm volatile("" : "+v"(p.tid));
  if (ph == 0) { phase_prologue(P, p, smem); return; }
  const int l = (ph - 1) / 12; int s = (ph - 1) % 12;
#ifdef ONLY_S
  if (s != ONLY_S) return;
  s = ONLY_S;
#endif
  switch (s) {
    case 0: phase_ffn_up(p, l, 0, smem); break;
    case 1: phase_ffn_down(p, l, 0, smem); break;
    case 2: phase_ln(p, l, 0, false); break;
#if ENABLE_MIX
    case 3: phase_win(p, l, smem); break;
    case 4: { const int nl = P.n_wtiles - P.n_early, a = P.n_early, b = a + (l == 0 ? nl / 3 : 0); phase_mix_a(P, p, l, smem, 0, a, b); } break;
    case 5: { const int nl = P.n_wtiles - P.n_early, a = P.n_early + nl / 3, b = a + (l == 0 ? nl / 3 : 0); phase_mix_b(P, p, l, smem, 1, a, b); } break;
    case 6: { const int nl = P.n_wtiles - P.n_early, a = P.n_early + 2 * (nl / 3), b = (l == 0 ? P.n_wtiles : a); phase_mix_d(P, p, l, smem, a, b); } break;
#else
    case 3: phase_zero_o(p); break;
    case 4: case 5: case 6: break;
#endif
    case 7: phase_wout(p, l, smem); break;
    case 8: phase_ln(p, l, 1, false); break;
    case 9: phase_ffn_up(p, l, 1, smem); break;
    case 10: phase_ffn_down(p, l, 1, smem); break;
    case 11: phase_ln(p, l, 2, false); break;
  }
}
constexpr int NPHASE = 25;

#if ONE_LAUNCH
DI unsigned xb_ld(unsigned* p) { return __hip_atomic_load(p, __ATOMIC_RELAXED, __HIP_MEMORY_SCOPE_AGENT); }
DI unsigned xb_add(unsigned* p, unsigned v) { return __hip_atomic_fetch_add(p, v, __ATOMIC_RELAXED, __HIP_MEMORY_SCOPE_AGENT); }
DI void xb_st(unsigned* p, unsigned v) { __hip_atomic_store(p, v, __ATOMIC_RELAXED, __HIP_MEMORY_SCOPE_AGENT); }
constexpr int XB_CNT = 256, XB_SUB = 256 + 64 * 16, XB_GEN = 256 + 64 * 32, XB_TOP = 256 + 64 * 48, XB_TOPGEN = 256 + 64 * 49, XB_WORDS = 256 + 64 * 50;
DI void grid_bar(const Params& P, unsigned idx, char* smem) {
  asm volatile("s_waitcnt vmcnt(0)" ::: "memory");
  __syncthreads();
  int t = threadIdx.x; asm volatile("" : "+v"(t));
  if (t == 0) {
    unsigned* bar = (unsigned*)(P.ws + OFF_CTRL);
    volatile unsigned* st = (volatile unsigned*)(smem + 69632 - 16);
    const unsigned x = st[1], nloc = st[2], nx = st[3];
    const unsigned old = xb_add(&bar[XB_SUB + 64 * x], 1u);
    if (old + 1u == idx * nloc) {
      __builtin_amdgcn_fence(__ATOMIC_RELEASE, "agent");
      asm volatile("s_waitcnt vmcnt(0)" ::: "memory");
      const unsigned og = xb_add(&bar[XB_TOP], 1u);
      if (og + 1u == idx * nx) xb_st(&bar[XB_TOPGEN], idx);
      else { while (xb_ld(&bar[XB_TOPGEN]) < idx) __builtin_amdgcn_s_sleep(1); }
      xb_st(&bar[XB_GEN + 64 * x], idx);
    } else { while (xb_ld(&bar[XB_GEN + 64 * x]) < idx) __builtin_amdgcn_s_sleep(1); }
    __builtin_amdgcn_fence(__ATOMIC_ACQUIRE, "agent");
    asm volatile("s_waitcnt vmcnt(0)" ::: "memory");
  }
  __syncthreads();
}
template <int PH> DI void run_all(const Params& p, char* smem) {
  run_phase(p, PH, smem);
  if constexpr (PH + 1 < NPHASE) { grid_bar(p, PH + 1, smem); run_all<PH + 1>(p, smem); }
}
__global__ void __launch_bounds__(256, 2) mega_kernel(Params p) {
  __shared__ __attribute__((aligned(16))) char smem[69632];
  {
    unsigned* bar = (unsigned*)(p.ws + OFF_CTRL); volatile unsigned* st = (volatile unsigned*)(smem + 69632 - 16);
    const unsigned x = (unsigned)__builtin_amdgcn_s_getreg((3 << 11) | 20) & 0xFu;
    if (threadIdx.x == 0) xb_add(&bar[XB_CNT + 64 * x], 1u);
    cg::this_grid().sync();
    if (threadIdx.x == 0) { unsigned nx = 0, mine = 1;
      for (unsigned j = 0; j < 16; ++j) { const unsigned c = xb_ld(&bar[XB_CNT + 64 * j]); nx += (c > 0u) ? 1u : 0u; if (j == x) mine = c; }
      st[1] = x; st[2] = mine; st[3] = nx; }
    __syncthreads();
  }
  run_all<0>(p, smem);
}
#define MAIN_KERNEL mega_kernel
#else
#define MAIN_KERNEL phase_kernel
#endif
__global__ void __launch_bounds__(256, 2) phase_kernel(Params p, int ph) {
  __shared__ __attribute__((aligned(16))) char smem[69632];
  run_phase(p, ph, smem);
}

extern "C" void kernel_launch(void* const* d_in, const int* in_sizes, int n_in, void* d_out, int out_size, void* d_ws, size_t ws_size, hipStream_t stream) {
  static int grid_blocks = 0;
  if (!grid_blocks) { int dev = 0, cus = 0, per_cu = 0; hipGetDevice(&dev); hipDeviceGetAttribute(&cus, hipDeviceAttributeMultiprocessorCount, dev);
    hipOccupancyMaxActiveBlocksPerMultiprocessor(&per_cu, MAIN_KERNEL, 256, 0); if (per_cu > 2) per_cu = 2; if (per_cu < 1) per_cu = 1; grid_blocks = cus * per_cu; }
  if (ws_size < OFF_END) { fprintf(stderr, "workspace too small: %zu < %zu\n", ws_size, (size_t)OFF_END); return; }
  Params p; memset(&p, 0, sizeof(p));
  const float* x = (const float*)d_in[0]; const float* ffn_in = (const float*)d_in[1]; const float* ffn_out = (const float*)d_in[2];
  const float* w_in = (const float*)d_in[5]; const float* w_out = (const float*)d_in[6]; const float* qn = (const float*)d_in[7]; const float* kvn = (const float*)d_in[8];
  const float* wuq = (const float*)d_in[9]; const float* wukv = (const float*)d_in[10]; const float* cw1 = (const float*)d_in[12]; const float* cw2 = (const float*)d_in[13];
  p.x = x; p.ln_g = (const float*)d_in[3]; p.ln_b = (const float*)d_in[4]; p.cmp_pos = (const float*)d_in[11]; p.cmp_w1 = cw1; p.out = (float*)d_out; p.ws = (char*)d_ws;
  int tile0 = 0, di = 0;
  auto add = [&](const float* src, size_t dst_off, const float* ksc, int K, int Nsrc, int Ndst, int map) {
    WDesc& d = p.wd[di++]; d.src = src; d.dst = (bf16_t*)((char*)d_ws + dst_off); d.kscale = ksc; d.K = K; d.Nsrc = Nsrc; d.Ndst = Ndst; d.map = map; d.tile0 = tile0; d.ntn = Ndst / 64;
    tile0 += (Ndst / 64) * (K / 128); };
  auto add_ffn_in = [&](int l, int j) { add(ffn_in + (size_t)(l * 2 + j) * 1024 * 5632, OFF_W + (size_t)l * LW_SIZE + LW_FIN + j * SZ_FIN, nullptr, 1024, 5632, 5632, 1); };
  auto add_ffn_out = [&](int l, int j) { add(ffn_out + (size_t)(l * 2 + j) * 2816 * 1024, OFF_W + (size_t)l * LW_SIZE + LW_FOUT + j * SZ_FOUT, nullptr, 2816, 1024, 1024, 0); };
  auto add_mix = [&](int l) { const size_t wb = OFF_W + (size_t)l * LW_SIZE;
    add(w_in + (size_t)l * 1024 * 2738, wb + LW_WIN, nullptr, 1024, 2738, PW, 2);
    add(wuq + (size_t)l * 256 * 384, wb + LW_UQ, qn + l * 256, 256, 384, 384, 0);
    add(wukv + (size_t)l * 128 * 512, wb + LW_UKV, kvn + l * 128, 128, 512, 512, 0);
    for (int kv = 0; kv < 2; ++kv) add(cw1 + (size_t)(l * 2 + kv) * 2048 * 256, wb + LW_C1 + kv * SZ_C1, nullptr, 2048, 256, 256, 0);
    for (int kv = 0; kv < 2; ++kv) add(cw2 + (size_t)(l * 2 + kv) * 256 * 64, wb + LW_C2 + kv * SZ_C2, nullptr, 256, 64, 64, 0); };
  auto add_wout = [&](int l) { add(w_out + (size_t)l * 1024 * 1024, OFF_W + (size_t)l * LW_SIZE + LW_WOUT, nullptr, 1024, 1024, 1024, 0); };
  add_ffn_in(0, 0); add_ffn_out(0, 0); add_mix(0);
  p.n_early = tile0;
  add_wout(0); add_ffn_in(0, 1); add_ffn_out(0, 1); add_ffn_in(1, 0); add_ffn_out(1, 0); add_mix(1); add_wout(1); add_ffn_in(1, 1); add_ffn_out(1, 1);
  p.n_wtiles = tile0;
  hipMemsetAsync((char*)d_ws + OFF_CTRL, 0, 16384, stream);
#if ONE_LAUNCH
  void* args[] = {&p};
  hipError_t e = hipLaunchCooperativeKernel((void*)mega_kernel, dim3(grid_blocks), dim3(256), args, 0, stream);
  if (e != hipSuccess) fprintf(stderr, "cooperative launch failed: %s (grid %d)\n", hipGetErrorString(e), grid_blocks);
#else
  for (int ph = 0; ph < NPHASE; ++ph) phase_kernel<<<dim3(grid_blocks), dim3(256), 0, stream>>>(p, ph);
#endif
}
```
